# Optimizing an MI355X kernel written in HIP

```python
import math
import jax, jax.numpy as jnp
from jax import lax
import numpy as np

D_MODEL = 2048
BATCH = 4
SEQ = 4096
DEPTH = 1

EPS = 1e-6
BLOCK = 128
NEG_INF = -1e30

MLA_HEADS = 8
MLA_NOPE = 128
MLA_ROPE = 64
MLA_V = 128
MLA_Q_RANK = 512
MLA_KV_RANK = 256
MLA_QK = MLA_NOPE + MLA_ROPE
ROPE_THETA = 10000.0

SWA_HEADS = 16
SWA_KV_HEADS = 2
SWA_HD = 64
SWA_GROUP = SWA_HEADS // SWA_KV_HEADS
WINDOW = 128

N_BUCKETS = 32
MAX_DISTANCE = 128

PEER_HEADS = 8
PEER_NKEYS = 128
PEER_N = PEER_NKEYS * PEER_NKEYS
PEER_DQ = 256
PEER_TOPK = 16
PEER_CHUNK = 64

MLA_OUT = MLA_HEADS * MLA_V
SWA_OUT = SWA_HEADS * SWA_HD
MIX_WIDTH = MLA_OUT + SWA_OUT
IN_SPLITS = (MLA_Q_RANK, MLA_KV_RANK, MLA_ROPE, SWA_HEADS * SWA_HD, SWA_KV_HEADS * SWA_HD, SWA_KV_HEADS * SWA_HD)
IN_COLS = sum(IN_SPLITS)

kernel_name = "hybrid_mla_swa_peer_block"


def rms_norm(x, g):
    xf = x.astype(jnp.float32)
    y = xf * lax.rsqrt(jnp.mean(xf * xf, axis=-1, keepdims=True) + EPS)
    return (y * g.astype(jnp.float32)).astype(x.dtype)


def rope(x, positions):
    half = x.shape[-1] // 2
    inv_freq = ROPE_THETA ** (-jnp.arange(half, dtype=jnp.float32) / half)
    ang = positions.astype(jnp.float32)[:, :, None, None] * inv_freq
    cos, sin = jnp.cos(ang), jnp.sin(ang)
    x1 = x[..., :half].astype(jnp.float32)
    x2 = x[..., half:].astype(jnp.float32)
    out = jnp.concatenate([x1 * cos - x2 * sin, x2 * cos + x1 * sin], axis=-1)
    return out.astype(x.dtype)


def t5_bucket(dist):
    n = jnp.maximum(dist, 0)
    max_exact = N_BUCKETS // 2
    nf = jnp.maximum(n, 1).astype(jnp.float32)
    large = max_exact + (jnp.log(nf / max_exact) / math.log(MAX_DISTANCE / max_exact)
                         * (N_BUCKETS - max_exact)).astype(jnp.int32)
    large = jnp.minimum(large, N_BUCKETS - 1)
    return jnp.where(n < max_exact, n, large)


def mla_group(q_lat, kv_lat, k_pe, positions, q_a_gain, w_q_b, kv_a_gain, w_kv_b, q_gain, k_gain):
    B, S, _ = q_lat.shape
    q = (rms_norm(q_lat, q_a_gain) @ w_q_b).reshape(B, S, MLA_HEADS, MLA_QK)
    kv = (rms_norm(kv_lat, kv_a_gain) @ w_kv_b).reshape(B, S, MLA_HEADS, MLA_NOPE + MLA_V)
    k_nope, v = kv[..., :MLA_NOPE], kv[..., MLA_NOPE:]
    k = jnp.concatenate([k_nope, jnp.broadcast_to(k_pe[:, :, None, :], (B, S, MLA_HEADS, MLA_ROPE))], axis=-1)
    q = rms_norm(q, q_gain)
    k = rms_norm(k, k_gain)
    q = jnp.concatenate([q[..., :MLA_NOPE], rope(q[..., MLA_NOPE:], positions)], axis=-1)
    k = jnp.concatenate([k[..., :MLA_NOPE], rope(k[..., MLA_NOPE:], positions)], axis=-1)
    scale = MLA_QK ** -0.5
    nb = S // BLOCK
    q_blocks = q.reshape(B, nb, BLOCK, MLA_HEADS, MLA_QK).transpose(1, 0, 2, 3, 4)
    k_idx = jnp.arange(S)

    def one_block(args):
        qb, bi = args
        s = jnp.einsum('bqhd,bkhd->bhqk', qb, k, preferred_element_type=jnp.float32) * scale
        q_idx = bi * BLOCK + jnp.arange(BLOCK)
        causal = k_idx[None, :] <= q_idx[:, None]
        s = jnp.where(causal[None, None], s, NEG_INF)
        p = jax.nn.softmax(s, axis=-1).astype(v.dtype)
        return jnp.einsum('bhqk,bkhd->bqhd', p, v)

    o = lax.map(one_block, (q_blocks, jnp.arange(nb)))
    return o.transpose(1, 0, 2, 3, 4).reshape(B, S, MLA_OUT)


def band(t, nb):
    B, S = t.shape[:2]
    rest = t.shape[2:]
    tp = jnp.pad(t, [(0, 0), (BLOCK, 0)] + [(0, 0)] * len(rest))
    prev = tp[:, :S].reshape(B, nb, BLOCK, *rest)
    cur = t.reshape(B, nb, BLOCK, *rest)
    return jnp.concatenate([prev, cur], axis=2)


def swa_group(q, k, v, positions, q_gain, k_gain, sinks, rel_table):
    B, S, _ = q.shape
    nb = S // BLOCK
    q = rms_norm(q.reshape(B, S, SWA_KV_HEADS, SWA_GROUP, SWA_HD), q_gain)
    k = rms_norm(k.reshape(B, S, SWA_KV_HEADS, SWA_HD), k_gain)
    v = v.reshape(B, S, SWA_KV_HEADS, SWA_HD)
    qb = q.reshape(B, nb, BLOCK, SWA_KV_HEADS, SWA_GROUP, SWA_HD)
    kb, vb, pb = band(k, nb), band(v, nb), band(positions, nb)
    s = jnp.einsum('bnqkgd,bnjkd->bnkgqj', qb, kb, preferred_element_type=jnp.float32) * (SWA_HD ** -0.5)
    qp = positions.reshape(B, nb, BLOCK)
    bucket = t5_bucket(qp[..., :, None] - pb[..., None, :])
    bias = rel_table[bucket].astype(jnp.float32)
    bias = bias.reshape(B, nb, BLOCK, 2 * BLOCK, SWA_KV_HEADS, SWA_GROUP).transpose(0, 1, 4, 5, 2, 3)
    s = s + bias
    q_idx = jnp.arange(S).reshape(nb, BLOCK)
    k_idx = (jnp.arange(nb) * BLOCK - BLOCK)[:, None] + jnp.arange(2 * BLOCK)[None, :]
    off = q_idx[:, :, None] - k_idx[:, None, :]
    mask = (off >= 0) & (off < WINDOW) & (k_idx[:, None, :] >= 0)
    s = jnp.where(mask[None, :, None, None], s, NEG_INF)
    sink = jnp.broadcast_to(sinks.astype(jnp.float32).reshape(SWA_KV_HEADS, SWA_GROUP)[None, None, :, :, None, None],
                            s.shape[:-1] + (1,))
    p = jax.nn.softmax(jnp.concatenate([s, sink], axis=-1), axis=-1)[..., :-1].astype(vb.dtype)
    o = jnp.einsum('bnkgqj,bnjkd->bnqkgd', p, vb)
    return o.reshape(B, S, SWA_OUT)


def peer(h, w_q, sub_keys, expert_u, expert_v):
    B, S, D = h.shape
    T = B * S
    xt = h.reshape(T, D)
    q = (xt @ w_q).reshape(T, PEER_HEADS, 2, PEER_DQ // 2)
    s = jnp.einsum('thpd,hpnd->thpn', q, sub_keys, preferred_element_type=jnp.float32)
    s_half, i_half = lax.top_k(s, PEER_TOPK)
    cand = (s_half[:, :, 0, :, None] + s_half[:, :, 1, None, :]).reshape(T, PEER_HEADS, PEER_TOPK * PEER_TOPK)
    cand_idx = (i_half[:, :, 0, :, None] * PEER_NKEYS + i_half[:, :, 1, None, :]).reshape(T, PEER_HEADS, PEER_TOPK * PEER_TOPK)
    top_s, pos = lax.top_k(cand, PEER_TOPK)
    idx = jnp.take_along_axis(cand_idx, pos, axis=-1)
    g = jax.nn.softmax(top_s, axis=-1)
    n_chunks = T // PEER_CHUNK
    HK = PEER_HEADS * PEER_TOPK

    def one_chunk(args):
        xc, ic, gc = args
        u = expert_u[ic]
        a = jnp.einsum('cd,ced->ce', xc, u, preferred_element_type=jnp.float32)
        w = (gc * jax.nn.gelu(a)).astype(xc.dtype)
        return jnp.einsum('ce,ced->cd', w, expert_v[ic])

    y = lax.map(one_chunk, (xt.reshape(n_chunks, PEER_CHUNK, D),
                            idx.reshape(n_chunks, PEER_CHUNK, HK),
                            g.reshape(n_chunks, PEER_CHUNK, HK)))
    return y.reshape(B, S, D)


def setup_inputs(seed: int = 0) -> dict:
    key = jax.random.key(seed)
    ks = jax.random.split(key, 24)
    f32 = jnp.float32
    L = DEPTH

    def nrm(k, shape, scale):
        return jax.random.normal(k, shape, f32) * scale

    def gain(k, shape):
        return 1.0 + 0.05 * jax.random.normal(k, shape, f32)

    x = jax.random.normal(ks[0], (BATCH, SEQ, D_MODEL), f32)
    offset = jax.random.randint(ks[1], (BATCH, 1), 0, 1024, dtype=jnp.int32)
    positions = (offset + jnp.arange(SEQ, dtype=jnp.int32)[None, :]).astype(jnp.int32)
    return {
        "x": x,
        "positions": positions,
        "norm1_gain": gain(ks[2], (L, D_MODEL)),
        "w_in": nrm(ks[3], (L, D_MODEL, IN_COLS), D_MODEL ** -0.5),
        "q_a_gain": gain(ks[4], (L, MLA_Q_RANK)),
        "w_q_b": nrm(ks[5], (L, MLA_Q_RANK, MLA_HEADS * MLA_QK), MLA_Q_RANK ** -0.5),
        "kv_a_gain": gain(ks[6], (L, MLA_KV_RANK)),
        "w_kv_b": nrm(ks[7], (L, MLA_KV_RANK, MLA_HEADS * (MLA_NOPE + MLA_V)), MLA_KV_RANK ** -0.5),
        "mla_q_gain": gain(ks[8], (L, MLA_QK)),
        "mla_k_gain": gain(ks[9], (L, MLA_QK)),
        "swa_q_gain": gain(ks[10], (L, SWA_HD)),
        "swa_k_gain": gain(ks[11], (L, SWA_HD)),
        "swa_sinks": nrm(ks[12], (L, SWA_HEADS), 1.0),
        "rel_bias_table": nrm(ks[13], (N_BUCKETS, SWA_HEADS), 0.5),
        "group_out_gain": gain(ks[14], (L, MIX_WIDTH)),
        "w_out": nrm(ks[15], (L, MIX_WIDTH, D_MODEL), MIX_WIDTH ** -0.5),
        "norm2_gain": gain(ks[16], (L, D_MODEL)),
        "peer_w_q": nrm(ks[17], (L, D_MODEL, PEER_HEADS * PEER_DQ), D_MODEL ** -0.5),
        "peer_sub_keys": nrm(ks[18], (L, PEER_HEADS, 2, PEER_NKEYS, PEER_DQ // 2), (PEER_DQ // 2) ** -0.5),
        "peer_u": nrm(ks[19], (L, PEER_N, D_MODEL), D_MODEL ** -0.5),
        "peer_v": nrm(ks[20], (L, PEER_N, D_MODEL), 0.3),
    }


def reference(x, positions, norm1_gain, w_in, q_a_gain, w_q_b, kv_a_gain, w_kv_b, mla_q_gain, mla_k_gain,
              swa_q_gain, swa_k_gain, swa_sinks, rel_bias_table, group_out_gain, w_out, norm2_gain,
              peer_w_q, peer_sub_keys, peer_u, peer_v):
    offsets = np.cumsum(IN_SPLITS)[:-1].tolist()
    h = x
    for l in range(DEPTH):
        n1 = rms_norm(h, norm1_gain[l])
        proj = n1 @ w_in[l]
        q_lat, kv_lat, k_pe, q_swa, k_swa, v_swa = jnp.split(proj, offsets, axis=-1)
        o_mla = mla_group(q_lat, kv_lat, k_pe, positions, q_a_gain[l], w_q_b[l], kv_a_gain[l], w_kv_b[l],
                          mla_q_gain[l], mla_k_gain[l])
        o_swa = swa_group(q_swa, k_swa, v_swa, positions, swa_q_gain[l], swa_k_gain[l], swa_sinks[l],
                          rel_bias_table)
        g_out = group_out_gain[l]
        mixed = jnp.concatenate([rms_norm(o_mla, g_out[:MLA_OUT]), rms_norm(o_swa, g_out[MLA_OUT:])], axis=-1)
        h = h + mixed @ w_out[l]
        h = h + peer(rms_norm(h, norm2_gain[l]), peer_w_q[l], peer_sub_keys[l], peer_u[l], peer_v[l])
    return h
```

```cpp
#include <hip/hip_runtime.h>
#include <stdint.h>
#include <stdio.h>

#define DEVI __device__ __forceinline__
typedef unsigned short bf16_t;
typedef short bf16x8 __attribute__((ext_vector_type(8)));
typedef float f32x4 __attribute__((ext_vector_type(4)));
typedef unsigned u32x4 __attribute__((ext_vector_type(4)));
typedef unsigned u32x2 __attribute__((ext_vector_type(2)));

constexpr int BATCH = 4, SEQ = 4096, DM = 2048, T = BATCH * SEQ;
constexpr int PROJ_LD = 2304;
constexpr int C_QLAT = 0, C_KVLAT = 512, C_SQ = 768, C_SK = 1792, C_SV = 1920, C_KPE = 2048;
constexpr int QK_LD = 1536;
constexpr int KV_LD = 2048;
constexpr float EPS = 1e-6f;
constexpr float LOG2E = 1.4426950408889634f;

constexpr size_t MiB = 1u << 20;
constexpr size_t WS_CTL = 0;
constexpr size_t WS_W1T = 2 * MiB;
constexpr size_t WS_WQB = 11 * MiB;
constexpr size_t WS_WKVB = 13 * MiB;
constexpr size_t WS_WOUT = 14 * MiB;
constexpr size_t WS_WPQ = 22 * MiB;
constexpr size_t WS_SUBK = 30 * MiB;
constexpr size_t WS_UB = 32 * MiB;
constexpr size_t WS_VB = 96 * MiB;
constexpr size_t WS_PROJ = 160 * MiB;
constexpr size_t WS_KV = 232 * MiB;
constexpr size_t WS_Q = 296 * MiB;
constexpr size_t WS_K = 344 * MiB;
constexpr size_t WS_ACT = 392 * MiB;
constexpr size_t WS_END = 456 * MiB;

__device__ const float kInvFreq[32] = {
    1.000000000e+00f, 7.498942018e-01f, 5.623413324e-01f, 4.216965139e-01f, 3.162277639e-01f, 2.371373773e-01f, 1.778279394e-01f, 1.333521456e-01f,
    1.000000015e-01f, 7.498942316e-02f, 5.623413250e-02f, 4.216964915e-02f, 3.162277490e-02f, 2.371373773e-02f, 1.778279431e-02f, 1.333521400e-02f,
    9.999999776e-03f, 7.498942316e-03f, 5.623413250e-03f, 4.216964822e-03f, 3.162277630e-03f, 2.371373819e-03f, 1.778279431e-03f, 1.333521446e-03f,
    1.000000047e-03f, 7.498941850e-04f, 5.623413017e-04f, 4.216965172e-04f, 3.162277571e-04f, 2.371373703e-04f, 1.778279402e-04f, 1.333521504e-04f};

DEVI float bf2f(unsigned h) { return __uint_as_float((h & 0xffffu) << 16); }
DEVI unsigned f2bf(float f) { unsigned u = __float_as_uint(f); return (u + 0x7fffu + ((u >> 16) & 1u)) >> 16; }
DEVI unsigned pk2(float lo, float hi) { return f2bf(lo) | (f2bf(hi) << 16); }
DEVI float wave_sum(float v) {
#pragma unroll
    for (int o = 1; o < 64; o <<= 1) v += __shfl_xor(v, o);
    return v;
}
DEVI void unpack8(const u32x4 w, float* f) {
    f[0] = __uint_as_float(w.x << 16); f[1] = __uint_as_float(w.x & 0xffff0000u);
    f[2] = __uint_as_float(w.y << 16); f[3] = __uint_as_float(w.y & 0xffff0000u);
    f[4] = __uint_as_float(w.z << 16); f[5] = __uint_as_float(w.z & 0xffff0000u);
    f[6] = __uint_as_float(w.w << 16); f[7] = __uint_as_float(w.w & 0xffff0000u);
}
DEVI u32x4 pack8(const float* f) { u32x4 w; w.x = pk2(f[0], f[1]); w.y = pk2(f[2], f[3]); w.z = pk2(f[4], f[5]); w.w = pk2(f[6], f[7]); return w; }
DEVI float gelu_tanh(float a) {
    const float z = 0.7978845608028654f * (a + 0.044715f * a * a * a);
    const float e = __expf(2.f * z);
    const float th = 1.f - 2.f / (e + 1.f);
    return 0.5f * a * (1.f + th);
}

struct TJob { const float* W; bf16_t* WT; const float* gain; int K, N, mode, pad; };
DEVI int dst_row(int mode, int n) {
    if (mode == 1) return n < 768 ? n : (n < 832 ? 2048 + (n - 768) : n - 64);
    if (mode == 2) { const int h = n >> 8, j = n & 255; return j < 128 ? h * 128 + j : 1024 + h * 128 + (j - 128); }
    return n;
}
DEVI void transpose_item(const TJob& j, int item, float* scr, int lane) {
    const int nblk = j.N / 32, kb = item / nblk, nb = item % nblk, k0 = 64 * kb, n0 = 32 * nb;
#pragma unroll 8
    for (int i = 0; i < 32; ++i) {
        const int kk = 2 * i + (lane >> 5);
        const float g = j.gain ? j.gain[k0 + kk] : 1.f;
        scr[kk * 33 + (lane & 31)] = j.W[(size_t)(k0 + kk) * j.N + n0 + (lane & 31)] * g;
    }
    asm volatile("s_waitcnt lgkmcnt(0)" ::: "memory");
    const int c = lane & 7;
#pragma unroll
    for (int jj = 0; jj < 4; ++jj) {
        const int n = (lane >> 3) + 8 * jj; const float* s = scr + (8 * c) * 33 + n;
        u32x4 o; o.x = pk2(s[0 * 33], s[1 * 33]); o.y = pk2(s[2 * 33], s[3 * 33]); o.z = pk2(s[4 * 33], s[5 * 33]); o.w = pk2(s[6 * 33], s[7 * 33]);
        *(u32x4*)(j.WT + (size_t)dst_row(j.mode, n0 + n) * j.K + k0 + 8 * c) = o;
    }
    asm volatile("s_waitcnt lgkmcnt(0)" ::: "memory");
}
__global__ __launch_bounds__(256) void k_transpose(TJob j) {
    __shared__ float scr_all[4][64 * 33];
    const int lane = threadIdx.x & 63, wave = threadIdx.x >> 6;
    const int nitems = (j.K / 64) * (j.N / 32);
    for (int it = blockIdx.x * 4 + wave; it < nitems; it += gridDim.x * 4) transpose_item(j, it, scr_all[wave], lane);
}
__global__ __launch_bounds__(256) void k_convert(const float* src, bf16_t* dst, size_t n8, const float* gain, int ncols) {
    for (size_t i = (size_t)blockIdx.x * 256 + threadIdx.x; i < n8; i += (size_t)gridDim.x * 256) {
        const f32x4 a = *(const f32x4*)(src + i * 8), b = *(const f32x4*)(src + i * 8 + 4);
        float f[8] = {a.x, a.y, a.z, a.w, b.x, b.y, b.z, b.w};
        if (gain) { const int c = (int)((i * 8) % (size_t)ncols); const f32x4 g0 = *(const f32x4*)(gain + c), g1 = *(const f32x4*)(gain + c + 4);
            f[0] *= g0.x; f[1] *= g0.y; f[2] *= g0.z; f[3] *= g0.w; f[4] *= g1.x; f[5] *= g1.y; f[6] *= g1.z; f[7] *= g1.w; }
        *(u32x4*)(dst + i * 8) = pack8(f);
    }
}
__global__ __launch_bounds__(256) void k_zero(unsigned* p, size_t n) {
    for (size_t i = (size_t)blockIdx.x * 256 + threadIdx.x; i < n; i += (size_t)gridDim.x * 256) p[i] = 0u;
}
DEVI void norm1_row(const float* xrow, const float* g, bf16_t* orow, int lane) {
    f32x4 v[8]; float s = 0.f;
#pragma unroll
    for (int j = 0; j < 8; ++j) { v[j] = *(const f32x4*)(xrow + 4 * (lane + 64 * j)); s += v[j].x * v[j].x + v[j].y * v[j].y + v[j].z * v[j].z + v[j].w * v[j].w; }
    const float r = 1.f / sqrtf(wave_sum(s) * (1.f / DM) + EPS);
#pragma unroll
    for (int j = 0; j < 8; ++j) { const f32x4 gg = *(const f32x4*)(g + 4 * (lane + 64 * j));
        u32x2 o; o.x = pk2(v[j].x * r * gg.x, v[j].y * r * gg.y); o.y = pk2(v[j].z * r * gg.z, v[j].w * r * gg.w);
        *(u32x2*)(orow + 4 * (lane + 64 * j)) = o; }
}
__global__ __launch_bounds__(256) void k_norm1(const float* x, const float* g, bf16_t* n1) {
    const int lane = threadIdx.x & 63, gw = blockIdx.x * 4 + (threadIdx.x >> 6), NGW = gridDim.x * 4;
    for (int t = gw; t < T; t += NGW) norm1_row(x + (size_t)t * DM, g, n1 + (size_t)t * DM, lane);
}

struct EpiBf16Store { bf16_t* C; int ldc; int pad; DEVI void operator()(int r, int c, float v) const { C[(size_t)r * ldc + c] = (bf16_t)f2bf(v); } };
struct EpiResidF32 { const float* X; float* O; int ld; int pad; DEVI void operator()(int r, int c, float v) const { O[(size_t)r * ld + c] = X[(size_t)r * ld + c] + v; } };
template <class Epi>
__global__ __launch_bounds__(256) void k_gemm_naive(const bf16_t* A, int lda, const bf16_t* Bt, int ldb, int K, Epi epi) {
    __shared__ __attribute__((aligned(16))) bf16_t sA[64][40];
    __shared__ __attribute__((aligned(16))) bf16_t sB[64][40];
    const int tid = threadIdx.x, lane = tid & 63, w = tid >> 6, wr = w >> 1, wc = w & 1, fr = lane & 15, fq = lane >> 4;
    const int m0 = blockIdx.y * 64, n0 = blockIdx.x * 64;
    const int lrow = tid >> 2, lch = tid & 3;
    f32x4 acc[2][2];
#pragma unroll
    for (int a = 0; a < 2; ++a)
#pragma unroll
        for (int b = 0; b < 2; ++b) acc[a][b] = (f32x4){0.f, 0.f, 0.f, 0.f};
    for (int k0 = 0; k0 < K; k0 += 32) {
        const u32x4 ga = *(const u32x4*)(A + (size_t)(m0 + lrow) * lda + k0 + lch * 8);
        const u32x4 gb = *(const u32x4*)(Bt + (size_t)(n0 + lrow) * ldb + k0 + lch * 8);
        __syncthreads();
        *(u32x4*)&sA[lrow][lch * 8] = ga; *(u32x4*)&sB[lrow][lch * 8] = gb;
        __syncthreads();
        bf16x8 a[2], b[2];
#pragma unroll
        for (int i = 0; i < 2; ++i) { a[i] = *(const bf16x8*)&sA[wr * 32 + i * 16 + fr][fq * 8]; b[i] = *(const bf16x8*)&sB[wc * 32 + i * 16 + fr][fq * 8]; }
#pragma unroll
        for (int mi = 0; mi < 2; ++mi)
#pragma unroll
            for (int ni = 0; ni < 2; ++ni) acc[mi][ni] = __builtin_amdgcn_mfma_f32_16x16x32_bf16(a[mi], b[ni], acc[mi][ni], 0, 0, 0);
    }
#pragma unroll
    for (int mi = 0; mi < 2; ++mi)
#pragma unroll
        for (int ni = 0; ni < 2; ++ni)
#pragma unroll
            for (int j = 0; j < 4; ++j) epi(m0 + wr * 32 + mi * 16 + fq * 4 + j, n0 + wc * 32 + ni * 16 + fr, acc[mi][ni][j]);
}

DEVI void p2_row(bf16_t* p, const float* sqg, const float* skg, int lane) {
    {
        u32x4 w = *(const u32x4*)(p + C_QLAT + lane * 8); float f[8]; unpack8(w, f); float s = 0.f;
#pragma unroll
        for (int i = 0; i < 8; ++i) s += f[i] * f[i];
        const float r = 1.f / sqrtf(wave_sum(s) * (1.f / 512.f) + EPS);
#pragma unroll
        for (int i = 0; i < 8; ++i) f[i] *= r;
        *(u32x4*)(p + C_QLAT + lane * 8) = pack8(f);
    }
    {
        u32x2 w = *(const u32x2*)(p + C_KVLAT + lane * 4);
        float f0 = __uint_as_float(w.x << 16), f1 = __uint_as_float(w.x & 0xffff0000u), f2 = __uint_as_float(w.y << 16), f3 = __uint_as_float(w.y & 0xffff0000u);
        const float r = 1.f / sqrtf(wave_sum(f0 * f0 + f1 * f1 + f2 * f2 + f3 * f3) * (1.f / 256.f) + EPS);
        u32x2 o; o.x = pk2(f0 * r, f1 * r); o.y = pk2(f2 * r, f3 * r);
        *(u32x2*)(p + C_KVLAT + lane * 4) = o;
    }
    {
        u32x4 w0 = *(const u32x4*)(p + C_SQ + lane * 16), w1 = *(const u32x4*)(p + C_SQ + lane * 16 + 8); float f[16]; unpack8(w0, f); unpack8(w1, f + 8); float s = 0.f;
#pragma unroll
        for (int i = 0; i < 16; ++i) s += f[i] * f[i];
        s += __shfl_xor(s, 1); s += __shfl_xor(s, 2);
        const float r = 0.125f / sqrtf(s * (1.f / 64.f) + EPS);
        const int d0 = (lane & 3) * 16;
#pragma unroll
        for (int i = 0; i < 16; ++i) f[i] *= r * sqg[d0 + i];
        *(u32x4*)(p + C_SQ + lane * 16) = pack8(f); *(u32x4*)(p + C_SQ + lane * 16 + 8) = pack8(f + 8);
    }
    {
        unsigned w = *(const unsigned*)(p + C_SK + lane * 2);
        float f0 = __uint_as_float(w << 16), f1 = __uint_as_float(w & 0xffff0000u);
        float s = f0 * f0 + f1 * f1;
#pragma unroll
        for (int o = 1; o < 32; o <<= 1) s += __shfl_xor(s, o);
        const float r = 1.f / sqrtf(s * (1.f / 64.f) + EPS);
        const int d0 = (lane & 31) * 2;
        *(unsigned*)(p + C_SK + lane * 2) = pk2(f0 * r * skg[d0], f1 * r * skg[d0 + 1]);
    }
}
__global__ __launch_bounds__(256) void k_p2(bf16_t* proj, const float* sqg, const float* skg) {
    const int lane = threadIdx.x & 63, gw = blockIdx.x * 4 + (threadIdx.x >> 6), NGW = gridDim.x * 4;
    for (int t = gw; t < T; t += NGW) p2_row(proj + (size_t)t * PROJ_LD, sqg, skg, lane);
}

DEVI void p3_row(const bf16_t* qraw, const bf16_t* kvrow, const bf16_t* kpe, int pos, const float* qg, const float* kg, bf16_t* Qo, bf16_t* Ko, int lane) {
    const float ang = (float)pos * kInvFreq[lane & 31];
    const double rev = (double)ang * 0.15915494309189535;
    const float fr = (float)(rev - floor(rev));
    const float sn = __builtin_amdgcn_sinf(fr), cs = __builtin_amdgcn_cosf(fr);
    const float qg0 = qg[lane], qg1 = qg[64 + lane], qg2 = qg[128 + lane];
    const float kg0 = kg[lane], kg1 = kg[64 + lane], kg2 = kg[128 + lane];
    const float kp = bf2f(kpe[lane]);
    const float qscale = 0.07216878364870322f * LOG2E;
#pragma unroll 2
    for (int h = 0; h < 8; ++h) {
        {
            const float v0 = bf2f(qraw[h * 192 + lane]), v1 = bf2f(qraw[h * 192 + 64 + lane]), v2 = bf2f(qraw[h * 192 + 128 + lane]);
            const float r = 1.f / sqrtf(wave_sum(v0 * v0 + v1 * v1 + v2 * v2) * (1.f / 192.f) + EPS);
            const float n0 = v0 * r * qg0, n1 = v1 * r * qg1, n2 = v2 * r * qg2;
            const float pr = __shfl_xor(n2, 32);
            const float ro = (lane < 32) ? (n2 * cs - pr * sn) : (n2 * cs + pr * sn);
            Qo[h * 192 + lane] = (bf16_t)f2bf(n0 * qscale); Qo[h * 192 + 64 + lane] = (bf16_t)f2bf(n1 * qscale); Qo[h * 192 + 128 + lane] = (bf16_t)f2bf(ro * qscale);
        }
        {
            const float v0 = bf2f(kvrow[h * 128 + lane]), v1 = bf2f(kvrow[h * 128 + 64 + lane]), v2 = kp;
            const float r = 1.f / sqrtf(wave_sum(v0 * v0 + v1 * v1 + v2 * v2) * (1.f / 192.f) + EPS);
            const float n0 = v0 * r * kg0, n1 = v1 * r * kg1, n2 = v2 * r * kg2;
            const float pr = __shfl_xor(n2, 32);
            const float ro = (lane < 32) ? (n2 * cs - pr * sn) : (n2 * cs + pr * sn);
            Ko[h * 192 + lane] = (bf16_t)f2bf(n0); Ko[h * 192 + 64 + lane] = (bf16_t)f2bf(n1); Ko[h * 192 + 128 + lane] = (bf16_t)f2bf(ro);
        }
    }
}
__global__ __launch_bounds__(256) void k_p3(const bf16_t* qraw, const bf16_t* kv, const bf16_t* proj, const int* pos, const float* qg, const float* kg, bf16_t* Q, bf16_t* K) {
    const int lane = threadIdx.x & 63, gw = blockIdx.x * 4 + (threadIdx.x >> 6), NGW = gridDim.x * 4;
    for (int t = gw; t < T; t += NGW)
        p3_row(qraw + (size_t)t * QK_LD, kv + (size_t)t * KV_LD, proj + (size_t)t * PROJ_LD + C_KPE, pos[t], qg, kg, Q + (size_t)t * QK_LD, K + (size_t)t * QK_LD, lane);
}

__global__ __launch_bounds__(256) void k_mla_naive(const bf16_t* Q, const bf16_t* K, const bf16_t* KV, bf16_t* O) {
    const int lane = threadIdx.x & 63;
    const int row = blockIdx.x * 4 + (threadIdx.x >> 6);
    const int q = row % SEQ, bh = row / SEQ, h = bh % 8, b = bh / 8;
    const size_t t = (size_t)b * SEQ + q;
    const bf16_t* qp = Q + t * QK_LD + h * 192;
    const float q0 = bf2f(qp[lane]), q1 = bf2f(qp[64 + lane]), q2 = bf2f(qp[128 + lane]);
    float m = -INFINITY, l = 0.f, o0 = 0.f, o1 = 0.f;
    const bf16_t* kb = K + (size_t)b * SEQ * QK_LD + h * 192;
    const bf16_t* vb = KV + (size_t)b * SEQ * KV_LD + 1024 + h * 128;
#pragma unroll 4
    for (int j = 0; j <= q; ++j) {
        const bf16_t* kr = kb + (size_t)j * QK_LD; const bf16_t* vr = vb + (size_t)j * KV_LD;
        const float s = wave_sum(q0 * bf2f(kr[lane]) + q1 * bf2f(kr[64 + lane]) + q2 * bf2f(kr[128 + lane]));
        const float v0 = bf2f(vr[lane]), v1 = bf2f(vr[64 + lane]);
        const float mn = fmaxf(m, s), c = exp2f(m - mn), p = exp2f(s - mn);
        l = l * c + p; o0 = o0 * c + p * v0; o1 = o1 * c + p * v1; m = mn;
    }
    const float il = 1.f / l;
    O[t * DM + h * 128 + lane] = (bf16_t)f2bf(o0 * il); O[t * DM + h * 128 + 64 + lane] = (bf16_t)f2bf(o1 * il);
}

DEVI int t5_bucket(int dist) {
    const int n = dist > 0 ? dist : 0;
    if (n < 16) return n;
    const float nf = (float)n;
    int large = 16 + (int)(logf(nf / 16.f) / 2.0794415416798357f * 16.f);
    return large < 31 ? large : 31;
}
__global__ __launch_bounds__(256) void k_swa_naive(const bf16_t* proj, const int* pos, const float* sinks, const float* rel, bf16_t* O) {
    const int lane = threadIdx.x & 63;
    const int row = blockIdx.x * 4 + (threadIdx.x >> 6);
    const int q = row % SEQ, bh = row / SEQ, hh = bh % 16, b = bh / 16, kvh = hh >> 3;
    const size_t t = (size_t)b * SEQ + q;
    const float qv = bf2f(proj[t * PROJ_LD + C_SQ + hh * 64 + lane]);
    const float sink = sinks[hh];
    float m = sink, l = 1.f, o = 0.f;
    const int pq = pos[t];
    const int j0 = q - 127 > 0 ? q - 127 : 0;
#pragma unroll 4
    for (int j = j0; j <= q; ++j) {
        const size_t tk = (size_t)b * SEQ + j;
        const float kx = bf2f(proj[tk * PROJ_LD + C_SK + kvh * 64 + lane]), vx = bf2f(proj[tk * PROJ_LD + C_SV + kvh * 64 + lane]);
        const float s = wave_sum(qv * kx) + rel[t5_bucket(pq - pos[tk]) * 16 + hh];
        const float mn = fmaxf(m, s), c = __expf(m - mn), p = __expf(s - mn);
        l = l * c + p; o = o * c + p * vx; m = mn;
    }
    O[t * DM + 1024 + hh * 64 + lane] = (bf16_t)f2bf(o / l);
}

DEVI void p4_row(bf16_t* p, int lane) {
    float f[4][8]; float sa = 0.f, sb = 0.f;
#pragma unroll
    for (int i = 0; i < 4; ++i) { unpack8(*(const u32x4*)(p + lane * 8 + 512 * i), f[i]);
        float s = 0.f;
#pragma unroll
        for (int e = 0; e < 8; ++e) s += f[i][e] * f[i][e];
        if (i < 2) sa += s; else sb += s; }
    const float ra = 1.f / sqrtf(wave_sum(sa) * (1.f / 1024.f) + EPS), rb = 1.f / sqrtf(wave_sum(sb) * (1.f / 1024.f) + EPS);
#pragma unroll
    for (int i = 0; i < 4; ++i) { const float r = i < 2 ? ra : rb;
#pragma unroll
        for (int e = 0; e < 8; ++e) f[i][e] *= r;
        *(u32x4*)(p + lane * 8 + 512 * i) = pack8(f[i]); }
}
__global__ __launch_bounds__(256) void k_p4(bf16_t* act) {
    const int lane = threadIdx.x & 63, gw = blockIdx.x * 4 + (threadIdx.x >> 6), NGW = gridDim.x * 4;
    for (int t = gw; t < T; t += NGW) p4_row(act + (size_t)t * DM, lane);
}
DEVI void p5_row(const float* hrow, bf16_t* orow, int lane) {
    f32x4 v[8]; float s = 0.f;
#pragma unroll
    for (int j = 0; j < 8; ++j) { v[j] = *(const f32x4*)(hrow + 4 * (lane + 64 * j)); s += v[j].x * v[j].x + v[j].y * v[j].y + v[j].z * v[j].z + v[j].w * v[j].w; }
    const float r = 1.f / sqrtf(wave_sum(s) * (1.f / DM) + EPS);
#pragma unroll
    for (int j = 0; j < 8; ++j) { u32x2 o; o.x = pk2(v[j].x * r, v[j].y * r); o.y = pk2(v[j].z * r, v[j].w * r); *(u32x2*)(orow + 4 * (lane + 64 * j)) = o; }
}
__global__ __launch_bounds__(256) void k_p5(const float* h, bf16_t* hn) {
    const int lane = threadIdx.x & 63, gw = blockIdx.x * 4 + (threadIdx.x >> 6), NGW = gridDim.x * 4;
    for (int t = gw; t < T; t += NGW) p5_row(h + (size_t)t * DM, hn + (size_t)t * DM, lane);
}

__global__ __launch_bounds__(256) void k_topk_naive(const bf16_t* qp, const bf16_t* subk, int* idx, float* gw) {
    const int lane = threadIdx.x & 63;
    const int task = blockIdx.x * 4 + (threadIdx.x >> 6);
    const int h = task & 7; const size_t t = (size_t)(task >> 3);
    float tv[2]; int ti[2];
#pragma unroll
    for (int p = 0; p < 2; ++p) {
        const bf16_t* qs = qp + t * DM + h * 256 + p * 128;
        const float qlo = bf2f(qs[lane]), qhi = bf2f(qs[64 + lane]);
        const bf16_t* k0 = subk + ((size_t)(h * 2 + p) * 128 + lane) * 128; const bf16_t* k1 = k0 + 64 * 128;
        float a0 = 0.f, a1 = 0.f;
        for (int d = 0; d < 64; ++d) { const float qd = __shfl(qlo, d); a0 += qd * bf2f(k0[d]); a1 += qd * bf2f(k1[d]); }
        for (int d = 0; d < 64; ++d) { const float qd = __shfl(qhi, d); a0 += qd * bf2f(k0[64 + d]); a1 += qd * bf2f(k1[64 + d]); }
        float v0 = a0, v1 = a1; float mytv = -INFINITY; int myti = 0;
        for (int r = 0; r < 16; ++r) {
            float bv = v0 >= v1 ? v0 : v1; int bi = v0 >= v1 ? lane : lane + 64;
#pragma unroll
            for (int o = 32; o >= 1; o >>= 1) { const float ov = __shfl_xor(bv, o); const int oi = __shfl_xor(bi, o); if (ov > bv || (ov == bv && oi < bi)) { bv = ov; bi = oi; } }
            if (lane == r) { mytv = bv; myti = bi; }
            if (bi == lane) v0 = -INFINITY; if (bi == lane + 64) v1 = -INFINITY;
        }
        tv[p] = mytv; ti[p] = myti;
    }
    float cv[4];
#pragma unroll
    for (int mm = 0; mm < 4; ++mm) { const int c = lane + 64 * mm; cv[mm] = __shfl(tv[0], c >> 4) + __shfl(tv[1], c & 15); }
    float mys = -INFINITY; int myc = 0;
    for (int r = 0; r < 16; ++r) {
        float bv = cv[0]; int bc = lane;
#pragma unroll
        for (int mm = 1; mm < 4; ++mm) if (cv[mm] > bv) { bv = cv[mm]; bc = lane + 64 * mm; }
#pragma unroll
        for (int o = 32; o >= 1; o >>= 1) { const float ov = __shfl_xor(bv, o); const int oc = __shfl_xor(bc, o); if (ov > bv || (ov == bv && oc < bc)) { bv = ov; bc = oc; } }
        if (lane == r) { mys = bv; myc = bc; }
#pragma unroll
        for (int mm = 0; mm < 4; ++mm) if (bc == lane + 64 * mm) cv[mm] = -INFINITY;
    }
    const int i1 = __shfl(ti[0], (myc >> 4) & 15), i2 = __shfl(ti[1], myc & 15);
    float mx = mys;
#pragma unroll
    for (int o = 8; o >= 1; o >>= 1) mx = fmaxf(mx, __shfl_xor(mx, o));
    const float e = __expf(mys - mx); float sm = e;
#pragma unroll
    for (int o = 8; o >= 1; o >>= 1) sm += __shfl_xor(sm, o);
    if (lane < 16) { idx[t * 128 + h * 16 + lane] = i1 * 128 + i2; gw[t * 128 + h * 16 + lane] = e / sm; }
}

__global__ __launch_bounds__(256) void k_gather_naive(const bf16_t* hn, const bf16_t* Ub, const bf16_t* Vb, const int* idx, const float* gw, float* out) {
    const int lane = threadIdx.x & 63;
    const size_t t = (size_t)blockIdx.x * 4 + (threadIdx.x >> 6);
    float hv[4][8];
#pragma unroll
    for (int i = 0; i < 4; ++i) unpack8(*(const u32x4*)(hn + t * DM + lane * 8 + 512 * i), hv[i]);
    float y[4][8];
#pragma unroll
    for (int i = 0; i < 4; ++i)
#pragma unroll
        for (int e = 0; e < 8; ++e) y[i][e] = 0.f;
    for (int k = 0; k < 128; ++k) {
        const int ex = idx[t * 128 + k]; const float g = gw[t * 128 + k];
        const bf16_t* ur = Ub + (size_t)ex * DM + lane * 8; const bf16_t* vr = Vb + (size_t)ex * DM + lane * 8;
        float d = 0.f;
#pragma unroll
        for (int i = 0; i < 4; ++i) { float f[8]; unpack8(*(const u32x4*)(ur + 512 * i), f);
#pragma unroll
            for (int e = 0; e < 8; ++e) d += f[e] * hv[i][e]; }
        const float a = wave_sum(d);
        const float wgt = g * gelu_tanh(a);
#pragma unroll
        for (int i = 0; i < 4; ++i) { float f[8]; unpack8(*(const u32x4*)(vr + 512 * i), f);
#pragma unroll
            for (int e = 0; e < 8; ++e) y[i][e] += wgt * f[e]; }
    }
#pragma unroll
    for (int i = 0; i < 4; ++i) { float* o = out + t * DM + lane * 8 + 512 * i;
        f32x4 a = *(const f32x4*)o, b = *(const f32x4*)(o + 4);
        a.x += y[i][0]; a.y += y[i][1]; a.z += y[i][2]; a.w += y[i][3]; b.x += y[i][4]; b.y += y[i][5]; b.z += y[i][6]; b.w += y[i][7];
        *(f32x4*)o = a; *(f32x4*)(o + 4) = b; }
}

extern "C" void kernel_launch(void* const* d_in, const int* in_sizes, int n_in, void* d_out, int out_size, void* d_ws, size_t ws_size, hipStream_t stream) {
    if (n_in != 21 || ws_size < WS_END || out_size != T * DM) { fprintf(stderr, "kernel_launch: unexpected problem (n_in %d, ws %zu, out %d)\n", n_in, ws_size, out_size); return; }
    const float* x = (const float*)d_in[0]; const int* pos = (const int*)d_in[1];
    const float* g1 = (const float*)d_in[2]; const float* w_in = (const float*)d_in[3]; const float* qag = (const float*)d_in[4]; const float* wqb = (const float*)d_in[5];
    const float* kvag = (const float*)d_in[6]; const float* wkvb = (const float*)d_in[7]; const float* mqg = (const float*)d_in[8]; const float* mkg = (const float*)d_in[9];
    const float* sqg = (const float*)d_in[10]; const float* skg = (const float*)d_in[11]; const float* sinks = (const float*)d_in[12]; const float* rel = (const float*)d_in[13];
    const float* gog = (const float*)d_in[14]; const float* wout = (const float*)d_in[15]; const float* g2 = (const float*)d_in[16]; const float* wpq = (const float*)d_in[17];
    const float* subk = (const float*)d_in[18]; const float* pu = (const float*)d_in[19]; const float* pv = (const float*)d_in[20];
    float* out = (float*)d_out; unsigned char* ws = (unsigned char*)d_ws;
    bf16_t* W1T = (bf16_t*)(ws + WS_W1T); bf16_t* WQB = (bf16_t*)(ws + WS_WQB); bf16_t* WKVB = (bf16_t*)(ws + WS_WKVB); bf16_t* WOUT = (bf16_t*)(ws + WS_WOUT);
    bf16_t* WPQ = (bf16_t*)(ws + WS_WPQ); bf16_t* SUBK = (bf16_t*)(ws + WS_SUBK); bf16_t* UB = (bf16_t*)(ws + WS_UB); bf16_t* VB = (bf16_t*)(ws + WS_VB);
    bf16_t* PROJ = (bf16_t*)(ws + WS_PROJ); bf16_t* KV = (bf16_t*)(ws + WS_KV); bf16_t* Q = (bf16_t*)(ws + WS_Q); bf16_t* K = (bf16_t*)(ws + WS_K); bf16_t* ACT = (bf16_t*)(ws + WS_ACT);
    bf16_t* QP = PROJ; int* IDX = (int*)(ws + WS_KV); float* GW = (float*)(ws + WS_KV + 8 * MiB);

    k_zero<<<256, 256, 0, stream>>>((unsigned*)(W1T + (size_t)2112 * 2048), (size_t)192 * 2048 / 2);
    k_transpose<<<1024, 256, 0, stream>>>(TJob{w_in, W1T, nullptr, 2048, 2112, 1, 0});
    k_transpose<<<512, 256, 0, stream>>>(TJob{wqb, WQB, qag, 512, 1536, 0, 0});
    k_transpose<<<256, 256, 0, stream>>>(TJob{wkvb, WKVB, kvag, 256, 2048, 2, 0});
    k_transpose<<<1024, 256, 0, stream>>>(TJob{wout, WOUT, gog, 2048, 2048, 0, 0});
    k_transpose<<<1024, 256, 0, stream>>>(TJob{wpq, WPQ, g2, 2048, 2048, 0, 0});
    k_convert<<<256, 256, 0, stream>>>(subk, SUBK, (size_t)8 * 2 * 128 * 128 / 8, nullptr, 128);
    k_convert<<<2048, 256, 0, stream>>>(pu, UB, (size_t)16384 * 2048 / 8, g2, 2048);
    k_convert<<<2048, 256, 0, stream>>>(pv, VB, (size_t)16384 * 2048 / 8, nullptr, 2048);
    k_norm1<<<2048, 256, 0, stream>>>(x, g1, ACT);
    k_gemm_naive<EpiBf16Store><<<dim3(PROJ_LD / 64, T / 64), 256, 0, stream>>>(ACT, DM, W1T, DM, DM, EpiBf16Store{PROJ, PROJ_LD, 0});
    k_p2<<<2048, 256, 0, stream>>>(PROJ, sqg, skg);
    k_gemm_naive<EpiBf16Store><<<dim3(1536 / 64, T / 64), 256, 0, stream>>>(PROJ + C_QLAT, PROJ_LD, WQB, 512, 512, EpiBf16Store{ACT, QK_LD, 0});
    k_gemm_naive<EpiBf16Store><<<dim3(2048 / 64, T / 64), 256, 0, stream>>>(PROJ + C_KVLAT, PROJ_LD, WKVB, 256, 256, EpiBf16Store{KV, KV_LD, 0});
    k_p3<<<2048, 256, 0, stream>>>(ACT, KV, PROJ, pos, mqg, mkg, Q, K);
    k_mla_naive<<<BATCH * 8 * SEQ / 4, 256, 0, stream>>>(Q, K, KV, ACT);
    k_swa_naive<<<BATCH * 16 * SEQ / 4, 256, 0, stream>>>(PROJ, pos, sinks, rel, ACT);
    k_p4<<<2048, 256, 0, stream>>>(ACT);
    k_gemm_naive<EpiResidF32><<<dim3(DM / 64, T / 64), 256, 0, stream>>>(ACT, DM, WOUT, DM, DM, EpiResidF32{x, out, DM, 0});
    k_p5<<<2048, 256, 0, stream>>>(out, ACT);
    k_gemm_naive<EpiBf16Store><<<dim3(DM / 64, T / 64), 256, 0, stream>>>(ACT, DM, WPQ, DM, DM, EpiBf16Store{QP, DM, 0});
    k_topk_naive<<<T * 8 / 4, 256, 0, stream>>>(QP, SUBK, IDX, GW);
    k_gather_naive<<<T / 4, 256, 0, stream>>>(ACT, UB, VB, IDX, GW, out);
}
```

```cpp
#include <hip/hip_runtime.h>
#include <stdint.h>
#include <stdio.h>

#define DEVI __device__ __forceinline__
#define LAS __attribute__((address_space(3)))
typedef unsigned short bf16_t;
typedef short bf16x8 __attribute__((ext_vector_type(8)));
typedef float f32x4 __attribute__((ext_vector_type(4)));
typedef unsigned u32x4 __attribute__((ext_vector_type(4)));
typedef unsigned u32x2 __attribute__((ext_vector_type(2)));
typedef int i32x4 __attribute__((ext_vector_type(4)));

constexpr int BATCH = 4, SEQ = 4096, DM = 2048, T = BATCH * SEQ;
constexpr int PROJ_LD = 2304;
constexpr int C_QLAT = 0, C_KVLAT = 512, C_SQ = 768, C_SK = 1792, C_SV = 1920, C_KPE = 2048;
constexpr int QK_LD = 1536;
constexpr int KV_LD = 2048;
constexpr float EPS = 1e-6f;
constexpr float LOG2E = 1.4426950408889634f;
constexpr int NWAVES = 8, NTHREADS = 512;

constexpr size_t MiB = 1u << 20;
constexpr size_t WS_CTL = 0, CTL_ZERO_BYTES = 128 * 1024;
constexpr size_t WS_W1T = 2 * MiB;
constexpr size_t WS_WQB = 11 * MiB;
constexpr size_t WS_WKVB = 13 * MiB;
constexpr size_t WS_WOUT = 14 * MiB;
constexpr size_t WS_WPQ = 22 * MiB;
constexpr size_t WS_SUBK = 30 * MiB;
constexpr size_t WS_UB = 32 * MiB;
constexpr size_t WS_VB = 96 * MiB;
constexpr size_t WS_PROJ = 160 * MiB;
constexpr size_t WS_KV = 232 * MiB;
constexpr size_t WS_Q = 296 * MiB;
constexpr size_t WS_K = 344 * MiB;
constexpr size_t WS_ACT = 392 * MiB;
constexpr size_t WS_END = 456 * MiB;

constexpr int RING_BYTES = 131072;
constexpr int MISC_OFF = RING_BYTES + 320;
constexpr int LDS_BYTES = 147456;

__device__ const float kInvFreq[32] = {
    1.000000000e+00f, 7.498942018e-01f, 5.623413324e-01f, 4.216965139e-01f, 3.162277639e-01f, 2.371373773e-01f, 1.778279394e-01f, 1.333521456e-01f,
    1.000000015e-01f, 7.498942316e-02f, 5.623413250e-02f, 4.216964915e-02f, 3.162277490e-02f, 2.371373773e-02f, 1.778279431e-02f, 1.333521400e-02f,
    9.999999776e-03f, 7.498942316e-03f, 5.623413250e-03f, 4.216964822e-03f, 3.162277630e-03f, 2.371373819e-03f, 1.778279431e-03f, 1.333521446e-03f,
    1.000000047e-03f, 7.498941850e-04f, 5.623413017e-04f, 4.216965172e-04f, 3.162277571e-04f, 2.371373703e-04f, 1.778279402e-04f, 1.333521504e-04f};

DEVI float bf2f(unsigned h) { return __uint_as_float((h & 0xffffu) << 16); }
typedef float f32x2_t __attribute__((ext_vector_type(2)));
typedef __bf16 bf16x2_t __attribute__((ext_vector_type(2)));
DEVI unsigned pk2(float lo, float hi) { const f32x2_t v = {lo, hi}; const bf16x2_t b = __builtin_convertvector(v, bf16x2_t); return __builtin_bit_cast(unsigned, b); }
DEVI unsigned f2bf(float f) { return pk2(f, 0.f) & 0xffffu; }
DEVI float wave_sum(float v) {
#pragma unroll
    for (int o = 1; o < 64; o <<= 1) v += __shfl_xor(v, o);
    return v;
}
DEVI void unpack8(const u32x4 w, float* f) {
    f[0] = __uint_as_float(w.x << 16); f[1] = __uint_as_float(w.x & 0xffff0000u);
    f[2] = __uint_as_float(w.y << 16); f[3] = __uint_as_float(w.y & 0xffff0000u);
    f[4] = __uint_as_float(w.z << 16); f[5] = __uint_as_float(w.z & 0xffff0000u);
    f[6] = __uint_as_float(w.w << 16); f[7] = __uint_as_float(w.w & 0xffff0000u);
}
DEVI u32x4 pack8(const float* f) { u32x4 w; w.x = pk2(f[0], f[1]); w.y = pk2(f[2], f[3]); w.z = pk2(f[4], f[5]); w.w = pk2(f[6], f[7]); return w; }
DEVI float gelu_tanh(float a) {
    const float z = 0.7978845608028654f * (a + 0.044715f * a * a * a);
    const float e = __expf(2.f * z);
    const float th = 1.f - 2.f / (e + 1.f);
    return 0.5f * a * (1.f + th);
}

namespace pg8 {
constexpr int BM = 256, BK = 64, HALF = 128, HTB = HALF * BK * 2, STAGE_BYTES = 8 * HTB, NXCD = 8, WGM = 8;
DEVI int lds_byte(int r, int c) { const int st = (r >> 4) * 2 + (c >> 5), rr = r & 15, cc = c & 31, ob = rr * 64 + cc * 2; return st * 1024 + (ob ^ (((ob >> 9) & 1) << 5)); }
DEVI void stage_rc(int b, int& R, int& C) { const int st = b / 1024, sb = b % 1024, swz = sb ^ (((sb >> 9) & 1) << 5); R = (st >> 1) * 16 + swz / 64; C = (st & 1) * 32 + (swz % 64) / 2; }
DEVI int perm32(int rho) { const int n = rho >> 4, i = rho & 15; return 8 * (i >> 2) + 4 * n + (i & 3); }
struct Unit { int pm, pn; };
struct Gemm { const bf16_t* A; const bf16_t* Bt; int M, N, K, lda, ldb; };
struct StaticOrder {
    int nM, nN, nwg, G, c;
    DEVI void init(int M, int N, int G_, int c_) { nM = M / BM; nN = N / BM; nwg = nM * nN; G = G_; c = c_; }
    DEVI bool next(int i, Unit& u) const {
        const long L = (long)i * G + c; if (L >= nwg) return false;
        int wgid = (int)L; { const int q = nwg / NXCD, r = nwg % NXCD, xcd = wgid % NXCD, off = wgid / NXCD; wgid = (xcd < r ? xcd * (q + 1) : r * (q + 1) + (xcd - r) * q) + off; }
        const int nig = WGM * nN, gid = wgid / nig, fm = gid * WGM, gsz = (nM - fm) < WGM ? (nM - fm) : WGM;
        u.pm = fm + ((wgid % nig) % gsz); u.pn = (wgid % nig) / gsz; return true;
    }
};
DEVI unsigned cvt_pk_bf16(float lo, float hi) { unsigned r; asm volatile("v_cvt_pk_bf16_f32 %0, %1, %2" : "=v"(r) : "v"(lo), "v"(hi)); return r; }
struct EpiBf16 {
    static constexpr bool PERM = true;
    bf16_t* O; int ldc;
    const float* ssq; float inv_n;
    const float* part; int pbase, pcnt;
    float* part_out; int pn_lim;
    DEVI void operator()(const f32x4 (&acc)[2][2][4][2], const Unit& u, int wr, int wc, int fr, int fq) const {
        const int row0 = u.pm * BM + wr * 64 + fr, col0 = u.pn * BM + wc * 32 + 8 * fq;
        const bool wr_part = part_out && u.pn < pn_lim;
#pragma unroll
        for (int ai = 0; ai < 2; ++ai)
#pragma unroll
            for (int m = 0; m < 4; ++m) { const int row = row0 + ai * HALF + m * 16; bf16_t* rowp = O + (size_t)row * ldc + col0;
                float rs = 1.f;
                if (ssq) rs = 1.f / sqrtf(ssq[row] * inv_n + EPS);
                else if (part) { float sq = 0.f; for (int j = 0; j < pcnt; ++j) sq += part[(size_t)row * 12 + pbase + j]; rs = 1.f / sqrtf(sq * inv_n + EPS); }
                float ss = 0.f;
#pragma unroll
                for (int bj = 0; bj < 2; ++bj) { const f32x4 v0 = acc[ai][bj][m][0] * rs, v1 = acc[ai][bj][m][1] * rs;
                    u32x4 w; w.x = cvt_pk_bf16(v0[0], v0[1]); w.y = cvt_pk_bf16(v0[2], v0[3]); w.z = cvt_pk_bf16(v1[0], v1[1]); w.w = cvt_pk_bf16(v1[2], v1[3]);
                    *(u32x4*)(rowp + bj * HALF) = w;
                    ss += v0[0] * v0[0] + v0[1] * v0[1] + v0[2] * v0[2] + v0[3] * v0[3] + v1[0] * v1[0] + v1[1] * v1[1] + v1[2] * v1[2] + v1[3] * v1[3]; }
                if (wr_part) { ss += __shfl_xor(ss, 16); ss += __shfl_xor(ss, 32); if (fq == 0) part_out[(size_t)row * 12 + 4 * u.pn + wc] = ss; } }
    }
};
struct EpiQp {
    static constexpr bool PERM = true;
    bf16_t* O; const float* ssq; float inv_n;
    DEVI void operator()(const f32x4 (&acc)[2][2][4][2], const Unit& u, int wr, int wc, int fr, int fq) const {
        const int row0 = u.pm * BM + wr * 64 + fr;
#pragma unroll
        for (int ai = 0; ai < 2; ++ai)
#pragma unroll
            for (int m = 0; m < 4; ++m) { const int row = row0 + ai * HALF + m * 16;
                const float rs = 1.f / sqrtf(ssq[row] * inv_n + EPS);
#pragma unroll
                for (int bj = 0; bj < 2; ++bj) { const f32x4 v0 = acc[ai][bj][m][0] * rs, v1 = acc[ai][bj][m][1] * rs;
                    u32x4 w; w.x = cvt_pk_bf16(v0[0], v0[1]); w.y = cvt_pk_bf16(v0[2], v0[3]); w.z = cvt_pk_bf16(v1[0], v1[1]); w.w = cvt_pk_bf16(v1[2], v1[3]);
                    *(u32x4*)(O + ((((size_t)(row >> 5) * 8 + u.pn) * 2 + bj) * 16 + 4 * wc + fq) * 256 + (row & 31) * 8) = w; } }
    }
};
struct EpiResid {
    static constexpr bool PERM = true;
    const float* X; float* O; bf16_t* HB; float* ssq; int ldc;
    DEVI void operator()(const f32x4 (&acc)[2][2][4][2], const Unit& u, int wr, int wc, int fr, int fq) const {
        const int row0 = u.pm * BM + wr * 64 + fr, col0 = u.pn * BM + wc * 32 + 8 * fq;
#pragma unroll
        for (int ai = 0; ai < 2; ++ai)
#pragma unroll
            for (int m = 0; m < 4; ++m) { const int row = row0 + ai * HALF + m * 16; const size_t off = (size_t)row * ldc + col0;
                float ss = 0.f;
#pragma unroll
                for (int bj = 0; bj < 2; ++bj) {
                    const f32x4 h0 = *(const f32x4*)(X + off + bj * HALF) + acc[ai][bj][m][0], h1 = *(const f32x4*)(X + off + bj * HALF + 4) + acc[ai][bj][m][1];
                    u32x4 w; w.x = cvt_pk_bf16(h0[0], h0[1]); w.y = cvt_pk_bf16(h0[2], h0[3]); w.z = cvt_pk_bf16(h1[0], h1[1]); w.w = cvt_pk_bf16(h1[2], h1[3]);
                    *(u32x4*)(HB + off + bj * HALF) = w;
                    ss += h0[0] * h0[0] + h0[1] * h0[1] + h0[2] * h0[2] + h0[3] * h0[3] + h1[0] * h1[0] + h1[1] * h1[1] + h1[2] * h1[2] + h1[3] * h1[3]; }
                ss += __shfl_xor(ss, 16); ss += __shfl_xor(ss, 32);
                if (fq == 0) atomicAdd(ssq + row, ss); }
    }
};

template <class Epi, class Sched, bool ALIGN_EPI>
DEVI void gemm_phase(LAS unsigned char* lds, const Gemm g, const Sched& S, const Epi& E) {
    const int tid = threadIdx.x, wid = __builtin_amdgcn_readfirstlane(tid >> 6), lane = tid & 63, wr = wid >> 2, wc = wid & 3, fr = lane & 15, fq = lane >> 4;
    const int K = g.K, nt = K / BK;
    unsigned voffA[2], voffB[2];
#pragma unroll
    for (int i = 0; i < 2; ++i) { int R, C; stage_rc(tid * 16 + i * 8192, R, C); const int Rb = Epi::PERM ? ((R & ~31) + perm32(R & 31)) : R;
        voffA[i] = (unsigned)(R * g.lda + C) * 2u; voffB[i] = (unsigned)(Rb * g.ldb + C) * 2u; }
    const size_t kstep = (size_t)(BK * 2);
    const size_t hA = (size_t)HALF * g.lda * 2, hB = (size_t)HALF * g.ldb * 2, tA = 2 * hA, tB = 2 * hB;
    const unsigned ldsw = (unsigned)wid * 1024u;
    const int aoff = lds_byte(wr * 64 + fr, fq * 8), boff = lds_byte(wc * 32 + fr, fq * 8);
#define PG8_SA(b, h) (((b) * 2 + (h)) * HTB)
#define PG8_SB(b, h) ((4 + (b) * 2 + (h)) * HTB)
#define PG8_STAGE(bufoff, gbase, voff) do { _Pragma("unroll") for (int _i = 0; _i < 2; ++_i) \
        __builtin_amdgcn_global_load_lds((const unsigned*)((const char*)(gbase) + (voff)[_i]), (LAS unsigned*)(lds + (bufoff) + ldsw + _i * 8192), 16, 0, 0); } while (0)
#define PG8_LDA(dst, b, h) do { _Pragma("unroll") for (int m = 0; m < 4; ++m) _Pragma("unroll") for (int k = 0; k < 2; ++k) dst[m][k] = *(const LAS bf16x8*)(lds + PG8_SA(b, h) + aoff + m * 2048 + k * 1024); } while (0)
#define PG8_LDB(dst, b, h) do { _Pragma("unroll") for (int n = 0; n < 2; ++n) _Pragma("unroll") for (int k = 0; k < 2; ++k) dst[n][k] = *(const LAS bf16x8*)(lds + PG8_SB(b, h) + boff + n * 2048 + k * 1024); } while (0)
#define PG8_MMA(ai, bj, At, Bt) do { __builtin_amdgcn_s_setprio(1); _Pragma("unroll") for (int m = 0; m < 4; ++m) _Pragma("unroll") for (int n = 0; n < 2; ++n) _Pragma("unroll") for (int k = 0; k < 2; ++k) \
        acc[ai][bj][m][n] = __builtin_amdgcn_mfma_f32_16x16x32_bf16(Bt[n][k], At[m][k], acc[ai][bj][m][n], 0, 0, 0); __builtin_amdgcn_s_setprio(0); } while (0)
#define PG8_WAIT_V(n) asm volatile("s_waitcnt vmcnt(" #n ")" ::: "memory")
#define PG8_WAIT_L(n) asm volatile("s_waitcnt lgkmcnt(" #n ")" ::: "memory")
#define PG8_BAR __builtin_amdgcn_s_barrier()
#define PG8_SCHED __builtin_amdgcn_sched_barrier(0)
    Unit cur, nxt; int ui = 0;
    if (!S.next(0, cur)) return;
    f32x4 acc[2][2][4][2];
#pragma unroll
    for (int a = 0; a < 2; ++a)
#pragma unroll
        for (int b = 0; b < 2; ++b)
#pragma unroll
            for (int m = 0; m < 4; ++m)
#pragma unroll
                for (int n = 0; n < 2; ++n) acc[a][b][m][n] = (f32x4){0.f, 0.f, 0.f, 0.f};
    bf16x8 At[4][2], B0[2][2], B1[2][2];
    const char* cA = (const char*)g.A + (size_t)cur.pm * tA; const char* cB = (const char*)g.Bt + (size_t)cur.pn * tB;
    PG8_STAGE(PG8_SB(0, 0), cB, voffB); PG8_STAGE(PG8_SB(0, 1), cB + hB, voffB); PG8_STAGE(PG8_SA(0, 0), cA, voffA); PG8_STAGE(PG8_SA(0, 1), cA + hA, voffA);
    if (wr == 1) PG8_BAR;
    PG8_WAIT_V(2); PG8_BAR;
    PG8_STAGE(PG8_SB(1, 0), cB + kstep, voffB); PG8_STAGE(PG8_SA(1, 0), cA + kstep, voffA); PG8_STAGE(PG8_SB(1, 1), cB + hB + kstep, voffB);
    PG8_WAIT_V(6); PG8_BAR;
    for (;;) {
        const bool has_next = S.next(ui + 1, nxt);
        const char* nA = has_next ? (const char*)g.A + (size_t)nxt.pm * tA : cA; const char* nB = has_next ? (const char*)g.Bt + (size_t)nxt.pn * tB : cB;
        for (int t = 0; t < nt; t += 2) {
            const bool last = (t == nt - 2);
            const char* a1 = cA + (size_t)(t + 1) * kstep;
            const char* a2 = last ? nA : cA + (size_t)(t + 2) * kstep; const char* b2 = last ? nB : cB + (size_t)(t + 2) * kstep;
            const char* a3 = a2 + kstep; const char* b3 = b2 + kstep;
            PG8_LDB(B0, 0, 0); PG8_LDB(B1, 0, 1); PG8_SCHED; PG8_LDA(At, 0, 0); PG8_STAGE(PG8_SA(1, 1), a1 + hA, voffA);
            PG8_WAIT_V(8); PG8_WAIT_L(0); PG8_BAR; PG8_MMA(0, 0, At, B0); PG8_MMA(0, 1, At, B1); PG8_BAR; PG8_SCHED;
            PG8_LDA(At, 0, 1); PG8_STAGE(PG8_SB(0, 0), b2, voffB); PG8_STAGE(PG8_SB(0, 1), b2 + hB, voffB); PG8_STAGE(PG8_SA(0, 0), a2, voffA);
            PG8_WAIT_V(8); PG8_WAIT_L(0); PG8_BAR; PG8_MMA(1, 0, At, B0); PG8_MMA(1, 1, At, B1); PG8_BAR; PG8_SCHED;
            PG8_LDB(B0, 1, 0); PG8_LDB(B1, 1, 1); PG8_SCHED; PG8_LDA(At, 1, 0); PG8_STAGE(PG8_SA(0, 1), a2 + hA, voffA);
            PG8_WAIT_V(8); PG8_WAIT_L(0); PG8_BAR; PG8_MMA(0, 0, At, B0); PG8_MMA(0, 1, At, B1); PG8_BAR; PG8_SCHED;
            PG8_LDA(At, 1, 1); PG8_STAGE(PG8_SB(1, 0), b3, voffB); PG8_STAGE(PG8_SB(1, 1), b3 + hB, voffB); PG8_STAGE(PG8_SA(1, 0), a3, voffA);
            PG8_WAIT_V(8); PG8_WAIT_L(0); PG8_BAR; PG8_MMA(1, 0, At, B0); PG8_MMA(1, 1, At, B1); PG8_BAR; PG8_SCHED;
        }
        if constexpr (ALIGN_EPI) { if (wr == 0) PG8_BAR; }
        E(acc, cur, wr, wc, fr, fq);
        if (!has_next) break;
#pragma unroll
        for (int a = 0; a < 2; ++a)
#pragma unroll
            for (int b = 0; b < 2; ++b)
#pragma unroll
                for (int m = 0; m < 4; ++m)
#pragma unroll
                    for (int n = 0; n < 2; ++n) acc[a][b][m][n] = (f32x4){0.f, 0.f, 0.f, 0.f};
        cur = nxt; cA = nA; cB = nB; ++ui;
        if constexpr (ALIGN_EPI) { if (wr == 1) PG8_BAR; }
    }
    PG8_WAIT_V(0);
    if constexpr (!ALIGN_EPI) { if (wr == 0) PG8_BAR; }
    PG8_BAR;
#undef PG8_SA
#undef PG8_SB
#undef PG8_STAGE
#undef PG8_LDA
#undef PG8_LDB
#undef PG8_MMA
#undef PG8_WAIT_V
#undef PG8_WAIT_L
#undef PG8_BAR
#undef PG8_SCHED
}
}

#define XB_TMO      128
#define XB_XCNT(j)  (256  + 64 * (j))
#define XB_XSUB(j)  (1280 + 64 * (j))
#define XB_XGEN(j)  (2304 + 64 * (j))
#define XB_TOP      3328
#define XB_TOPGEN   3392
#define XCD_BAR_WORDS 3456
#define XB_SPIN_CAP (1u << 18)
DEVI unsigned xb_ld(unsigned* p)              { return __hip_atomic_load(p, __ATOMIC_RELAXED, __HIP_MEMORY_SCOPE_AGENT); }
DEVI unsigned xb_add(unsigned* p, unsigned v) { return __hip_atomic_fetch_add(p, v, __ATOMIC_RELAXED, __HIP_MEMORY_SCOPE_AGENT); }
DEVI unsigned xb_xcc_id() { return (unsigned)__builtin_amdgcn_s_getreg((3 << 11) | 20) & 0xFu; }
#define XB_SPIN(cond, bar) do { unsigned _sp = 0; while (cond) { __builtin_amdgcn_s_sleep(1); \
    if ((++_sp & 255u) == 0u) { if (xb_ld(&(bar)[XB_TMO])) break; if (_sp > XB_SPIN_CAP) { atomicAdd(&(bar)[XB_TMO], 1u); break; } } } } while (0)
struct XcdBarrier { unsigned* bar; unsigned x; volatile LAS unsigned* st; };
DEVI XcdBarrier xcd_barrier_post(unsigned* bar, volatile LAS unsigned* st) {
    XcdBarrier b; b.bar = bar; b.x = xb_xcc_id(); b.st = st;
    if (threadIdx.x == 0) (void)xb_add(&bar[XB_XCNT(b.x)], 1u);
    return b;
}
DEVI void xcd_barrier_complete(unsigned* bar, unsigned x, unsigned& nloc, unsigned& nx) {
    const unsigned G = gridDim.x * gridDim.y * gridDim.z;
    unsigned sum, cnt, mine, sp = 0u;
    for (;;) {
        sum = 0u; cnt = 0u; mine = 0u;
#pragma unroll
        for (unsigned j = 0; j < 16; ++j) { const unsigned c = xb_ld(&bar[XB_XCNT(j)]); sum += c; cnt += (c > 0u) ? 1u : 0u; mine = (j == x) ? c : mine; }
        if (sum == G) break;
        __builtin_amdgcn_s_sleep(1);
        if ((++sp & 255u) == 0u) { if (xb_ld(&bar[XB_TMO])) break; if (sp > XB_SPIN_CAP) { atomicAdd(&bar[XB_TMO], 1u); break; } }
    }
    nloc = mine > 0u ? mine : 1u; nx = cnt > 0u ? cnt : 1u;
}
DEVI void xcd_barrier(const XcdBarrier& b) {
    asm volatile("s_waitcnt vmcnt(0)" ::: "memory");
    __syncthreads();
    if (threadIdx.x == 0) {
        unsigned* bar = b.bar;
        __builtin_amdgcn_s_waitcnt(0);
        unsigned nloc = b.st[0], nx = b.st[1];
        if (nloc == 0u) { xcd_barrier_complete(bar, b.x, nloc, nx); b.st[0] = nloc; b.st[1] = nx; }
        const unsigned old = xb_add(&bar[XB_XSUB(b.x)], 1u);
        const unsigned gen = old / nloc;
        if (old + 1u == (gen + 1u) * nloc) {
            __builtin_amdgcn_fence(__ATOMIC_RELEASE, "agent");
            asm volatile("s_waitcnt vmcnt(0)" ::: "memory");
            const unsigned og = xb_add(&bar[XB_TOP], 1u);
            const unsigned tg = og / nx;
            if (og + 1u == (tg + 1u) * nx) xb_add(&bar[XB_TOPGEN], 1u);
            else XB_SPIN(xb_ld(&bar[XB_TOPGEN]) == tg, bar);
            __builtin_amdgcn_fence(__ATOMIC_ACQUIRE, "agent");
            xb_add(&bar[XB_XGEN(b.x)], 1u);
            asm volatile("s_waitcnt vmcnt(0)" ::: "memory");
        } else {
            XB_SPIN(xb_ld(&bar[XB_XGEN(b.x)]) == gen, bar);
            __builtin_amdgcn_fence(__ATOMIC_ACQUIRE, "agent");
            asm volatile("s_waitcnt vmcnt(0)" ::: "memory");
        }
    }
    __syncthreads();
}

struct TJob { const float* W; bf16_t* WT; const float* gain; int K, N, mode, pad; };
DEVI int dst_row(int mode, int n) {
    if (mode == 1) return n < 768 ? n : (n < 832 ? 2048 + (n - 768) : n - 64);
    if (mode == 2) { const int h = n >> 8, j = n & 255; return j < 128 ? h * 128 + j : 1024 + h * 128 + (j - 128); }
    return n;
}
DEVI void transpose_item(const float* W, bf16_t* WT, const float* gain, int K, int N, int mode, int item, LAS float* scr, int lane) {
    const int nblk = N / 32, kb = item / nblk, nb = item % nblk, k0 = 64 * kb, n0 = 32 * nb;
#pragma unroll 8
    for (int i = 0; i < 32; ++i) {
        const int kk = 2 * i + (lane >> 5);
        const float g = gain ? gain[k0 + kk] : 1.f;
        scr[kk * 33 + (lane & 31)] = W[(size_t)(k0 + kk) * N + n0 + (lane & 31)] * g;
    }
    asm volatile("s_waitcnt lgkmcnt(0)" ::: "memory");
    const int c = lane & 7;
#pragma unroll
    for (int jj = 0; jj < 4; ++jj) {
        const int n = (lane >> 3) + 8 * jj; const LAS float* s = scr + (8 * c) * 33 + n;
        u32x4 o; o.x = pk2(s[0 * 33], s[1 * 33]); o.y = pk2(s[2 * 33], s[3 * 33]); o.z = pk2(s[4 * 33], s[5 * 33]); o.w = pk2(s[6 * 33], s[7 * 33]);
        *(u32x4*)(WT + (size_t)dst_row(mode, n0 + n) * K + k0 + 8 * c) = o;
    }
    asm volatile("s_waitcnt lgkmcnt(0)" ::: "memory");
}
DEVI void convert_range(const float* src, bf16_t* dst, size_t n8, const float* gain, int ncols, size_t gtid, size_t nthr) {
    for (size_t i = gtid; i < n8; i += nthr) {
        const f32x4 a = *(const f32x4*)(src + i * 8), b = *(const f32x4*)(src + i * 8 + 4);
        float f[8] = {a.x, a.y, a.z, a.w, b.x, b.y, b.z, b.w};
        if (gain) { const int c = (int)((i * 8) % (size_t)ncols); const f32x4 g0 = *(const f32x4*)(gain + c), g1 = *(const f32x4*)(gain + c + 4);
            f[0] *= g0.x; f[1] *= g0.y; f[2] *= g0.z; f[3] *= g0.w; f[4] *= g1.x; f[5] *= g1.y; f[6] *= g1.z; f[7] *= g1.w; }
        *(u32x4*)(dst + i * 8) = pack8(f);
    }
}
DEVI void norm1_regs(const f32x4 (&v)[8], const float* g, bf16_t* orow, int lane) {
    float s = 0.f;
#pragma unroll
    for (int j = 0; j < 8; ++j) s += v[j].x * v[j].x + v[j].y * v[j].y + v[j].z * v[j].z + v[j].w * v[j].w;
    const float r = 1.f / sqrtf(wave_sum(s) * (1.f / DM) + EPS);
#pragma unroll
    for (int j = 0; j < 8; ++j) { const f32x4 gg = *(const f32x4*)(g + 4 * (lane + 64 * j));
        u32x2 o; o.x = pk2(v[j].x * r * gg.x, v[j].y * r * gg.y); o.y = pk2(v[j].z * r * gg.z, v[j].w * r * gg.w);
        *(u32x2*)(orow + 4 * (lane + 64 * j)) = o; }
}
DEVI void norm1_row(const float* xrow, const float* g, bf16_t* orow, int lane) {
    f32x4 v[8]; float s = 0.f;
#pragma unroll
    for (int j = 0; j < 8; ++j) { v[j] = *(const f32x4*)(xrow + 4 * (lane + 64 * j)); s += v[j].x * v[j].x + v[j].y * v[j].y + v[j].z * v[j].z + v[j].w * v[j].w; }
    const float r = 1.f / sqrtf(wave_sum(s) * (1.f / DM) + EPS);
#pragma unroll
    for (int j = 0; j < 8; ++j) { const f32x4 gg = *(const f32x4*)(g + 4 * (lane + 64 * j));
        u32x2 o; o.x = pk2(v[j].x * r * gg.x, v[j].y * r * gg.y); o.y = pk2(v[j].z * r * gg.z, v[j].w * r * gg.w);
        *(u32x2*)(orow + 4 * (lane + 64 * j)) = o; }
}
DEVI void p2_row(bf16_t* p, const float* sqg, const float* skg, int lane) {
    {
        u32x4 w = *(const u32x4*)(p + C_QLAT + lane * 8); float f[8]; unpack8(w, f); float s = 0.f;
#pragma unroll
        for (int i = 0; i < 8; ++i) s += f[i] * f[i];
        const float r = 1.f / sqrtf(wave_sum(s) * (1.f / 512.f) + EPS);
#pragma unroll
        for (int i = 0; i < 8; ++i) f[i] *= r;
        *(u32x4*)(p + C_QLAT + lane * 8) = pack8(f);
    }
    {
        u32x2 w = *(const u32x2*)(p + C_KVLAT + lane * 4);
        float f0 = __uint_as_float(w.x << 16), f1 = __uint_as_float(w.x & 0xffff0000u), f2 = __uint_as_float(w.y << 16), f3 = __uint_as_float(w.y & 0xffff0000u);
        const float r = 1.f / sqrtf(wave_sum(f0 * f0 + f1 * f1 + f2 * f2 + f3 * f3) * (1.f / 256.f) + EPS);
        u32x2 o; o.x = pk2(f0 * r, f1 * r); o.y = pk2(f2 * r, f3 * r);
        *(u32x2*)(p + C_KVLAT + lane * 4) = o;
    }
    {
        u32x4 w0 = *(const u32x4*)(p + C_SQ + lane * 16), w1 = *(const u32x4*)(p + C_SQ + lane * 16 + 8); float f[16]; unpack8(w0, f); unpack8(w1, f + 8); float s = 0.f;
#pragma unroll
        for (int i = 0; i < 16; ++i) s += f[i] * f[i];
        s += __shfl_xor(s, 1); s += __shfl_xor(s, 2);
        const float r = 0.125f / sqrtf(s * (1.f / 64.f) + EPS);
        const int d0 = (lane & 3) * 16;
#pragma unroll
        for (int i = 0; i < 16; ++i) f[i] *= r * sqg[d0 + i];
        *(u32x4*)(p + C_SQ + lane * 16) = pack8(f); *(u32x4*)(p + C_SQ + lane * 16 + 8) = pack8(f + 8);
    }
    {
        unsigned w = *(const unsigned*)(p + C_SK + lane * 2);
        float f0 = __uint_as_float(w << 16), f1 = __uint_as_float(w & 0xffff0000u);
        float s = f0 * f0 + f1 * f1;
#pragma unroll
        for (int o = 1; o < 32; o <<= 1) s += __shfl_xor(s, o);
        const float r = 1.f / sqrtf(s * (1.f / 64.f) + EPS);
        const int d0 = (lane & 31) * 2;
        *(unsigned*)(p + C_SK + lane * 2) = pk2(f0 * r * skg[d0], f1 * r * skg[d0 + 1]);
    }
}
DEVI void p3_row(const bf16_t* qraw, const bf16_t* kvrow, const bf16_t* kpe, int pos, const float* qg, const float* kg, bf16_t* Qo, bf16_t* Ko, int lane) {
    const int hd = lane >> 3, sub = lane & 7;
    float cs[8], sn[8];
#pragma unroll
    for (int e = 0; e < 8; ++e) {
        const float ang = (float)pos * kInvFreq[8 * (sub & 3) + e];
        const double rev = (double)ang * 0.15915494309189535;
        const float fr = (float)(rev - floor(rev));
        sn[e] = __builtin_amdgcn_sinf(fr); cs[e] = __builtin_amdgcn_cosf(fr);
    }
    const float qscale = 0.07216878364870322f * LOG2E;
#pragma unroll
    for (int which = 0; which < 2; ++which) {
        const float* gn = which ? kg : qg;
        u32x4 w0, w1, w2;
        if (which == 0) { const bf16_t* qh = qraw + hd * 192; w0 = *(const u32x4*)(qh + 8 * sub); w1 = *(const u32x4*)(qh + 64 + 8 * sub); w2 = *(const u32x4*)(qh + 128 + 8 * sub); }
        else { const bf16_t* kh = kvrow + hd * 128; w0 = *(const u32x4*)(kh + 8 * sub); w1 = *(const u32x4*)(kh + 64 + 8 * sub); w2 = *(const u32x4*)(kpe + 8 * sub); }
        float f0[8], f1[8], f2[8]; unpack8(w0, f0); unpack8(w1, f1); unpack8(w2, f2);
        float ss = 0.f;
#pragma unroll
        for (int e = 0; e < 8; ++e) ss += f0[e] * f0[e] + f1[e] * f1[e] + f2[e] * f2[e];
        ss += __shfl_xor(ss, 1); ss += __shfl_xor(ss, 2); ss += __shfl_xor(ss, 4);
        const float r = (which ? 1.f : qscale) / sqrtf(ss * (1.f / 192.f) + EPS);
        const f32x4 ga = *(const f32x4*)(gn + 8 * sub), gb = *(const f32x4*)(gn + 8 * sub + 4), gc = *(const f32x4*)(gn + 64 + 8 * sub), gd = *(const f32x4*)(gn + 64 + 8 * sub + 4),
                    ge = *(const f32x4*)(gn + 128 + 8 * sub), gf = *(const f32x4*)(gn + 128 + 8 * sub + 4);
        const float g0[8] = {ga[0], ga[1], ga[2], ga[3], gb[0], gb[1], gb[2], gb[3]}, g1[8] = {gc[0], gc[1], gc[2], gc[3], gd[0], gd[1], gd[2], gd[3]}, g2[8] = {ge[0], ge[1], ge[2], ge[3], gf[0], gf[1], gf[2], gf[3]};
        float ro[8];
#pragma unroll
        for (int e = 0; e < 8; ++e) { f0[e] *= r * g0[e]; f1[e] *= r * g1[e]; f2[e] *= r * g2[e]; }
#pragma unroll
        for (int e = 0; e < 8; ++e) { const float pr = __shfl_xor(f2[e], 4); ro[e] = (sub < 4) ? (f2[e] * cs[e] - pr * sn[e]) : (f2[e] * cs[e] + pr * sn[e]); }
        bf16_t* dst = (which ? Ko : Qo) + hd * 192;
        *(u32x4*)(dst + 8 * sub) = pack8(f0); *(u32x4*)(dst + 64 + 8 * sub) = pack8(f1); *(u32x4*)(dst + 128 + 8 * sub) = pack8(ro);
    }
}
DEVI void mla_row(const bf16_t* Q, const bf16_t* K, const bf16_t* KV, bf16_t* O, int b, int h, int q, int lane) {
    const size_t t = (size_t)b * SEQ + q;
    const bf16_t* qp = Q + t * QK_LD + h * 192;
    const float q0 = bf2f(qp[lane]), q1 = bf2f(qp[64 + lane]), q2 = bf2f(qp[128 + lane]);
    float m = -INFINITY, l = 0.f, o0 = 0.f, o1 = 0.f;
    const bf16_t* kb = K + (size_t)b * SEQ * QK_LD + h * 192;
    const bf16_t* vb = KV + (size_t)b * SEQ * KV_LD + 1024 + h * 128;
#pragma unroll 4
    for (int j = 0; j <= q; ++j) {
        const bf16_t* kr = kb + (size_t)j * QK_LD; const bf16_t* vr = vb + (size_t)j * KV_LD;
        const float s = wave_sum(q0 * bf2f(kr[lane]) + q1 * bf2f(kr[64 + lane]) + q2 * bf2f(kr[128 + lane]));
        const float v0 = bf2f(vr[lane]), v1 = bf2f(vr[64 + lane]);
        const float mn = fmaxf(m, s), c = exp2f(m - mn), p = exp2f(s - mn);
        l = l * c + p; o0 = o0 * c + p * v0; o1 = o1 * c + p * v1; m = mn;
    }
    const float il = 1.f / l;
    O[t * DM + h * 128 + lane] = (bf16_t)f2bf(o0 * il); O[t * DM + h * 128 + 64 + lane] = (bf16_t)f2bf(o1 * il);
}
DEVI int t5_bucket(int dist) {
    const int n = dist > 0 ? dist : 0;
    if (n < 16) return n;
    const float nf = (float)n;
    int large = 16 + (int)(logf(nf / 16.f) / 2.0794415416798357f * 16.f);
    return large < 31 ? large : 31;
}
DEVI void swa_row(const bf16_t* proj, const int* pos, const float* sinks, const float* rel, bf16_t* O, int b, int hh, int q, int lane) {
    const int kvh = hh >> 3;
    const size_t t = (size_t)b * SEQ + q;
    const float qv = bf2f(proj[t * PROJ_LD + C_SQ + hh * 64 + lane]);
    const float sink = sinks[hh];
    float m = sink, l = 1.f, o = 0.f;
    const int pq = pos[t];
    const int j0 = q - 127 > 0 ? q - 127 : 0;
#pragma unroll 4
    for (int j = j0; j <= q; ++j) {
        const size_t tk = (size_t)b * SEQ + j;
        const float kx = bf2f(proj[tk * PROJ_LD + C_SK + kvh * 64 + lane]), vx = bf2f(proj[tk * PROJ_LD + C_SV + kvh * 64 + lane]);
        const float s = wave_sum(qv * kx) + rel[t5_bucket(pq - pos[tk]) * 16 + hh];
        const float mn = fmaxf(m, s), c = __expf(m - mn), p = __expf(s - mn);
        l = l * c + p; o = o * c + p * vx; m = mn;
    }
    O[t * DM + 1024 + hh * 64 + lane] = (bf16_t)f2bf(o / l);
}
DEVI void p4_row(bf16_t* p, int lane) {
    float f[4][8]; float sa = 0.f, sb = 0.f;
#pragma unroll
    for (int i = 0; i < 4; ++i) { unpack8(*(const u32x4*)(p + lane * 8 + 512 * i), f[i]);
        float s = 0.f;
#pragma unroll
        for (int e = 0; e < 8; ++e) s += f[i][e] * f[i][e];
        if (i < 2) sa += s; else sb += s; }
    const float ra = 1.f / sqrtf(wave_sum(sa) * (1.f / 1024.f) + EPS), rb = 1.f / sqrtf(wave_sum(sb) * (1.f / 1024.f) + EPS);
#pragma unroll
    for (int i = 0; i < 4; ++i) { const float r = i < 2 ? ra : rb;
#pragma unroll
        for (int e = 0; e < 8; ++e) f[i][e] *= r;
        *(u32x4*)(p + lane * 8 + 512 * i) = pack8(f[i]); }
}
DEVI void p5_row(const float* hrow, bf16_t* orow, int lane) {
    f32x4 v[8]; float s = 0.f;
#pragma unroll
    for (int j = 0; j < 8; ++j) { v[j] = *(const f32x4*)(hrow + 4 * (lane + 64 * j)); s += v[j].x * v[j].x + v[j].y * v[j].y + v[j].z * v[j].z + v[j].w * v[j].w; }
    const float r = 1.f / sqrtf(wave_sum(s) * (1.f / DM) + EPS);
#pragma unroll
    for (int j = 0; j < 8; ++j) { u32x2 o; o.x = pk2(v[j].x * r, v[j].y * r); o.y = pk2(v[j].z * r, v[j].w * r); *(u32x2*)(orow + 4 * (lane + 64 * j)) = o; }
}
DEVI void topk_task(const bf16_t* qp, const bf16_t* subk, int* idx, float* gw, size_t t, int h, int lane) {
    float tv[2]; int ti[2];
#pragma unroll
    for (int p = 0; p < 2; ++p) {
        const bf16_t* qs = qp + t * DM + h * 256 + p * 128;
        const float qlo = bf2f(qs[lane]), qhi = bf2f(qs[64 + lane]);
        const bf16_t* k0 = subk + ((size_t)(h * 2 + p) * 128 + lane) * 128; const bf16_t* k1 = k0 + 64 * 128;
        float a0 = 0.f, a1 = 0.f;
        for (int d = 0; d < 64; ++d) { const float qd = __shfl(qlo, d); a0 += qd * bf2f(k0[d]); a1 += qd * bf2f(k1[d]); }
        for (int d = 0; d < 64; ++d) { const float qd = __shfl(qhi, d); a0 += qd * bf2f(k0[64 + d]); a1 += qd * bf2f(k1[64 + d]); }
        float v0 = a0, v1 = a1; float mytv = -INFINITY; int myti = 0;
        for (int r = 0; r < 16; ++r) {
            float bv = v0 >= v1 ? v0 : v1; int bi = v0 >= v1 ? lane : lane + 64;
#pragma unroll
            for (int o = 32; o >= 1; o >>= 1) { const float ov = __shfl_xor(bv, o); const int oi = __shfl_xor(bi, o); if (ov > bv || (ov == bv && oi < bi)) { bv = ov; bi = oi; } }
            if (lane == r) { mytv = bv; myti = bi; }
            if (bi == lane) v0 = -INFINITY;
            if (bi == lane + 64) v1 = -INFINITY;
        }
        tv[p] = mytv; ti[p] = myti;
    }
    float cv[4];
#pragma unroll
    for (int mm = 0; mm < 4; ++mm) { const int c = lane + 64 * mm; cv[mm] = __shfl(tv[0], c >> 4) + __shfl(tv[1], c & 15); }
    float mys = -INFINITY; int myc = 0;
    for (int r = 0; r < 16; ++r) {
        float bv = cv[0]; int bc = lane;
#pragma unroll
        for (int mm = 1; mm < 4; ++mm) if (cv[mm] > bv) { bv = cv[mm]; bc = lane + 64 * mm; }
#pragma unroll
        for (int o = 32; o >= 1; o >>= 1) { const float ov = __shfl_xor(bv, o); const int oc = __shfl_xor(bc, o); if (ov > bv || (ov == bv && oc < bc)) { bv = ov; bc = oc; } }
        if (lane == r) { mys = bv; myc = bc; }
#pragma unroll
        for (int mm = 0; mm < 4; ++mm) if (bc == lane + 64 * mm) cv[mm] = -INFINITY;
    }
    const int i1 = __shfl(ti[0], (myc >> 4) & 15), i2 = __shfl(ti[1], myc & 15);
    float mx = mys;
#pragma unroll
    for (int o = 8; o >= 1; o >>= 1) mx = fmaxf(mx, __shfl_xor(mx, o));
    const float e = __expf(mys - mx); float sm = e;
#pragma unroll
    for (int o = 8; o >= 1; o >>= 1) sm += __shfl_xor(sm, o);
    if (lane < 16) { idx[t * 128 + h * 16 + lane] = i1 * 128 + i2; gw[t * 128 + h * 16 + lane] = e / sm; }
}
DEVI void gather_token(const bf16_t* hn, const bf16_t* Ub, const bf16_t* Vb, const int* idx, const float* gw, float* out, size_t t, int lane) {
    float hv[4][8];
#pragma unroll
    for (int i = 0; i < 4; ++i) unpack8(*(const u32x4*)(hn + t * DM + lane * 8 + 512 * i), hv[i]);
    float y[4][8];
#pragma unroll
    for (int i = 0; i < 4; ++i)
#pragma unroll
        for (int e = 0; e < 8; ++e) y[i][e] = 0.f;
#pragma unroll 2
    for (int k = 0; k < 128; ++k) {
        const int ex = idx[t * 128 + k]; const float g = gw[t * 128 + k];
        const bf16_t* ur = Ub + (size_t)ex * DM + lane * 8; const bf16_t* vr = Vb + (size_t)ex * DM + lane * 8;
        u32x4 uw[4], vw[4];
#pragma unroll
        for (int i = 0; i < 4; ++i) { uw[i] = *(const u32x4*)(ur + 512 * i); vw[i] = *(const u32x4*)(vr + 512 * i); }
        float d = 0.f;
#pragma unroll
        for (int i = 0; i < 4; ++i) { float f[8]; unpack8(uw[i], f);
#pragma unroll
            for (int e = 0; e < 8; ++e) d += f[e] * hv[i][e]; }
        const float a = wave_sum(d);
        const float wgt = g * gelu_tanh(a);
#pragma unroll
        for (int i = 0; i < 4; ++i) { float f[8]; unpack8(vw[i], f);
#pragma unroll
            for (int e = 0; e < 8; ++e) y[i][e] += wgt * f[e]; }
    }
#pragma unroll
    for (int i = 0; i < 4; ++i) { float* o = out + t * DM + lane * 8 + 512 * i;
        f32x4 a = *(const f32x4*)o, b = *(const f32x4*)(o + 4);
        a.x += y[i][0]; a.y += y[i][1]; a.z += y[i][2]; a.w += y[i][3]; b.x += y[i][4]; b.y += y[i][5]; b.z += y[i][6]; b.w += y[i][7];
        *(f32x4*)o = a; *(f32x4*)(o + 4) = b; }
}


typedef float f32x16 __attribute__((ext_vector_type(16)));
typedef short s16x4 __attribute__((ext_vector_type(4)));
namespace mla {
constexpr int SLOT = 40960, KOFF = 0, VOFF = 24576, NSLOT = 3, WS_OFF = NSLOT * SLOT;
DEVI int crow(int r, int hh) { return (r & 3) + 8 * (r >> 2) + 4 * hh; }
DEVI void glds16(const void* gsrc, unsigned lds_dst) { unsigned keep;
    asm volatile("s_mov_b32 %0, m0\n\ts_mov_b32 m0, %2\n\ts_nop 0\n\tglobal_load_lds_dwordx4 %1, off\n\ts_mov_b32 m0, %0" : "=&s"(keep) : "v"(gsrc), "s"(lds_dst) : "memory"); }
DEVI s16x4 vtr(LAS const unsigned char* p) { return __builtin_bit_cast(s16x4, __builtin_amdgcn_ds_read_tr16_b64_v4i16((LAS s16x4*)p)); }

DEVI void unit(LAS unsigned char* lds, const bf16_t* Q, const bf16_t* K, const bf16_t* KV, bf16_t* O, int b, int h, int qb) {
    const int tid = threadIdx.x, lane = tid & 63, w = __builtin_amdgcn_readfirstlane(tid >> 6), r32 = lane & 31, hh = lane >> 5;
    const int grp = w >> 2;
    const int q0 = qb * 256; const size_t rowbase = (size_t)b * SEQ;
    const int NT = (q0 + 256) / 64;
    const int prow = 8 * w + (lane >> 3);
    const char* kg = (const char*)(K + (rowbase + prow) * QK_LD + h * 192 + 8 * ((lane & 7) ^ ((prow >> 1) & 7)));
    const char* vg = (const char*)(KV + (rowbase + prow) * KV_LD + 1024 + h * 128 + 8 * (((((lane & 7) >> 2) ^ ((prow >> 1) & 1)) << 2) | (lane & 3)));
    const unsigned kdst = (unsigned)(KOFF + w * 1024), vdst = (unsigned)(VOFF + w * 1024);
    const unsigned lds0 = (unsigned)(uintptr_t)lds;
#define MLA_ISSUE(t, slotoff) do { \
        const char* kp_ = kg + (size_t)(t) * 64 * QK_LD * 2; const char* vp_ = vg + (size_t)(t) * 64 * KV_LD * 2; \
        _Pragma("unroll") for (int i_ = 0; i_ < 3; ++i_) glds16(kp_ + i_ * 128, (unsigned)__builtin_amdgcn_readfirstlane((int)(lds0 + (slotoff) + kdst + i_ * 8192))); \
        _Pragma("unroll") for (int i_ = 0; i_ < 2; ++i_) glds16(vp_ + i_ * 128, (unsigned)__builtin_amdgcn_readfirstlane((int)(lds0 + (slotoff) + vdst + i_ * 8192))); } while (0)
    MLA_ISSUE(0, 0); MLA_ISSUE(1, SLOT);
    const bf16_t* qrow = Q + (rowbase + q0 + 32 * w + r32) * QK_LD + h * 192 + 8 * hh;
    bf16x8 qf[12];
#pragma unroll
    for (int ks = 0; ks < 12; ++ks) qf[ks] = *(const bf16x8*)(qrow + 16 * ks);
#pragma unroll
    for (int ks = 0; ks < 12; ++ks) asm volatile("" : "+v"(qf[ks]));
    f32x16 o[4];
#pragma unroll
    for (int d = 0; d < 4; ++d)
#pragma unroll
        for (int r = 0; r < 16; ++r) o[d][r] = 0.f;
    float mref = 0.f, lsum = 0.f;
    LAS float* wsf = (LAS float*)(lds + WS_OFF) + w * 32;
    const int ksw = (r32 >> 1) & 7;
    const int vread = VOFF + ((lane >> 4) & 1) * 32 + (lane & 3) * 8 + (4 * hh + ((lane & 15) >> 2)) * 128;
    asm volatile("s_waitcnt vmcnt(5)" ::: "memory");
    __builtin_amdgcn_s_barrier();
    asm volatile("" ::: "memory");
#define MLA_BAR() do { asm volatile("s_waitcnt lgkmcnt(0)" ::: "memory"); __builtin_amdgcn_s_barrier(); asm volatile("" ::: "memory"); } while (0)
#define MLA_PREFETCH(i) do { if ((i) + 2 < NT) { const int so_ = (((i) + 2) % 3) * SLOT; MLA_ISSUE((i) + 2, so_); } } while (0)
#define MLA_LANDED(i) do { if ((i) + 2 < NT) asm volatile("s_waitcnt vmcnt(5)" ::: "memory"); else asm volatile("s_waitcnt vmcnt(0)" ::: "memory"); } while (0)
    if (grp) MLA_BAR();
    for (int t = 0; t < NT; ++t) {
        const int slot = (t % 3) * SLOT;
        if (grp) MLA_PREFETCH(t);
        f32x16 s0, s1;
        {
            unsigned kr[4];
#pragma unroll
            for (int j = 0; j < 4; ++j) kr[j] = lds0 + (unsigned)(slot + KOFF + r32 * 128 + (((2 * j + hh) ^ ksw) * 16));
#define MLA_KLD(ks, d0, d1) do { asm volatile("ds_read_b128 %0, %1 offset:%2" : "=&v"(d0) : "v"(kr[(ks) & 3]), "i"(((ks) >> 2) * 8192)); \
                                 asm volatile("ds_read_b128 %0, %1 offset:%2" : "=&v"(d1) : "v"(kr[(ks) & 3]), "i"(((ks) >> 2) * 8192 + 4096)); } while (0)
            bf16x8 ka[3], kb[3];
            __builtin_amdgcn_s_setprio(1);
            MLA_KLD(0, ka[0], kb[0]); MLA_KLD(1, ka[1], kb[1]);
#pragma unroll
            for (int ks = 0; ks < 12; ++ks) {
                if (ks + 2 < 12) { MLA_KLD(ks + 2, ka[(ks + 2) % 3], kb[(ks + 2) % 3]); asm volatile("s_waitcnt lgkmcnt(4)" : "+v"(ka[ks % 3]), "+v"(kb[ks % 3])); }
                else if (ks + 1 < 12) asm volatile("s_waitcnt lgkmcnt(2)" : "+v"(ka[ks % 3]), "+v"(kb[ks % 3]));
                else asm volatile("s_waitcnt lgkmcnt(0)" : "+v"(ka[ks % 3]), "+v"(kb[ks % 3]));
                if (ks == 0) { f32x16 z;
#pragma unroll
                    for (int r = 0; r < 16; ++r) z[r] = 0.f;
                    s0 = __builtin_amdgcn_mfma_f32_32x32x16_bf16(ka[0], qf[0], z, 0, 0, 0); s1 = __builtin_amdgcn_mfma_f32_32x32x16_bf16(kb[0], qf[0], z, 0, 0, 0); }
                else { s0 = __builtin_amdgcn_mfma_f32_32x32x16_bf16(ka[ks % 3], qf[ks], s0, 0, 0, 0); s1 = __builtin_amdgcn_mfma_f32_32x32x16_bf16(kb[ks % 3], qf[ks], s1, 0, 0, 0); }
            }
#undef MLA_KLD
            __builtin_amdgcn_s_setprio(0);
        }
        if (grp) MLA_LANDED(t);
        MLA_BAR();
        if (!grp) MLA_PREFETCH(t);
        {
            const int jb = t - (NT - 4);
            if (jb >= 0) {
                const int qrel = 32 * w + r32, kb_ = 64 * jb + 4 * hh;
#pragma unroll
                for (int r = 0; r < 16; ++r) { const int kv = kb_ + (r & 3) + 8 * (r >> 2); if (kv > qrel) s0[r] = -INFINITY; if (kv + 32 > qrel) s1[r] = -INFINITY; }
            }
            float ma = fmaxf(fmaxf(s0[0], s0[1]), s1[0]), mb = fmaxf(fmaxf(s0[2], s0[3]), s1[1]);
            ma = fmaxf(fmaxf(ma, s1[2]), s1[3]);
#pragma unroll
            for (int r = 4; r < 16; r += 4) { ma = fmaxf(fmaxf(ma, s0[r]), s0[r + 1]); mb = fmaxf(fmaxf(mb, s0[r + 2]), s0[r + 3]); ma = fmaxf(fmaxf(ma, s1[r]), s1[r + 1]); mb = fmaxf(fmaxf(mb, s1[r + 2]), s1[r + 3]); }
            float rm = fmaxf(ma, mb) - mref;
            rm = fmaxf(rm, __shfl_xor(rm, 32));
            if (__any(rm > 8.f)) {
                const float dl = fmaxf(rm, 0.f);
                mref += dl;
                const float corr = __builtin_amdgcn_exp2f(-dl);
                lsum *= corr;
                if (hh == 0) wsf[r32] = corr;
                asm volatile("s_waitcnt lgkmcnt(0)" ::: "memory");
#pragma unroll
                for (int g = 0; g < 4; ++g) { const f32x4 c4 = *(LAS const f32x4*)(wsf + 8 * g + 4 * hh);
#pragma unroll
                    for (int d = 0; d < 4; ++d) { o[d][4 * g + 0] *= c4[0]; o[d][4 * g + 1] *= c4[1]; o[d][4 * g + 2] *= c4[2]; o[d][4 * g + 3] *= c4[3]; } }
                asm volatile("s_waitcnt lgkmcnt(0)" ::: "memory");
            }
            float ps = 0.f;
#pragma unroll
            for (int r = 0; r < 16; ++r) { s0[r] = __builtin_amdgcn_exp2f(s0[r] - mref); s1[r] = __builtin_amdgcn_exp2f(s1[r] - mref); ps += s0[r] + s1[r]; }
            lsum += ps;
            bf16x8 pf[4];
#pragma unroll
            for (int ks = 0; ks < 4; ++ks) {
                u32x4 wv;
                if (ks < 2) { wv.x = pk2(s0[8 * ks + 0], s0[8 * ks + 1]); wv.y = pk2(s0[8 * ks + 2], s0[8 * ks + 3]); wv.z = pk2(s0[8 * ks + 4], s0[8 * ks + 5]); wv.w = pk2(s0[8 * ks + 6], s0[8 * ks + 7]); }
                else { const int k2 = ks - 2; wv.x = pk2(s1[8 * k2 + 0], s1[8 * k2 + 1]); wv.y = pk2(s1[8 * k2 + 2], s1[8 * k2 + 3]); wv.z = pk2(s1[8 * k2 + 4], s1[8 * k2 + 5]); wv.w = pk2(s1[8 * k2 + 6], s1[8 * k2 + 7]); }
                pf[ks] = __builtin_bit_cast(bf16x8, wv);
            }
            const unsigned rb64 = (unsigned)(((lane >> 3) & 1) * 64);
            const unsigned va0 = lds0 + (unsigned)(slot + vread) + rb64, va1 = lds0 + (unsigned)(slot + vread) + (64u - rb64);
            s16x4 vlo[3], vhi[3];
#define MLA_VLD(i, b) do { if (((i) >> 2) & 1) { asm volatile("ds_read_b64_tr_b16 %0, %1 offset:%2" : "=&v"(vlo[b]) : "v"(va1), "i"(((i) >> 3) * 8192 + ((i) & 3) * 2048)); \
                                                 asm volatile("ds_read_b64_tr_b16 %0, %1 offset:%2" : "=&v"(vhi[b]) : "v"(va1), "i"(((i) >> 3) * 8192 + ((i) & 3) * 2048 + 1024)); } \
                           else { asm volatile("ds_read_b64_tr_b16 %0, %1 offset:%2" : "=&v"(vlo[b]) : "v"(va0), "i"(((i) >> 3) * 8192 + ((i) & 3) * 2048)); \
                                  asm volatile("ds_read_b64_tr_b16 %0, %1 offset:%2" : "=&v"(vhi[b]) : "v"(va0), "i"(((i) >> 3) * 8192 + ((i) & 3) * 2048 + 1024)); } } while (0)
            __builtin_amdgcn_s_setprio(1);
            MLA_VLD(0, 0); MLA_VLD(1, 1);
#pragma unroll
            for (int i = 0; i < 16; ++i) {
                if (i + 2 < 16) { MLA_VLD(i + 2, (i + 2) % 3); asm volatile("s_waitcnt lgkmcnt(4)" : "+v"(vlo[i % 3]), "+v"(vhi[i % 3])); }
                else if (i + 1 < 16) asm volatile("s_waitcnt lgkmcnt(2)" : "+v"(vlo[i % 3]), "+v"(vhi[i % 3]));
                else asm volatile("s_waitcnt lgkmcnt(0)" : "+v"(vlo[i % 3]), "+v"(vhi[i % 3]));
                const s16x4 lo = vlo[i % 3], hi = vhi[i % 3];
                const bf16x8 vf = (bf16x8){lo[0], lo[1], lo[2], lo[3], hi[0], hi[1], hi[2], hi[3]};
                o[i >> 2] = __builtin_amdgcn_mfma_f32_32x32x16_bf16(pf[i & 3], vf, o[i >> 2], 0, 0, 0);
            }
#undef MLA_VLD
            __builtin_amdgcn_s_setprio(0);
        }
        if (!grp) MLA_LANDED(t);
        MLA_BAR();
    }
    if (!grp) MLA_BAR();
#undef MLA_BAR
#undef MLA_PREFETCH
#undef MLA_LANDED
    lsum += __shfl_xor(lsum, 32);
    if (hh == 0) wsf[r32] = 1.f / lsum;
    asm volatile("s_waitcnt lgkmcnt(0)" ::: "memory");
    bf16_t* orow = O + (rowbase + q0 + 32 * w) * DM + h * 128 + r32;
#pragma unroll
    for (int g = 0; g < 4; ++g) { const f32x4 c4 = *(LAS const f32x4*)(wsf + 8 * g + 4 * hh);
#pragma unroll
        for (int e = 0; e < 4; ++e) { const int qr = 8 * g + 4 * hh + e;
#pragma unroll
            for (int d = 0; d < 4; ++d) orow[(size_t)qr * DM + 32 * d] = (bf16_t)f2bf(o[d][4 * g + e] * c4[e]); } }
    asm volatile("s_waitcnt lgkmcnt(0)" ::: "memory");
    __builtin_amdgcn_s_barrier();
    asm volatile("" ::: "memory");
#undef MLA_ISSUE
}
DEVI void phase(LAS unsigned char* lds, const bf16_t* Q, const bf16_t* K, const bf16_t* KV, bf16_t* O, int vcu, int G) {
    for (int p = vcu; p < 256; p += G) {
        const int bh = p >> 3, s = p & 7;
        unit(lds, Q, K, KV, O, bh >> 3, bh & 7, 15 - s);
        unit(lds, Q, K, KV, O, bh >> 3, bh & 7, s);
    }
}
}


namespace peer {
typedef float f32x2 __attribute__((ext_vector_type(2)));
DEVI float rl(float v, int l) { return __builtin_bit_cast(float, __builtin_amdgcn_readlane(__builtin_bit_cast(int, v), l)); }
DEVI void convert_load(f32x4 (&v)[8], const float* src, int lane) {
#pragma unroll
    for (int i = 0; i < 8; ++i) v[i] = *(const f32x4*)(src + 256 * i + 4 * lane);
}
template <bool HAS_GAIN, bool INT8> DEVI void convert_finish(f32x4 (&v)[8], const f32x4 (&gn)[8], unsigned char* dst, float* scale_inv, int lane) {
    float am = 0.f;
#pragma unroll
    for (int i = 0; i < 8; ++i) { f32x4 x = v[i]; if (HAS_GAIN) x = x * gn[i];
        v[i] = x; am = fmaxf(am, fmaxf(fmaxf(fabsf(x[0]), fabsf(x[1])), fmaxf(fabsf(x[2]), fabsf(x[3])))); }
#pragma unroll
    for (int o = 1; o < 64; o <<= 1) am = fmaxf(am, __shfl_xor(am, o));
    const float top = INT8 ? 127.f : 256.f;
    const float sc = am > 0.f ? top / am : 1.f;
#pragma unroll
    for (int i = 0; i < 8; ++i) { const f32x4 x = v[i] * sc; int p;
        if (INT8) { const int q0 = __float2int_rn(x[0]), q1 = __float2int_rn(x[1]), q2 = __float2int_rn(x[2]), q3 = __float2int_rn(x[3]);
                    p = (q0 & 255) | ((q1 & 255) << 8) | ((q2 & 255) << 16) | (q3 << 24); }
        else { p = __builtin_amdgcn_cvt_pk_fp8_f32(x[0], x[1], 0, false); p = __builtin_amdgcn_cvt_pk_fp8_f32(x[2], x[3], p, true); }
        *(int*)(dst + ((size_t)(2 * i + (lane >> 5)) * 16384) * 128 + 4 * (lane & 31)) = p; }
    if (lane == 0) *scale_inv = am > 0.f ? am / top : 1.f;
}
template <bool HAS_GAIN> DEVI void convert_rows(const float* src, const float* gain, unsigned char* dst, float* scale_inv, int first, int stride, int n, int lane) {
    if (first >= n) return;
    f32x4 gn[8];
#pragma unroll
    for (int i = 0; i < 8; ++i) gn[i] = HAS_GAIN ? *(const f32x4*)(gain + 256 * i + 4 * lane) : (f32x4){1.f, 1.f, 1.f, 1.f};
    f32x4 cur[8], nx1[8], nx2[8];
    int r = first;
    if (r + stride < n) {
        convert_load(cur, src + (size_t)r * DM, lane);
        convert_load(nx1, src + (size_t)(r + stride) * DM, lane);
        for (; r + 2 * stride < n; r += stride) {
            convert_load(nx2, src + (size_t)(r + 2 * stride) * DM, lane);
            convert_finish<HAS_GAIN, true>(cur, gn, dst + (size_t)r * 128, scale_inv + r, lane);
#pragma unroll
            for (int i = 0; i < 8; ++i) { cur[i] = nx1[i]; nx1[i] = nx2[i]; }
        }
        convert_finish<HAS_GAIN, true>(cur, gn, dst + (size_t)r * 128, scale_inv + r, lane); r += stride;
        convert_finish<HAS_GAIN, true>(nx1, gn, dst + (size_t)r * 128, scale_inv + r, lane);
    } else {
        convert_load(cur, src + (size_t)r * DM, lane);
        convert_finish<HAS_GAIN, true>(cur, gn, dst + (size_t)r * 128, scale_inv + r, lane);
    }
}
DEVI float reduce4(float p0, float p1, float p2, float p3, int lane) {
    const bool h5 = (lane & 32) != 0, h4 = (lane & 16) != 0;
    float a = h5 ? p2 : p0, b = h5 ? p0 : p2; a += __shfl_xor(b, 32);
    float c = h5 ? p3 : p1, d = h5 ? p1 : p3; c += __shfl_xor(d, 32);
    float x = h4 ? c : a, y = h4 ? a : c; x += __shfl_xor(y, 16);
    x += __shfl_xor(x, 8); x += __shfl_xor(x, 4); x += __shfl_xor(x, 2); x += __shfl_xor(x, 1);
    return x;
}
#define PEER_LOAD4(buf, base, sel, k0) do { _Pragma("unroll") for (int r_ = 0; r_ < 4; ++r_) { \
        const unsigned char* rp_ = (base) + (size_t)__builtin_amdgcn_readlane((sel), ((k0) + r_) & 63) * DM + lane * 16; \
        buf[r_][0] = *(const u32x4*)(rp_); buf[r_][1] = *(const u32x4*)(rp_ + 1024); } } while (0)
DEVI float dotrow(const u32x4 (&row)[2], const f32x2 (&h2)[16]) {
    f32x2 p = (f32x2){0.f, 0.f};
#pragma unroll
    for (int c = 0; c < 2; ++c)
#pragma unroll
        for (int j = 0; j < 4; ++j) { const int wv = (int)row[c][j];
            const f32x2 f01 = __builtin_amdgcn_cvt_pk_f32_fp8(wv, false), f23 = __builtin_amdgcn_cvt_pk_f32_fp8(wv, true);
            p += f01 * h2[8 * c + 2 * j]; p += f23 * h2[8 * c + 2 * j + 1]; }
    return p[0] + p[1];
}
DEVI void axpyrow(f32x2 (&y)[16], const u32x4 (&row)[2], float wk) {
#pragma unroll
    for (int c = 0; c < 2; ++c)
#pragma unroll
        for (int j = 0; j < 4; ++j) { const int wv = (int)row[c][j];
            const f32x2 f01 = __builtin_amdgcn_cvt_pk_f32_fp8(wv, false), f23 = __builtin_amdgcn_cvt_pk_f32_fp8(wv, true);
            y[8 * c + 2 * j] += f01 * wk; y[8 * c + 2 * j + 1] += f23 * wk; }
}
DEVI void token(LAS float* scr, const bf16_t* hn, const unsigned char* U8, const unsigned char* V8, const float* usc, const float* vsc, const int* idx, const float* gw, float* out, size_t t, int lane) {
    f32x2 h2[16];
#pragma unroll
    for (int c = 0; c < 2; ++c)
#pragma unroll
        for (int q = 0; q < 2; ++q) { const u32x4 w = *(const u32x4*)(hn + t * DM + 1024 * c + 16 * lane + 8 * q); float f[8]; unpack8(w, f);
#pragma unroll
            for (int e = 0; e < 4; ++e) h2[8 * c + 4 * q + e] = (f32x2){f[2 * e], f[2 * e + 1]}; }
    const int idlo = idx[t * 128 + lane], idhi = idx[t * 128 + 64 + lane];
    const float glo = gw[t * 128 + lane] * vsc[idlo], ghi = gw[t * 128 + 64 + lane] * vsc[idhi];
    const float ulo = usc[idlo], uhi = usc[idhi];
    u32x4 bA[4][2], bB[4][2];
    PEER_LOAD4(bA, U8, idlo, 0);
    for (int kb = 0; kb < 128; kb += 8) {
        const int sel = kb < 64 ? idlo : idhi;
        PEER_LOAD4(bB, U8, sel, kb + 4);
        { const float x = reduce4(dotrow(bA[0], h2), dotrow(bA[1], h2), dotrow(bA[2], h2), dotrow(bA[3], h2), lane); if ((lane & 15) == 0) scr[kb + (lane >> 4)] = x; }
        if (kb + 8 < 128) { const int sel2 = (kb + 8) < 64 ? idlo : idhi; PEER_LOAD4(bA, U8, sel2, kb + 8); }
        { const float x = reduce4(dotrow(bB[0], h2), dotrow(bB[1], h2), dotrow(bB[2], h2), dotrow(bB[3], h2), lane); if ((lane & 15) == 0) scr[kb + 4 + (lane >> 4)] = x; }
    }
    asm volatile("s_waitcnt lgkmcnt(0)" ::: "memory");
    const float wlo = glo * gelu_tanh(scr[lane] * ulo), whi = ghi * gelu_tanh(scr[64 + lane] * uhi);
    asm volatile("s_waitcnt lgkmcnt(0)" ::: "memory");
    f32x2 y[16];
#pragma unroll
    for (int i = 0; i < 16; ++i) y[i] = (f32x2){0.f, 0.f};
    PEER_LOAD4(bA, V8, idlo, 0);
    for (int kb = 0; kb < 128; kb += 8) {
        const int sel = kb < 64 ? idlo : idhi; const float wsel = kb < 64 ? wlo : whi;
        PEER_LOAD4(bB, V8, sel, kb + 4);
#pragma unroll
        for (int r = 0; r < 4; ++r) axpyrow(y, bA[r], rl(wsel, (kb + r) & 63));
        if (kb + 8 < 128) { const int sel2 = (kb + 8) < 64 ? idlo : idhi; PEER_LOAD4(bA, V8, sel2, kb + 8); }
#pragma unroll
        for (int r = 0; r < 4; ++r) axpyrow(y, bB[r], rl(wsel, (kb + 4 + r) & 63));
    }
#pragma unroll
    for (int c = 0; c < 2; ++c)
#pragma unroll
        for (int j = 0; j < 4; ++j) { float* o = out + t * DM + 1024 * c + 16 * lane + 4 * j;
            f32x4 a = *(const f32x4*)o; a[0] += y[8 * c + 2 * j][0]; a[1] += y[8 * c + 2 * j][1]; a[2] += y[8 * c + 2 * j + 1][0]; a[3] += y[8 * c + 2 * j + 1][1];
            *(f32x4*)o = a; }
}
#undef PEER_LOAD4

DEVI f32x2 dot16(const u32x4 row, const f32x2 (&h2)[8], f32x2 p) {
#pragma unroll
    for (int j = 0; j < 4; ++j) { const int wv = (int)row[j];
        p += __builtin_amdgcn_cvt_pk_f32_fp8(wv, false) * h2[2 * j]; p += __builtin_amdgcn_cvt_pk_f32_fp8(wv, true) * h2[2 * j + 1]; }
    return p;
}
template <int M> DEVI float xshf(float x) {
    if constexpr (M == 1) return __builtin_bit_cast(float, __builtin_amdgcn_update_dpp(0, __builtin_bit_cast(int, x), 0xB1, 0xF, 0xF, false));
    else if constexpr (M == 2) return __builtin_bit_cast(float, __builtin_amdgcn_update_dpp(0, __builtin_bit_cast(int, x), 0x4E, 0xF, 0xF, false));
    else return __shfl_xor(x, M);
}
template <int M> DEVI int xshi(int x) {
    if constexpr (M == 1) return __builtin_amdgcn_update_dpp(0, x, 0xB1, 0xF, 0xF, false);
    else if constexpr (M == 2) return __builtin_amdgcn_update_dpp(0, x, 0x4E, 0xF, 0xF, false);
    else return __shfl_xor(x, M);
}
template <int B2, int B1, int B0> DEVI void reduce16i(const int (&v)[16], int lane, int& o0, int& o1) {
    const bool b2 = (lane & B2) != 0, b1 = (lane & B1) != 0, b0 = (lane & B0) != 0;
    int q[8], r[4];
#pragma unroll
    for (int j = 0; j < 8; ++j) q[j] = (b2 ? v[8 + j] : v[j]) + xshi<B2>(b2 ? v[j] : v[8 + j]);
#pragma unroll
    for (int j = 0; j < 4; ++j) r[j] = (b1 ? q[4 + j] : q[j]) + xshi<B1>(b1 ? q[j] : q[4 + j]);
    o0 = (b0 ? r[2] : r[0]) + xshi<B0>(b0 ? r[0] : r[2]);
    o1 = (b0 ? r[3] : r[1]) + xshi<B0>(b0 ? r[1] : r[3]);
}
template <int B2, int B1, int B0> DEVI f32x2 reduce16(const float (&v)[16], int lane) {
    const bool b2 = (lane & B2) != 0, b1 = (lane & B1) != 0, b0 = (lane & B0) != 0;
    float q[8], r[4];
#pragma unroll
    for (int j = 0; j < 8; ++j) q[j] = (b2 ? v[8 + j] : v[j]) + xshf<B2>(b2 ? v[j] : v[8 + j]);
#pragma unroll
    for (int j = 0; j < 4; ++j) r[j] = (b1 ? q[4 + j] : q[j]) + xshf<B1>(b1 ? q[j] : q[4 + j]);
    f32x2 o;
    o[0] = (b0 ? r[2] : r[0]) + xshf<B0>(b0 ? r[0] : r[2]);
    o[1] = (b0 ? r[3] : r[1]) + xshf<B0>(b0 ? r[1] : r[3]);
    return o;
}
template <int MASK> DEVI u32x4 bcast4(const u32x4 v) {
    u32x4 r;
#pragma unroll
    for (int k = 0; k < 4; ++k) r[k] = (unsigned)__builtin_amdgcn_ds_swizzle((int)v[k], MASK);
    return r;
}
DEVI void unpack_ids(const u32x4 lo, const u32x4 hi, int (&id)[16]) {
#pragma unroll
    for (int k = 0; k < 4; ++k) { id[2 * k] = (int)(lo[k] & 0xffffu); id[2 * k + 1] = (int)(lo[k] >> 16); id[8 + 2 * k] = (int)(hi[k] & 0xffffu); id[8 + 2 * k + 1] = (int)(hi[k] >> 16); }
}
DEVI void h_to_int8(const bf16_t* hrow, const float ssq, signed char* orow, float* hsc_inv, int lane) {
    const float rms = sqrtf(ssq * (1.f / DM) + EPS), sc = 127.f / (6.f * rms);
#pragma unroll
    for (int i = 0; i < 4; ++i) { float f[8]; unpack8(*(const u32x4*)(hrow + 512 * i + 8 * lane), f);
        u32x2 w;
        { const int q0 = max(-127, min(127, __float2int_rn(f[0] * sc))), q1 = max(-127, min(127, __float2int_rn(f[1] * sc))), q2 = max(-127, min(127, __float2int_rn(f[2] * sc))), q3 = max(-127, min(127, __float2int_rn(f[3] * sc)));
          w.x = (unsigned)((q0 & 255) | ((q1 & 255) << 8) | ((q2 & 255) << 16) | (q3 << 24)); }
        { const int q0 = max(-127, min(127, __float2int_rn(f[4] * sc))), q1 = max(-127, min(127, __float2int_rn(f[5] * sc))), q2 = max(-127, min(127, __float2int_rn(f[6] * sc))), q3 = max(-127, min(127, __float2int_rn(f[7] * sc)));
          w.y = (unsigned)((q0 & 255) | ((q1 & 255) << 8) | ((q2 & 255) << 16) | (q3 << 24)); }
        *(u32x2*)(orow + 512 * i + 8 * lane) = w; }
    if (lane == 0) *hsc_inv = 6.f * rms * (1.f / 127.f);
}
DEVI void sliceA(const signed char* h8, const unsigned char* U8, const unsigned short* idx, bf16_t* aP, int s, int t0, int nt, int lane) {
    const int g = lane >> 3, c8 = lane & 7;
    const unsigned char* ub = U8 + (size_t)s * 16384 * 128; const unsigned lo = 16u * (unsigned)c8;
    const bool ldi = (c8 == 0), ldh = ((lane & 0x18) == 0);
    u32x4 il = (u32x4){0u, 0u, 0u, 0u}, ih = il, hw = il;
    if (ldi) { il = *(const u32x4*)(idx + (size_t)t0 * 128 + 16 * g); ih = *(const u32x4*)(idx + (size_t)t0 * 128 + 16 * g + 8); }
    if (ldh) hw = *(const u32x4*)(h8 + (size_t)t0 * DM + 128 * s + 16 * c8);
    u32x4 bil = bcast4<0x18>(il), bih = bcast4<0x18>(ih), hb = bcast4<0x07>(hw);
    for (int tt = 0; tt < nt; ++tt) {
        const size_t t = (size_t)t0 + tt;
        int id[16]; unpack_ids(bil, bih, id);
        u32x4 rows[16];
#pragma unroll
        for (int i = 0; i < 16; ++i) rows[i] = *(const u32x4*)(ub + ((unsigned)id[i] * 128u + lo));
        const u32x4 hcur = hb;
        if (tt + 1 < nt) {
            if (ldi) { il = *(const u32x4*)(idx + (t + 1) * 128 + 16 * g); ih = *(const u32x4*)(idx + (t + 1) * 128 + 16 * g + 8); }
            if (ldh) hw = *(const u32x4*)(h8 + (t + 1) * DM + 128 * s + 16 * c8);
        }
        int p[16];
#pragma unroll
        for (int i = 0; i < 16; ++i) { int acc = __builtin_amdgcn_sdot4((int)rows[i][0], (int)hcur[0], 0, false); acc = __builtin_amdgcn_sdot4((int)rows[i][1], (int)hcur[1], acc, false);
            acc = __builtin_amdgcn_sdot4((int)rows[i][2], (int)hcur[2], acc, false); acc = __builtin_amdgcn_sdot4((int)rows[i][3], (int)hcur[3], acc, false); p[i] = acc; }
        int oi0, oi1; reduce16i<4, 2, 1>(p, lane, oi0, oi1);
        const f32x2 o = (f32x2){(float)oi0, (float)oi1};
        bil = bcast4<0x18>(il); bih = bcast4<0x18>(ih); hb = bcast4<0x07>(hw);
        asm volatile("" : "+v"(bil), "+v"(bih), "+v"(hb));
        *(unsigned*)(aP + (t * 16 + s) * 128 + 2 * lane) = pk2(o[0], o[1]);
    }
}
DEVI void rowA2(const bf16_t* aP, const unsigned short* idx, const float* gw, const float* usc, const float* vsc, const float* ssqh, const float* hsc_inv, signed char* W, float* wsc, size_t t, int lane) {
    const float r2 = hsc_inv[t] / sqrtf(ssqh[t] * (1.f / DM) + EPS);
    f32x2 a = (f32x2){0.f, 0.f};
#pragma unroll
    for (int s = 0; s < 16; ++s) { const unsigned w2 = *(const unsigned*)(aP + (t * 16 + s) * 128 + 2 * lane); a += (f32x2){__uint_as_float(w2 << 16), __uint_as_float(w2 & 0xffff0000u)}; }
    const unsigned ii = *(const unsigned*)(idx + t * 128 + 2 * lane);
    const int i0 = (int)(ii & 0xffffu), i1 = (int)(ii >> 16);
    const f32x2 g = *(const f32x2*)(gw + t * 128 + 2 * lane);
    const float w0 = g[0] * vsc[i0] * gelu_tanh(a[0] * usc[i0] * r2), w1 = g[1] * vsc[i1] * gelu_tanh(a[1] * usc[i1] * r2);
    float am = fmaxf(fabsf(w0), fabsf(w1));
#pragma unroll
    for (int o = 1; o < 64; o <<= 1) am = fmaxf(am, __shfl_xor(am, o));
    const float sc = am > 0.f ? 127.f / am : 0.f;
    const int q0 = __float2int_rn(w0 * sc), q1 = __float2int_rn(w1 * sc);
    *(unsigned short*)(W + t * 128 + 2 * lane) = (unsigned short)((q0 & 255) | ((q1 & 255) << 8));
    if (lane == 0) wsc[t] = am * (1.f / 127.f);
}
DEVI unsigned bperm(unsigned hi, unsigned lo, unsigned sel) { return __builtin_amdgcn_perm(hi, lo, sel); }
DEVI void sliceB(const unsigned char* V8, const unsigned short* idx, const signed char* W, const float* wsc, const bf16_t* hb, float* out, int s, int t0, int nt, int lane) {
    const int g = lane >> 3, c8 = lane & 7;
    const unsigned char* vb = V8 + (size_t)s * 16384 * 128; const unsigned lo = 16u * (unsigned)c8;
    const bool ldi = (c8 == 0);
    u32x4 il = (u32x4){0u, 0u, 0u, 0u}, ih = il, wq = il;
    if (ldi) { il = *(const u32x4*)(idx + (size_t)t0 * 128 + 16 * g); ih = *(const u32x4*)(idx + (size_t)t0 * 128 + 16 * g + 8); wq = *(const u32x4*)(W + (size_t)t0 * 128 + 16 * g); }
    u32x4 bil = bcast4<0x18>(il), bih = bcast4<0x18>(ih), wb = bcast4<0x18>(wq);
    unsigned hw2 = *(const unsigned*)(hb + (size_t)t0 * DM + 128 * s + 16 * c8 + 2 * g);
    float ws = wsc[t0];
    for (int tt = 0; tt < nt; ++tt) {
        const size_t t = (size_t)t0 + tt;
        int id[16]; unpack_ids(bil, bih, id);
        u32x4 rows[16];
#pragma unroll
        for (int i = 0; i < 16; ++i) rows[i] = *(const u32x4*)(vb + ((unsigned)id[i] * 128u + lo));
        float* op = out + t * DM + 128 * s + 16 * c8 + 2 * g;
        const f32x2 hcur = (f32x2){__uint_as_float(hw2 << 16), __uint_as_float(hw2 & 0xffff0000u)};
        const u32x4 wcur = wb; const float wscur = ws;
        if (tt + 1 < nt) {
            if (ldi) { il = *(const u32x4*)(idx + (t + 1) * 128 + 16 * g); ih = *(const u32x4*)(idx + (t + 1) * 128 + 16 * g + 8); wq = *(const u32x4*)(W + (t + 1) * 128 + 16 * g); }
            hw2 = *(const unsigned*)(hb + (t + 1) * DM + 128 * s + 16 * c8 + 2 * g);
            ws = wsc[t + 1];
        }
        int acc[16];
#pragma unroll
        for (int c = 0; c < 16; ++c) acc[c] = 0;
#pragma unroll
        for (int q = 0; q < 4; ++q)
#pragma unroll
            for (int j = 0; j < 4; ++j) {
                const unsigned d0 = rows[4 * q][j], d1 = rows[4 * q + 1][j], d2 = rows[4 * q + 2][j], d3 = rows[4 * q + 3][j];
                const unsigned p01l = bperm(d1, d0, 0x05010400u), p01h = bperm(d1, d0, 0x07030602u);
                const unsigned p23l = bperm(d3, d2, 0x05010400u), p23h = bperm(d3, d2, 0x07030602u);
                const unsigned t0_ = bperm(p23l, p01l, 0x05040100u), t1_ = bperm(p23l, p01l, 0x07060302u);
                const unsigned t2_ = bperm(p23h, p01h, 0x05040100u), t3_ = bperm(p23h, p01h, 0x07060302u);
                acc[4 * j + 0] = __builtin_amdgcn_sdot4((int)t0_, (int)wcur[q], acc[4 * j + 0], false);
                acc[4 * j + 1] = __builtin_amdgcn_sdot4((int)t1_, (int)wcur[q], acc[4 * j + 1], false);
                acc[4 * j + 2] = __builtin_amdgcn_sdot4((int)t2_, (int)wcur[q], acc[4 * j + 2], false);
                acc[4 * j + 3] = __builtin_amdgcn_sdot4((int)t3_, (int)wcur[q], acc[4 * j + 3], false);
            }
        int oi0, oi1; reduce16i<32, 16, 8>(acc, lane, oi0, oi1);
        const f32x2 o = (f32x2){(float)oi0, (float)oi1};
        bil = bcast4<0x18>(il); bih = bcast4<0x18>(ih); wb = bcast4<0x18>(wq);
        asm volatile("" : "+v"(bil), "+v"(bih), "+v"(wb), "+v"(hw2), "+v"(ws));
        *(f32x2*)op = hcur + o * wscur;
    }
}
}


namespace topk {
struct CandTab { int a[50], b[50]; };
constexpr CandTab make_tab() { CandTab t{}; int n = 0; for (int a = 0; a < 16; ++a) for (int b = 0; b < 16; ++b) if ((a + 1) * (b + 1) <= 16) { t.a[n] = a; t.b[n] = b; ++n; } return t; }
constexpr CandTab CT = make_tab();
DEVI void ins16(float (&L)[16], float x) {
#pragma unroll
    for (int k = 0; k < 16; ++k) { const float hi = fmaxf(L[k], x); x = fminf(L[k], x); L[k] = hi; }
}
DEVI void merge_partner(float (&L)[16]) {
    float M[16];
#pragma unroll
    for (int k = 0; k < 16; ++k) M[k] = __shfl_xor(L[k], 32);
#pragma unroll
    for (int k = 0; k < 16; ++k) L[k] = fmaxf(L[k], M[15 - k]);
#pragma unroll
    for (int st = 8; st >= 1; st >>= 1)
#pragma unroll
        for (int i = 0; i < 16; ++i) if ((i & st) == 0) { const float a = L[i], b = L[i + st]; L[i] = fmaxf(a, b); L[i + st] = fminf(a, b); }
}
DEVI void stage_keys(LAS unsigned char* lds, const bf16_t* subk, int h, int tid) {
#pragma unroll
    for (int i = 0; i < 8; ++i) {
        const int c = tid + 512 * i, p = c >> 11, rem = c & 2047, row = rem >> 4, ch = rem & 15, kb = ch >> 2, cq = ch & 3;
        const u32x4 v = *(const u32x4*)(subk + ((size_t)(h * 2 + p) * 128 + row) * 128 + ch * 8);
        *(LAS u32x4*)(lds + p * 32768 + kb * 8192 + row * 64 + ((cq ^ ((row >> 2) & 3)) * 16)) = v;
    }
}
DEVI void unit(LAS unsigned char* lds, const bf16_t* qp, unsigned short* idx, float* gw, int tt, int h) {
    const int tid = threadIdx.x, lane = tid & 63, w = __builtin_amdgcn_readfirstlane(tid >> 6), r32 = lane & 31, hh = lane >> 5;
    const size_t tok = (size_t)tt * 256 + 32 * w + r32;
    const int ksw = (r32 >> 2) & 3;
    float T0[16], T1[16];
#pragma unroll
    for (int p = 0; p < 2; ++p) {
        bf16x8 qf[8];
        const bf16_t* qfrag = qp + ((((size_t)tt * 8 + w) * 8 + h) * 2 + p) * 4096 + hh * 256 + r32 * 8;
#pragma unroll
        for (int ks = 0; ks < 8; ++ks) qf[ks] = *(const bf16x8*)(qfrag + ks * 512);
        f32x16 acc[4];
#pragma unroll
        for (int kt = 0; kt < 4; ++kt)
#pragma unroll
            for (int r = 0; r < 16; ++r) acc[kt][r] = 0.f;
        LAS const unsigned char* kbase = lds + p * 32768 + r32 * 64;
#pragma unroll
        for (int ks = 0; ks < 8; ++ks) {
            const int off = (ks >> 1) * 8192 + (((2 * (ks & 1) + hh) ^ ksw) * 16);
#pragma unroll
            for (int kt = 0; kt < 4; ++kt) { const bf16x8 kf = *(LAS const bf16x8*)(kbase + off + kt * 2048); acc[kt] = __builtin_amdgcn_mfma_f32_32x32x16_bf16(kf, qf[ks], acc[kt], 0, 0, 0); }
        }
        float L[16];
#pragma unroll
        for (int k = 0; k < 16; ++k) L[k] = -INFINITY;
#pragma unroll
        for (int kt = 0; kt < 4; ++kt)
#pragma unroll
            for (int r = 0; r < 16; ++r) { const unsigned key = (unsigned)(32 * kt + (r & 3) + 8 * (r >> 2) + 4 * hh); ins16(L, __uint_as_float((__float_as_uint(acc[kt][r]) & ~127u) | key)); }
        merge_partner(L);
#pragma unroll
        for (int k = 0; k < 16; ++k) { if (p == 0) T0[k] = L[k]; else T1[k] = L[k]; }
    }
    LAS unsigned* tl = (LAS unsigned*)(lds + 65536) + w * 2048 + lane;
#pragma unroll
    for (int k = 0; k < 16; ++k) { tl[k * 64] = __float_as_uint(T0[k]); tl[(16 + k) * 64] = __float_as_uint(T1[k]); }
    float C[16];
#pragma unroll
    for (int k = 0; k < 16; ++k) C[k] = -INFINITY;
#pragma unroll
    for (int i = 0; i < 25; ++i) {
        const float v0 = T0[CT.a[2 * i]] + T1[CT.b[2 * i]], v1 = T0[CT.a[2 * i + 1]] + T1[CT.b[2 * i + 1]];
        const unsigned c0 = (unsigned)(CT.a[2 * i] * 16 + CT.b[2 * i]), c1 = (unsigned)(CT.a[2 * i + 1] * 16 + CT.b[2 * i + 1]);
        const unsigned bits = (__float_as_uint(hh ? v1 : v0) & ~255u) | (hh ? c1 : c0);
        ins16(C, __uint_as_float(bits));
    }
    merge_partner(C);
    const float mx = C[0];
    float sum = 0.f;
#pragma unroll
    for (int k = 0; k < 16; ++k) sum += __expf(C[k] - mx);
    const float inv = 1.f / sum;
    unsigned short io8[8]; f32x4 go4[2];
#pragma unroll
    for (int k = 0; k < 8; ++k) {
        float clo = C[k], chi = C[8 + k]; asm volatile("" : "+v"(clo), "+v"(chi));
        const float cv = hh ? chi : clo;
        const unsigned cb = __float_as_uint(cv), ai = (cb >> 4) & 15u, bi = cb & 15u;
        const unsigned i1 = tl[ai * 64] & 127u, i2 = tl[(16 + bi) * 64] & 127u;
        io8[k] = (unsigned short)((i1 << 7) | i2); go4[k >> 2][k & 3] = __expf(cv - mx) * inv;
    }
    asm volatile("s_waitcnt lgkmcnt(0)" ::: "memory");
    unsigned short* io = idx + tok * 128 + h * 16 + 8 * hh; float* go = gw + tok * 128 + h * 16 + 8 * hh;
    { u32x4 pw; pw.x = io8[0] | ((unsigned)io8[1] << 16); pw.y = io8[2] | ((unsigned)io8[3] << 16); pw.z = io8[4] | ((unsigned)io8[5] << 16); pw.w = io8[6] | ((unsigned)io8[7] << 16); *(u32x4*)io = pw; }
    *(f32x4*)go = go4[0]; *(f32x4*)(go + 4) = go4[1];
}
DEVI void phase(LAS unsigned char* lds, const bf16_t* qp, const bf16_t* subk, unsigned short* idx, float* gw, int vcu, int G) {
    int last_h = -1;
    for (int u = vcu; u < 512; u += G) {
        const int h = u & 7, tt = u >> 3;
        if (h != last_h) {
            asm volatile("s_waitcnt lgkmcnt(0)" ::: "memory"); __builtin_amdgcn_s_barrier(); asm volatile("" ::: "memory");
            stage_keys(lds, subk, h, threadIdx.x); last_h = h;
            asm volatile("s_waitcnt vmcnt(0) lgkmcnt(0)" ::: "memory"); __builtin_amdgcn_s_barrier(); asm volatile("" ::: "memory");
        }
        unit(lds, qp, idx, gw, tt, h);
    }
}
}


namespace swa {
constexpr int KOFF = 0, VOFF = 32768, POFF = 65536, LOFF = 66560, WOFF = 70784;
DEVI s16x4 vtr(LAS const unsigned char* p) { return __builtin_bit_cast(s16x4, __builtin_amdgcn_ds_read_tr16_b64_v4i16((LAS s16x4*)p)); }
DEVI void unit(LAS unsigned char* lds, const bf16_t* proj, const int* pos, const float* sinks, const float* rel, const float* sqg, const float* skg, bf16_t* O, int b, int kvh, int nb) {
    const int tid = threadIdx.x, lane = tid & 63, w = __builtin_amdgcn_readfirstlane(tid >> 6), r32 = lane & 31, hh = lane >> 5;
    const int head = kvh * 8 + w;
    const int tk0 = nb * 128 - 128;
    const size_t rowbase = (size_t)b * SEQ;
    asm volatile("s_waitcnt lgkmcnt(0)" ::: "memory"); __builtin_amdgcn_s_barrier(); asm volatile("" ::: "memory");
#pragma unroll
    for (int i = 0; i < 8; ++i) {
        const int c = tid + 512 * i, isV = c >> 11, rem = c & 2047, row = rem >> 3, ch = rem & 7, kb = ch >> 2, cq = ch & 3;
        const int tk = tk0 + row;
        u32x4 v = (u32x4){0u, 0u, 0u, 0u};
        if (tk >= 0) v = *(const u32x4*)(proj + (rowbase + tk) * PROJ_LD + (isV ? C_SV : C_SK) + kvh * 64 + ch * 8);
        if (i < 4) {
            float f[8]; unpack8(v, f); float ss = 0.f;
#pragma unroll
            for (int e = 0; e < 8; ++e) ss += f[e] * f[e];
            ss += __shfl_xor(ss, 1); ss += __shfl_xor(ss, 2); ss += __shfl_xor(ss, 4);
            const float r = 1.f / sqrtf(ss * (1.f / 64.f) + EPS);
            const f32x4 g0 = *(const f32x4*)(skg + ch * 8), g1 = *(const f32x4*)(skg + ch * 8 + 4);
            f[0] *= r * g0[0]; f[1] *= r * g0[1]; f[2] *= r * g0[2]; f[3] *= r * g0[3]; f[4] *= r * g1[0]; f[5] *= r * g1[1]; f[6] *= r * g1[2]; f[7] *= r * g1[3];
            v = pack8(f);
        }
        const int dst = isV ? (VOFF + kb * 16384 + row * 64 + cq * 16) : (KOFF + kb * 16384 + row * 64 + ((cq ^ ((row >> 2) & 3)) * 16));
        *(LAS u32x4*)(lds + dst) = v;
    }
    LAS int* posk = (LAS int*)(lds + POFF);
    if (tid < 256) posk[tid] = (tk0 + tid >= 0) ? pos[rowbase + tk0 + tid] : 0;
    LAS float* lut = (LAS float*)(lds + LOFF) + w * 132;
    for (int d = lane; d <= 128; d += 64) lut[d] = rel[t5_bucket(d) * 16 + head];
    asm volatile("s_waitcnt vmcnt(0) lgkmcnt(0)" ::: "memory"); __builtin_amdgcn_s_barrier(); asm volatile("" ::: "memory");
    const float sink = sinks[head];
    LAS float* wsf = (LAS float*)(lds + WOFF) + w * 32;
    const int ksw = (r32 >> 2) & 3;
    const int vlane = VOFF + ((lane >> 4) & 1) * 32 + (lane & 3) * 8 + (4 * hh + ((lane & 15) >> 2)) * 64;
#pragma unroll 1
    for (int qs = 0; qs < 4; ++qs) {
        const size_t t = rowbase + nb * 128 + 32 * qs + r32;
        const bf16_t* qrow = proj + t * PROJ_LD + C_SQ + head * 64 + 8 * hh;
        bf16x8 qf[4];
        {
            float qv[4][8]; float ss = 0.f;
#pragma unroll
            for (int ks = 0; ks < 4; ++ks) { unpack8(*(const u32x4*)(qrow + 16 * ks), qv[ks]);
#pragma unroll
                for (int e = 0; e < 8; ++e) ss += qv[ks][e] * qv[ks][e]; }
            ss += __shfl_xor(ss, 32);
            const float r = 0.125f / sqrtf(ss * (1.f / 64.f) + EPS);
#pragma unroll
            for (int ks = 0; ks < 4; ++ks) { const f32x4 g0 = *(const f32x4*)(sqg + 16 * ks + 8 * hh), g1 = *(const f32x4*)(sqg + 16 * ks + 8 * hh + 4);
                qv[ks][0] *= r * g0[0]; qv[ks][1] *= r * g0[1]; qv[ks][2] *= r * g0[2]; qv[ks][3] *= r * g0[3]; qv[ks][4] *= r * g1[0]; qv[ks][5] *= r * g1[1]; qv[ks][6] *= r * g1[2]; qv[ks][7] *= r * g1[3];
                qf[ks] = __builtin_bit_cast(bf16x8, pack8(qv[ks])); }
        }
        const int pq = pos[t];
        f32x16 S[5];
#pragma unroll
        for (int kk = 0; kk < 5; ++kk)
#pragma unroll
            for (int r = 0; r < 16; ++r) S[kk][r] = 0.f;
#pragma unroll
        for (int ks = 0; ks < 4; ++ks) {
            const int off = KOFF + (ks >> 1) * 16384 + (32 * qs + r32) * 64 + (((2 * (ks & 1) + hh) ^ ksw) * 16);
#pragma unroll
            for (int kk = 0; kk < 5; ++kk) { const bf16x8 kf = *(LAS const bf16x8*)(lds + off + kk * 2048); S[kk] = __builtin_amdgcn_mfma_f32_32x32x16_bf16(kf, qf[ks], S[kk], 0, 0, 0); }
        }
        float m = sink;
#pragma unroll
        for (int kk = 0; kk < 5; ++kk)
#pragma unroll
            for (int g = 0; g < 4; ++g) {
                const int jb = 32 * (qs + kk) + 8 * g + 4 * hh;
                const i32x4 pk = *(LAS const i32x4*)(posk + jb);
                const int pkv[4] = {pk[0], pk[1], pk[2], pk[3]};
#pragma unroll
                for (int e = 0; e < 4; ++e) {
                    const int dj = 32 * kk + 8 * g + 4 * hh + e - r32;
                    int d = pq - pkv[e]; d = d < 0 ? 0 : (d > 128 ? 128 : d);
                    const float sv = S[kk][4 * g + e] + lut[d];
                    const bool valid = (dj >= 1) && (dj <= 128) && (tk0 + jb + e >= 0);
                    const float sm = valid ? sv : -INFINITY;
                    S[kk][4 * g + e] = sm; m = fmaxf(m, sm);
                }
            }
        m = fmaxf(m, __shfl_xor(m, 32));
        float ps = 0.f;
#pragma unroll
        for (int kk = 0; kk < 5; ++kk)
#pragma unroll
            for (int r = 0; r < 16; ++r) { const float p = __expf(S[kk][r] - m); S[kk][r] = p; ps += p; }
        ps += __shfl_xor(ps, 32);
        ps += __expf(sink - m);
        f32x16 o[2];
#pragma unroll
        for (int d = 0; d < 2; ++d)
#pragma unroll
            for (int r = 0; r < 16; ++r) o[d][r] = 0.f;
#pragma unroll
        for (int kk = 0; kk < 5; ++kk)
#pragma unroll
            for (int s2 = 0; s2 < 2; ++s2) {
                u32x4 wv; wv.x = pk2(S[kk][8 * s2 + 0], S[kk][8 * s2 + 1]); wv.y = pk2(S[kk][8 * s2 + 2], S[kk][8 * s2 + 3]); wv.z = pk2(S[kk][8 * s2 + 4], S[kk][8 * s2 + 5]); wv.w = pk2(S[kk][8 * s2 + 6], S[kk][8 * s2 + 7]);
                const bf16x8 pf = __builtin_bit_cast(bf16x8, wv);
                LAS const unsigned char* vb = lds + vlane + (32 * (qs + kk) + 16 * s2) * 64;
#pragma unroll
                for (int d = 0; d < 2; ++d) {
                    const s16x4 lo = vtr(vb + d * 16384), hi = vtr(vb + d * 16384 + 512);
                    const bf16x8 vf = (bf16x8){lo[0], lo[1], lo[2], lo[3], hi[0], hi[1], hi[2], hi[3]};
                    o[d] = __builtin_amdgcn_mfma_f32_32x32x16_bf16(pf, vf, o[d], 0, 0, 0);
                }
            }
        if (hh == 0) wsf[r32] = 1.f / ps;
        asm volatile("s_waitcnt lgkmcnt(0)" ::: "memory");
        bf16_t* orow = O + (rowbase + nb * 128 + 32 * qs) * DM + 1024 + head * 64 + r32;
#pragma unroll
        for (int g = 0; g < 4; ++g) { const f32x4 c4 = *(LAS const f32x4*)(wsf + 8 * g + 4 * hh);
#pragma unroll
            for (int e = 0; e < 4; ++e) { const int qr = 8 * g + 4 * hh + e;
#pragma unroll
                for (int d = 0; d < 2; ++d) orow[(size_t)qr * DM + 32 * d] = (bf16_t)f2bf(o[d][4 * g + e] * c4[e]); } }
        asm volatile("s_waitcnt lgkmcnt(0)" ::: "memory");
    }
}
DEVI void phase(LAS unsigned char* lds, const bf16_t* proj, const int* pos, const float* sinks, const float* rel, const float* sqg, const float* skg, bf16_t* O, int vcu, int G) {
    for (int u = vcu; u < 256; u += G) { const int nb = u & 31, bk = u >> 5; unit(lds, proj, pos, sinks, rel, sqg, skg, O, bk >> 1, bk & 1, nb); }
    asm volatile("s_waitcnt lgkmcnt(0)" ::: "memory"); __builtin_amdgcn_s_barrier(); asm volatile("" ::: "memory");
}
}

constexpr int N_PHASES = 14;
struct Args { const void* in[21]; float* out; unsigned char* ws; int ph_lo, ph_hi; };

__global__ void __launch_bounds__(NTHREADS, 2) __attribute__((amdgpu_waves_per_eu(2, 2))) mega_fwd(Args a) {
    extern __shared__ __attribute__((aligned(16))) unsigned char lds_raw[];
    LAS unsigned char* lds = (LAS unsigned char*)lds_raw;
    volatile LAS unsigned* MISC = (volatile LAS unsigned*)(lds + MISC_OFF);
    const int tid = threadIdx.x, lane = tid & 63, wave = __builtin_amdgcn_readfirstlane(tid >> 6);
    const int G = gridDim.x, bx = blockIdx.x;
    const int vcu = (G % 8 == 0) ? (bx % 8) * (G / 8) + bx / 8 : bx;
    const int gw = vcu * NWAVES + wave, NGW = G * NWAVES;

    const float* x = (const float*)a.in[0]; const int* pos = (const int*)a.in[1];
    const float* g1 = (const float*)a.in[2]; const float* w_in = (const float*)a.in[3]; const float* qag = (const float*)a.in[4]; const float* wqb = (const float*)a.in[5];
    const float* kvag = (const float*)a.in[6]; const float* wkvb = (const float*)a.in[7]; const float* mqg = (const float*)a.in[8]; const float* mkg = (const float*)a.in[9];
    const float* sqg = (const float*)a.in[10]; const float* skg = (const float*)a.in[11]; const float* sinks = (const float*)a.in[12]; const float* rel = (const float*)a.in[13];
    const float* gog = (const float*)a.in[14]; const float* wout = (const float*)a.in[15]; const float* g2 = (const float*)a.in[16]; const float* wpq = (const float*)a.in[17];
    const float* subk = (const float*)a.in[18]; const float* pu = (const float*)a.in[19]; const float* pv = (const float*)a.in[20];
    float* out = a.out; unsigned char* ws = a.ws;
    bf16_t* W1T = (bf16_t*)(ws + WS_W1T); bf16_t* WQB = (bf16_t*)(ws + WS_WQB); bf16_t* WKVB = (bf16_t*)(ws + WS_WKVB); bf16_t* WOUT = (bf16_t*)(ws + WS_WOUT);
    bf16_t* WPQ = (bf16_t*)(ws + WS_WPQ); bf16_t* SUBK = (bf16_t*)(ws + WS_SUBK); bf16_t* UB = (bf16_t*)(ws + WS_UB); bf16_t* VB = (bf16_t*)(ws + WS_VB);
    bf16_t* PROJ = (bf16_t*)(ws + WS_PROJ); bf16_t* KV = (bf16_t*)(ws + WS_KV); bf16_t* Q = (bf16_t*)(ws + WS_Q); bf16_t* K = (bf16_t*)(ws + WS_K); bf16_t* ACT = (bf16_t*)(ws + WS_ACT);
    bf16_t* QP = PROJ; unsigned short* IDX = (unsigned short*)(ws + WS_Q); float* GWT = (float*)(ws + WS_Q + 8 * MiB); signed char* WEX = (signed char*)(ws + WS_Q + 16 * MiB); float* WSC = (float*)(ws + WS_CTL + 512 * 1024); bf16_t* AP = (bf16_t*)(ws + WS_PROJ);
    float* LATP = (float*)(ws + WS_CTL + 1024 * 1024);
    bf16_t* HB = (bf16_t*)(ws + WS_Q + 24 * MiB); float* SSQH = (float*)(ws + WS_CTL + 64 * 1024);
    signed char* HB8 = (signed char*)(ws + WS_ACT); float* HSC = (float*)(ws + WS_CTL + 448 * 1024);
    unsigned char* U8 = ws + WS_UB; unsigned char* V8 = ws + WS_VB; float* USC = (float*)(ws + WS_CTL + 256 * 1024); float* VSC = (float*)(ws + WS_CTL + 384 * 1024);

    for (int u = tid; u < (LDS_BYTES - RING_BYTES) / 4; u += NTHREADS) ((LAS unsigned*)(lds + RING_BYTES))[u] = 0u;
    __syncthreads();
    XcdBarrier bar = xcd_barrier_post((unsigned*)(ws + WS_CTL) + 1024, MISC + 8);
    const int lo = a.ph_lo, hi = a.ph_hi;
#define IN(k) (lo <= (k) && (k) < hi)
#define SEAM(k) do { if (IN(k) && IN((k) + 1)) xcd_barrier(bar); } while (0)

    if (IN(0)) {
        LAS float* scr = (LAS float*)(lds + wave * 16384);
        constexpr int I1 = 32 * 66, I2 = 8 * 48, I3 = 4 * 64, I4 = 32 * 64, I5 = 32 * 64;
        for (int it = gw; it < I1 + I2 + I3 + I4 + I5; it += NGW) {
            int r = it;
            if (r < I1) { transpose_item(w_in, W1T, nullptr, 2048, 2112, 1, r, scr, lane); continue; } r -= I1;
            if (r < I2) { transpose_item(wqb, WQB, qag, 512, 1536, 0, r, scr, lane); continue; } r -= I2;
            if (r < I3) { transpose_item(wkvb, WKVB, kvag, 256, 2048, 2, r, scr, lane); continue; } r -= I3;
            if (r < I4) { transpose_item(wout, WOUT, gog, 2048, 2048, 0, r, scr, lane); continue; } r -= I4;
            transpose_item(wpq, WPQ, g2, 2048, 2048, 0, r, scr, lane);
        }
        const size_t gtid = (size_t)vcu * NTHREADS + tid, nthr = (size_t)G * NTHREADS;
        for (size_t i = gtid; i < (size_t)192 * 2048 / 2; i += nthr) ((unsigned*)(W1T + (size_t)2112 * 2048))[i] = 0u;
        convert_range(subk, SUBK, (size_t)8 * 2 * 128 * 128 / 8, nullptr, 128, gtid, nthr);
        { f32x4 cur[8], nxt[8];
          if (gw < T) {
#pragma unroll
              for (int j = 0; j < 8; ++j) cur[j] = *(const f32x4*)(x + (size_t)gw * DM + 4 * (lane + 64 * j));
          }
          for (int t = gw; t < T; t += NGW) {
              const bool more = t + NGW < T;
              if (more) {
#pragma unroll
                  for (int j = 0; j < 8; ++j) nxt[j] = *(const f32x4*)(x + (size_t)(t + NGW) * DM + 4 * (lane + 64 * j));
              }
              norm1_regs(cur, g1, ACT + (size_t)t * DM, lane);
              if (more) {
#pragma unroll
                  for (int j = 0; j < 8; ++j) cur[j] = nxt[j];
              }
          } }
    }
    SEAM(0);
    if (IN(1)) {
        pg8::Gemm g{ACT, W1T, T, PROJ_LD, DM, DM, DM}; pg8::StaticOrder S; S.init(T, PROJ_LD, G, bx);
        pg8::EpiBf16 E{PROJ, PROJ_LD, nullptr, 0.f, nullptr, 0, 0, LATP, 3};
        pg8::gemm_phase<pg8::EpiBf16, pg8::StaticOrder, true>(lds, g, S, E);
        { const int nfull = (T / 256) * (PROJ_LD / 256) % G;
          const int nconv = G - nfull;
          if (nfull == 0 || nconv <= 0) { peer::convert_rows<true>(pu, g2, U8, USC, gw, NGW, 16384, lane); peer::convert_rows<false>(pv, nullptr, V8, VSC, gw, NGW, 16384, lane); }
          else if (bx >= nfull) { const int cw = (bx - nfull) * NWAVES + wave, cs = nconv * NWAVES;
              peer::convert_rows<true>(pu, g2, U8, USC, cw, cs, 16384, lane); peer::convert_rows<false>(pv, nullptr, V8, VSC, cw, cs, 16384, lane); } }
    }
    SEAM(1);
    if (IN(3)) {
        { pg8::Gemm g{PROJ + C_QLAT, WQB, T, 1536, 512, PROJ_LD, 512}; pg8::StaticOrder S; S.init(T, 1536, G, bx);
          pg8::EpiBf16 E{ACT, QK_LD, nullptr, 1.f / 512.f, LATP, 0, 8, nullptr, 0};
          pg8::gemm_phase<pg8::EpiBf16, pg8::StaticOrder, true>(lds, g, S, E); }
        { pg8::Gemm g{PROJ + C_KVLAT, WKVB, T, 2048, 256, PROJ_LD, 256}; pg8::StaticOrder S; S.init(T, 2048, G, bx);
          pg8::EpiBf16 E{KV, KV_LD, nullptr, 1.f / 256.f, LATP, 8, 4, nullptr, 0};
          pg8::gemm_phase<pg8::EpiBf16, pg8::StaticOrder, true>(lds, g, S, E); }
    }
    SEAM(3);
    if (IN(4)) {
        for (int t = gw; t < T; t += NGW)
            p3_row(ACT + (size_t)t * QK_LD, KV + (size_t)t * KV_LD, PROJ + (size_t)t * PROJ_LD + C_KPE, pos[t], mqg, mkg, Q + (size_t)t * QK_LD, K + (size_t)t * QK_LD, lane);
    }
    SEAM(4);
    if (IN(5)) {
        mla::phase(lds, Q, K, KV, ACT, vcu, G);
        swa::phase(lds, PROJ, pos, sinks, rel, sqg, skg, ACT, vcu, G);
    }
    SEAM(5);
    if (IN(6)) { for (int t = gw; t < T; t += NGW) p4_row(ACT + (size_t)t * DM, lane); }
    SEAM(6);
    if (IN(7)) {
        pg8::Gemm g{ACT, WOUT, T, DM, DM, DM, DM}; pg8::StaticOrder S; S.init(T, DM, G, bx);
        pg8::EpiResid E{x, out, HB, SSQH, DM};
        pg8::gemm_phase<pg8::EpiResid, pg8::StaticOrder, true>(lds, g, S, E);
    }
    SEAM(7);
    if (IN(9)) {
        pg8::Gemm g{HB, WPQ, T, DM, DM, DM, DM}; pg8::StaticOrder S; S.init(T, DM, G, bx);
        pg8::EpiQp E{QP, SSQH, 1.f / DM};
        pg8::gemm_phase<pg8::EpiQp, pg8::StaticOrder, true>(lds, g, S, E);
    }
    SEAM(9);
    if (IN(10)) {
        for (int t = gw; t < T; t += NGW) peer::h_to_int8(HB + (size_t)t * DM, SSQH[t], HB8 + (size_t)t * DM, HSC + t, lane);
        topk::phase(lds, QP, SUBK, IDX, GWT, vcu, G);
    }
    SEAM(10);
    if (IN(11)) {
        for (int vb = bx; vb < 256; vb += G) { const int grp = vb & 7, rank = vb >> 3, t0 = rank * 512 + wave * 64;
            peer::sliceA(HB8, U8, IDX, AP, grp, t0, 64, lane); peer::sliceA(HB8, U8, IDX, AP, grp + 8, t0, 64, lane); }
    }
    SEAM(11);
    if (IN(12)) { for (int t = gw; t < T; t += NGW) peer::rowA2(AP, IDX, GWT, USC, VSC, SSQH, HSC, WEX, WSC, (size_t)t, lane); }
    SEAM(12);
    if (IN(13)) {
        for (int vb = bx; vb < 256; vb += G) { const int grp = vb & 7, rank = vb >> 3, t0 = rank * 512 + wave * 64;
            peer::sliceB(V8, IDX, WEX, WSC, HB, out, grp, t0, 64, lane); peer::sliceB(V8, IDX, WEX, WSC, HB, out, grp + 8, t0, 64, lane); }
    }
#undef IN
#undef SEAM
}

#ifndef MK_N_LAUNCHES
#define MK_N_LAUNCHES 1
#endif
extern "C" void kernel_launch(void* const* d_in, const int* in_sizes, int n_in, void* d_out, int out_size, void* d_ws, size_t ws_size, hipStream_t stream) {
    static int grid = 0;
    if (grid == 0) {
        if (n_in != 21 || ws_size < WS_END || out_size != T * DM) { fprintf(stderr, "kernel_launch: unexpected problem (n_in %d, ws %zu, out %d)\n", n_in, ws_size, out_size); grid = -1; return; }
        int dev = 0, cus = 0;
        if (hipGetDevice(&dev) != hipSuccess || hipDeviceGetAttribute(&cus, hipDeviceAttributeMultiprocessorCount, dev) != hipSuccess) { grid = -1; return; }
        if (hipFuncSetAttribute((const void*)mega_fwd, hipFuncAttributeMaxDynamicSharedMemorySize, LDS_BYTES) != hipSuccess) { fprintf(stderr, "kernel_launch: hipFuncSetAttribute failed\n"); grid = -1; return; }
        int per_cu = 0;
        if (hipOccupancyMaxActiveBlocksPerMultiprocessor(&per_cu, (const void*)mega_fwd, NTHREADS, LDS_BYTES) != hipSuccess || per_cu < 1) { fprintf(stderr, "kernel_launch: occupancy query says %d\n", per_cu); }
        (void)hipGetLastError();
        grid = cus;
    }
    if (grid < 0) return;
    (void)hipMemsetAsync((char*)d_ws + WS_CTL, 0, CTL_ZERO_BYTES, stream);
    Args a{};
    for (int i = 0; i < 21; ++i) a.in[i] = d_in[i];
    a.out = (float*)d_out; a.ws = (unsigned char*)d_ws;
    if (MK_N_LAUNCHES == 1) { a.ph_lo = 0; a.ph_hi = N_PHASES; hipLaunchKernelGGL(mega_fwd, dim3(grid), dim3(NTHREADS), LDS_BYTES, stream, a); }
    else for (int p = 0; p < N_PHASES; ++p) { a.ph_lo = p; a.ph_hi = p + 1; hipLaunchKernelGGL(mega_fwd, dim3(grid), dim3(NTHREADS), LDS_BYTES, stream, a); }
}
```

```cpp
#include <hip/hip_runtime.h>
#include <stdint.h>
#include <stdio.h>

#define DEVI __device__ __forceinline__
#define LAS __attribute__((address_space(3)))
typedef unsigned short bf16_t;
typedef short bf16x8 __attribute__((ext_vector_type(8)));
typedef float f32x4 __attribute__((ext_vector_type(4)));
typedef unsigned u32x4 __attribute__((ext_vector_type(4)));
typedef unsigned u32x2 __attribute__((ext_vector_type(2)));
typedef int i32x4 __attribute__((ext_vector_type(4)));

constexpr int BATCH = 4, SEQ = 4096, DM = 2048, T = BATCH * SEQ;
constexpr int PROJ_LD = 2304;
constexpr int C_QLAT = 0, C_KVLAT = 512, C_SQ = 768, C_SK = 1792, C_SV = 1920, C_KPE = 2048;
constexpr int QK_LD = 1536;
constexpr int KV_LD = 2048;
constexpr float EPS = 1e-6f;
constexpr float LOG2E = 1.4426950408889634f;
constexpr int NWAVES = 8, NTHREADS = 512;

constexpr size_t MiB = 1u << 20;
constexpr size_t WS_CTL = 0, CTL_ZERO_BYTES = 128 * 1024;
constexpr size_t WS_W1T = 2 * MiB;
constexpr size_t WS_WQB = 11 * MiB;
constexpr size_t WS_WKVB = 13 * MiB;
constexpr size_t WS_WOUT = 14 * MiB;
constexpr size_t WS_WPQ = 22 * MiB;
constexpr size_t WS_SUBK = 30 * MiB;
constexpr size_t WS_UB = 32 * MiB;
constexpr size_t WS_VB = 96 * MiB;
constexpr size_t WS_PROJ = 160 * MiB;
constexpr size_t WS_KV = 232 * MiB;
constexpr size_t WS_Q = 296 * MiB;
constexpr size_t WS_K = 344 * MiB;
constexpr size_t WS_ACT = 392 * MiB;
constexpr size_t WS_END = 456 * MiB;

constexpr int RING_BYTES = 131072;
constexpr int MISC_OFF = RING_BYTES + 320;
constexpr int LDS_BYTES = 147456;

__device__ const float kInvFreq[32] = {
    1.000000000e+00f, 7.498942018e-01f, 5.623413324e-01f, 4.216965139e-01f, 3.162277639e-01f, 2.371373773e-01f, 1.778279394e-01f, 1.333521456e-01f,
    1.000000015e-01f, 7.498942316e-02f, 5.623413250e-02f, 4.216964915e-02f, 3.162277490e-02f, 2.371373773e-02f, 1.778279431e-02f, 1.333521400e-02f,
    9.999999776e-03f, 7.498942316e-03f, 5.623413250e-03f, 4.216964822e-03f, 3.162277630e-03f, 2.371373819e-03f, 1.778279431e-03f, 1.333521446e-03f,
    1.000000047e-03f, 7.498941850e-04f, 5.623413017e-04f, 4.216965172e-04f, 3.162277571e-04f, 2.371373703e-04f, 1.778279402e-04f, 1.333521504e-04f};

DEVI float bf2f(unsigned h) { return __uint_as_float((h & 0xffffu) << 16); }
typedef float f32x2_t __attribute__((ext_vector_type(2)));
typedef __bf16 bf16x2_t __attribute__((ext_vector_type(2)));
DEVI unsigned pk2(float lo, float hi) { const f32x2_t v = {lo, hi}; const bf16x2_t b = __builtin_convertvector(v, bf16x2_t); return __builtin_bit_cast(unsigned, b); }
DEVI unsigned f2bf(float f) { return pk2(f, 0.f) & 0xffffu; }
DEVI float wave_sum(float v) {
#pragma unroll
    for (int o = 1; o < 64; o <<= 1) v += __shfl_xor(v, o);
    return v;
}
DEVI void unpack8(const u32x4 w, float* f) {
    f[0] = __uint_as_float(w.x << 16); f[1] = __uint_as_float(w.x & 0xffff0000u);
    f[2] = __uint_as_float(w.y << 16); f[3] = __uint_as_float(w.y & 0xffff0000u);
    f[4] = __uint_as_float(w.z << 16); f[5] = __uint_as_float(w.z & 0xffff0000u);
    f[6] = __uint_as_float(w.w << 16); f[7] = __uint_as_float(w.w & 0xffff0000u);
}
DEVI u32x4 pack8(const float* f) { u32x4 w; w.x = pk2(f[0], f[1]); w.y = pk2(f[2], f[3]); w.z = pk2(f[4], f[5]); w.w = pk2(f[6], f[7]); return w; }
DEVI float gelu_tanh(float a) {
    const float z = 0.7978845608028654f * (a + 0.044715f * a * a * a);
    const float e = __expf(2.f * z);
    const float th = 1.f - 2.f / (e + 1.f);
    return 0.5f * a * (1.f + th);
}

namespace pg8 {
constexpr int BM = 256, BK = 64, HALF = 128, HTB = HALF * BK * 2, STAGE_BYTES = 8 * HTB, NXCD = 8, WGM = 8;
DEVI int lds_byte(int r, int c) { const int st = (r >> 4) * 2 + (c >> 5), rr = r & 15, cc = c & 31, ob = rr * 64 + cc * 2; return st * 1024 + (ob ^ (((ob >> 9) & 1) << 5)); }
DEVI void stage_rc(int b, int& R, int& C) { const int st = b / 1024, sb = b % 1024, swz = sb ^ (((sb >> 9) & 1) << 5); R = (st >> 1) * 16 + swz / 64; C = (st & 1) * 32 + (swz % 64) / 2; }
DEVI int perm32(int rho) { const int n = rho >> 4, i = rho & 15; return 8 * (i >> 2) + 4 * n + (i & 3); }
struct Unit { int pm, pn; };
struct Gemm { const bf16_t* A; const bf16_t* Bt; int M, N, K, lda, ldb; };
struct StaticOrder {
    int nM, nN, nwg, G, c;
    DEVI void init(int M, int N, int G_, int c_) { nM = M / BM; nN = N / BM; nwg = nM * nN; G = G_; c = c_; }
    DEVI bool next(int i, Unit& u) const {
        const long L = (long)i * G + c; if (L >= nwg) return false;
        int wgid = (int)L; { const int q = nwg / NXCD, r = nwg % NXCD, xcd = wgid % NXCD, off = wgid / NXCD; wgid = (xcd < r ? xcd * (q + 1) : r * (q + 1) + (xcd - r) * q) + off; }
        const int nig = WGM * nN, gid = wgid / nig, fm = gid * WGM, gsz = (nM - fm) < WGM ? (nM - fm) : WGM;
        u.pm = fm + ((wgid % nig) % gsz); u.pn = (wgid % nig) / gsz; return true;
    }
};
DEVI unsigned cvt_pk_bf16(float lo, float hi) { unsigned r; asm volatile("v_cvt_pk_bf16_f32 %0, %1, %2" : "=v"(r) : "v"(lo), "v"(hi)); return r; }
struct EpiBf16 {
    static constexpr bool PERM = true;
    bf16_t* O; int ldc;
    const float* ssq; float inv_n;
    const float* part; int pbase, pcnt;
    float* part_out; int pn_lim;
    DEVI void operator()(const f32x4 (&acc)[2][2][4][2], const Unit& u, int wr, int wc, int fr, int fq) const {
        const int row0 = u.pm * BM + wr * 64 + fr, col0 = u.pn * BM + wc * 32 + 8 * fq;
        const bool wr_part = part_out && u.pn < pn_lim;
#pragma unroll
        for (int ai = 0; ai < 2; ++ai)
#pragma unroll
            for (int m = 0; m < 4; ++m) { const int row = row0 + ai * HALF + m * 16; bf16_t* rowp = O + (size_t)row * ldc + col0;
                float rs = 1.f;
                if (ssq) rs = 1.f / sqrtf(ssq[row] * inv_n + EPS);
                else if (part) { float sq = 0.f; for (int j = 0; j < pcnt; ++j) sq += part[(size_t)row * 12 + pbase + j]; rs = 1.f / sqrtf(sq * inv_n + EPS); }
                float ss = 0.f;
#pragma unroll
                for (int bj = 0; bj < 2; ++bj) { const f32x4 v0 = acc[ai][bj][m][0] * rs, v1 = acc[ai][bj][m][1] * rs;
                    u32x4 w; w.x = cvt_pk_bf16(v0[0], v0[1]); w.y = cvt_pk_bf16(v0[2], v0[3]); w.z = cvt_pk_bf16(v1[0], v1[1]); w.w = cvt_pk_bf16(v1[2], v1[3]);
                    *(u32x4*)(rowp + bj * HALF) = w;
                    ss += v0[0] * v0[0] + v0[1] * v0[1] + v0[2] * v0[2] + v0[3] * v0[3] + v1[0] * v1[0] + v1[1] * v1[1] + v1[2] * v1[2] + v1[3] * v1[3]; }
                if (wr_part) { ss += __shfl_xor(ss, 16); ss += __shfl_xor(ss, 32); if (fq == 0) part_out[(size_t)row * 12 + 4 * u.pn + wc] = ss; } }
    }
};
struct EpiQp {
    static constexpr bool PERM = true;
    bf16_t* O; const float* ssq; float inv_n;
    DEVI void operator()(const f32x4 (&acc)[2][2][4][2], const Unit& u, int wr, int wc, int fr, int fq) const {
        const int row0 = u.pm * BM + wr * 64 + fr;
#pragma unroll
        for (int ai = 0; ai < 2; ++ai)
#pragma unroll
            for (int m = 0; m < 4; ++m) { const int row = row0 + ai * HALF + m * 16;
                const float rs = 1.f / sqrtf(ssq[row] * inv_n + EPS);
#pragma unroll
                for (int bj = 0; bj < 2; ++bj) { const f32x4 v0 = acc[ai][bj][m][0] * rs, v1 = acc[ai][bj][m][1] * rs;
                    u32x4 w; w.x = cvt_pk_bf16(v0[0], v0[1]); w.y = cvt_pk_bf16(v0[2], v0[3]); w.z = cvt_pk_bf16(v1[0], v1[1]); w.w = cvt_pk_bf16(v1[2], v1[3]);
                    *(u32x4*)(O + ((((size_t)(row >> 5) * 8 + u.pn) * 2 + bj) * 16 + 4 * wc + fq) * 256 + (row & 31) * 8) = w; } }
    }
};
struct EpiResid {
    static constexpr bool PERM = true;
    const float* X; float* O; bf16_t* HB; float* ssq; int ldc;
    DEVI void operator()(const f32x4 (&acc)[2][2][4][2], const Unit& u, int wr, int wc, int fr, int fq) const {
        const int row0 = u.pm * BM + wr * 64 + fr, col0 = u.pn * BM + wc * 32 + 8 * fq;
#pragma unroll
        for (int ai = 0; ai < 2; ++ai)
#pragma unroll
            for (int m = 0; m < 4; ++m) { const int row = row0 + ai * HALF + m * 16; const size_t off = (size_t)row * ldc + col0;
                float ss = 0.f;
#pragma unroll
                for (int bj = 0; bj < 2; ++bj) {
                    const f32x4 h0 = *(const f32x4*)(X + off + bj * HALF) + acc[ai][bj][m][0], h1 = *(const f32x4*)(X + off + bj * HALF + 4) + acc[ai][bj][m][1];
                    u32x4 w; w.x = cvt_pk_bf16(h0[0], h0[1]); w.y = cvt_pk_bf16(h0[2], h0[3]); w.z = cvt_pk_bf16(h1[0], h1[1]); w.w = cvt_pk_bf16(h1[2], h1[3]);
                    *(u32x4*)(HB + off + bj * HALF) = w;
                    ss += h0[0] * h0[0] + h0[1] * h0[1] + h0[2] * h0[2] + h0[3] * h0[3] + h1[0] * h1[0] + h1[1] * h1[1] + h1[2] * h1[2] + h1[3] * h1[3]; }
                ss += __shfl_xor(ss, 16); ss += __shfl_xor(ss, 32);
                if (fq == 0) atomicAdd(ssq + row, ss); }
    }
};

template <class Epi, class Sched, bool ALIGN_EPI>
DEVI void gemm_phase(LAS unsigned char* lds, const Gemm g, const Sched& S, const Epi& E) {
    const int tid = threadIdx.x, wid = __builtin_amdgcn_readfirstlane(tid >> 6), lane = tid & 63, wr = wid >> 2, wc = wid & 3, fr = lane & 15, fq = lane >> 4;
    const int K = g.K, nt = K / BK;
    unsigned voffA[2], voffB[2];
#pragma unroll
    for (int i = 0; i < 2; ++i) { int R, C; stage_rc(tid * 16 + i * 8192, R, C); const int Rb = Epi::PERM ? ((R & ~31) + perm32(R & 31)) : R;
        voffA[i] = (unsigned)(R * g.lda + C) * 2u; voffB[i] = (unsigned)(Rb * g.ldb + C) * 2u; }
    const size_t kstep = (size_t)(BK * 2);
    const size_t hA = (size_t)HALF * g.lda * 2, hB = (size_t)HALF * g.ldb * 2, tA = 2 * hA, tB = 2 * hB;
    const unsigned ldsw = (unsigned)wid * 1024u;
    const int aoff = lds_byte(wr * 64 + fr, fq * 8), boff = lds_byte(wc * 32 + fr, fq * 8);
#define PG8_SA(b, h) (((b) * 2 + (h)) * HTB)
#define PG8_SB(b, h) ((4 + (b) * 2 + (h)) * HTB)
#define PG8_STAGE(bufoff, gbase, voff) do { _Pragma("unroll") for (int _i = 0; _i < 2; ++_i) \
        __builtin_amdgcn_global_load_lds((const unsigned*)((const char*)(gbase) + (voff)[_i]), (LAS unsigned*)(lds + (bufoff) + ldsw + _i * 8192), 16, 0, 0); } while (0)
#define PG8_LDA(dst, b, h) do { _Pragma("unroll") for (int m = 0; m < 4; ++m) _Pragma("unroll") for (int k = 0; k < 2; ++k) dst[m][k] = *(const LAS bf16x8*)(lds + PG8_SA(b, h) + aoff + m * 2048 + k * 1024); } while (0)
#define PG8_LDB(dst, b, h) do { _Pragma("unroll") for (int n = 0; n < 2; ++n) _Pragma("unroll") for (int k = 0; k < 2; ++k) dst[n][k] = *(const LAS bf16x8*)(lds + PG8_SB(b, h) + boff + n * 2048 + k * 1024); } while (0)
#define PG8_MMA(ai, bj, At, Bt) do { __builtin_amdgcn_s_setprio(1); _Pragma("unroll") for (int m = 0; m < 4; ++m) _Pragma("unroll") for (int n = 0; n < 2; ++n) _Pragma("unroll") for (int k = 0; k < 2; ++k) \
        acc[ai][bj][m][n] = __builtin_amdgcn_mfma_f32_16x16x32_bf16(Bt[n][k], At[m][k], acc[ai][bj][m][n], 0, 0, 0); __builtin_amdgcn_s_setprio(0); } while (0)
#define PG8_WAIT_V(n) asm volatile("s_waitcnt vmcnt(" #n ")" ::: "memory")
#define PG8_WAIT_L(n) asm volatile("s_waitcnt lgkmcnt(" #n ")" ::: "memory")
#define PG8_BAR __builtin_amdgcn_s_barrier()
#define PG8_SCHED __builtin_amdgcn_sched_barrier(0)
    Unit cur, nxt; int ui = 0;
    if (!S.next(0, cur)) return;
    f32x4 acc[2][2][4][2];
#pragma unroll
    for (int a = 0; a < 2; ++a)
#pragma unroll
        for (int b = 0; b < 2; ++b)
#pragma unroll
            for (int m = 0; m < 4; ++m)
#pragma unroll
                for (int n = 0; n < 2; ++n) acc[a][b][m][n] = (f32x4){0.f, 0.f, 0.f, 0.f};
    bf16x8 At[4][2], B0[2][2], B1[2][2];
    const char* cA = (const char*)g.A + (size_t)cur.pm * tA; const char* cB = (const char*)g.Bt + (size_t)cur.pn * tB;
    PG8_STAGE(PG8_SB(0, 0), cB, voffB); PG8_STAGE(PG8_SB(0, 1), cB + hB, voffB); PG8_STAGE(PG8_SA(0, 0), cA, voffA); PG8_STAGE(PG8_SA(0, 1), cA + hA, voffA);
    if (wr == 1) PG8_BAR;
    PG8_WAIT_V(2); PG8_BAR;
    PG8_STAGE(PG8_SB(1, 0), cB + kstep, voffB); PG8_STAGE(PG8_SA(1, 0), cA + kstep, voffA); PG8_STAGE(PG8_SB(1, 1), cB + hB + kstep, voffB);
    PG8_WAIT_V(6); PG8_BAR;
    for (;;) {
        const bool has_next = S.next(ui + 1, nxt);
        const char* nA = has_next ? (const char*)g.A + (size_t)nxt.pm * tA : cA; const char* nB = has_next ? (const char*)g.Bt + (size_t)nxt.pn * tB : cB;
        for (int t = 0; t < nt; t += 2) {
            const bool last = (t == nt - 2);
            const char* a1 = cA + (size_t)(t + 1) * kstep;
            const char* a2 = last ? nA : cA + (size_t)(t + 2) * kstep; const char* b2 = last ? nB : cB + (size_t)(t + 2) * kstep;
            const char* a3 = a2 + kstep; const char* b3 = b2 + kstep;
            PG8_LDB(B0, 0, 0); PG8_LDB(B1, 0, 1); PG8_SCHED; PG8_LDA(At, 0, 0); PG8_STAGE(PG8_SA(1, 1), a1 + hA, voffA);
            PG8_WAIT_V(8); PG8_WAIT_L(0); PG8_BAR; PG8_MMA(0, 0, At, B0); PG8_MMA(0, 1, At, B1); PG8_BAR; PG8_SCHED;
            PG8_LDA(At, 0, 1); PG8_STAGE(PG8_SB(0, 0), b2, voffB); PG8_STAGE(PG8_SB(0, 1), b2 + hB, voffB); PG8_STAGE(PG8_SA(0, 0), a2, voffA);
            PG8_WAIT_V(8); PG8_WAIT_L(0); PG8_BAR; PG8_MMA(1, 0, At, B0); PG8_MMA(1, 1, At, B1); PG8_BAR; PG8_SCHED;
            PG8_LDB(B0, 1, 0); PG8_LDB(B1, 1, 1); PG8_SCHED; PG8_LDA(At, 1, 0); PG8_STAGE(PG8_SA(0, 1), a2 + hA, voffA);
            PG8_WAIT_V(8); PG8_WAIT_L(0); PG8_BAR; PG8_MMA(0, 0, At, B0); PG8_MMA(0, 1, At, B1); PG8_BAR; PG8_SCHED;
            PG8_LDA(At, 1, 1); PG8_STAGE(PG8_SB(1, 0), b3, voffB); PG8_STAGE(PG8_SB(1, 1), b3 + hB, voffB); PG8_STAGE(PG8_SA(1, 0), a3, voffA);
            PG8_WAIT_V(8); PG8_WAIT_L(0); PG8_BAR; PG8_MMA(1, 0, At, B0); PG8_MMA(1, 1, At, B1); PG8_BAR; PG8_SCHED;
        }
        if constexpr (ALIGN_EPI) { if (wr == 0) PG8_BAR; }
        E(acc, cur, wr, wc, fr, fq);
        if (!has_next) break;
#pragma unroll
        for (int a = 0; a < 2; ++a)
#pragma unroll
            for (int b = 0; b < 2; ++b)
#pragma unroll
                for (int m = 0; m < 4; ++m)
#pragma unroll
                    for (int n = 0; n < 2; ++n) acc[a][b][m][n] = (f32x4){0.f, 0.f, 0.f, 0.f};
        cur = nxt; cA = nA; cB = nB; ++ui;
        if constexpr (ALIGN_EPI) { if (wr == 1) PG8_BAR; }
    }
    PG8_WAIT_V(0);
    if constexpr (!ALIGN_EPI) { if (wr == 0) PG8_BAR; }
    PG8_BAR;
#undef PG8_SA
#undef PG8_SB
#undef PG8_STAGE
#undef PG8_LDA
#undef PG8_LDB
#undef PG8_MMA
#undef PG8_WAIT_V
#undef PG8_WAIT_L
#undef PG8_BAR
#undef PG8_SCHED
}
}

#define XB_TMO      128
#define XB_XCNT(j)  (256  + 64 * (j))
#define XB_XSUB(j)  (1280 + 64 * (j))
#define XB_XGEN(j)  (2304 + 64 * (j))
#define XB_TOP      3328
#define XB_TOPGEN   3392
#define XCD_BAR_WORDS 3456
#define XB_SPIN_CAP (1u << 18)
DEVI unsigned xb_ld(unsigned* p)              { return __hip_atomic_load(p, __ATOMIC_RELAXED, __HIP_MEMORY_SCOPE_AGENT); }
DEVI unsigned xb_add(unsigned* p, unsigned v) { return __hip_atomic_fetch_add(p, v, __ATOMIC_RELAXED, __HIP_MEMORY_SCOPE_AGENT); }
DEVI unsigned xb_xcc_id() { return (unsigned)__builtin_amdgcn_s_getreg((3 << 11) | 20) & 0xFu; }
#define XB_SPIN(cond, bar) do { unsigned _sp = 0; while (cond) { __builtin_amdgcn_s_sleep(1); \
    if ((++_sp & 255u) == 0u) { if (xb_ld(&(bar)[XB_TMO])) break; if (_sp > XB_SPIN_CAP) { atomicAdd(&(bar)[XB_TMO], 1u); break; } } } } while (0)
struct XcdBarrier { unsigned* bar; unsigned x; volatile LAS unsigned* st; };
DEVI XcdBarrier xcd_barrier_post(unsigned* bar, volatile LAS unsigned* st) {
    XcdBarrier b; b.bar = bar; b.x = xb_xcc_id(); b.st = st;
    if (threadIdx.x == 0) (void)xb_add(&bar[XB_XCNT(b.x)], 1u);
    return b;
}
DEVI void xcd_barrier_complete(unsigned* bar, unsigned x, unsigned& nloc, unsigned& nx) {
    const unsigned G = gridDim.x * gridDim.y * gridDim.z;
    unsigned sum, cnt, mine, sp = 0u;
    for (;;) {
        sum = 0u; cnt = 0u; mine = 0u;
#pragma unroll
        for (unsigned j = 0; j < 16; ++j) { const unsigned c = xb_ld(&bar[XB_XCNT(j)]); sum += c; cnt += (c > 0u) ? 1u : 0u; mine = (j == x) ? c : mine; }
        if (sum == G) break;
        __builtin_amdgcn_s_sleep(1);
        if ((++sp & 255u) == 0u) { if (xb_ld(&bar[XB_TMO])) break; if (sp > XB_SPIN_CAP) { atomicAdd(&bar[XB_TMO], 1u); break; } }
    }
    nloc = mine > 0u ? mine : 1u; nx = cnt > 0u ? cnt : 1u;
}
DEVI void xcd_barrier(const XcdBarrier& b) {
    asm volatile("s_waitcnt vmcnt(0)" ::: "memory");
    __syncthreads();
    if (threadIdx.x == 0) {
        unsigned* bar = b.bar;
        __builtin_amdgcn_s_waitcnt(0);
        unsigned nloc = b.st[0], nx = b.st[1];
        if (nloc == 0u) { xcd_barrier_complete(bar, b.x, nloc, nx); b.st[0] = nloc; b.st[1] = nx; }
        const unsigned old = xb_add(&bar[XB_XSUB(b.x)], 1u);
        const unsigned gen = old / nloc;
        if (old + 1u == (gen + 1u) * nloc) {
            __builtin_amdgcn_fence(__ATOMIC_RELEASE, "agent");
            asm volatile("s_waitcnt vmcnt(0)" ::: "memory");
            const unsigned og = xb_add(&bar[XB_TOP], 1u);
            const unsigned tg = og / nx;
            if (og + 1u == (tg + 1u) * nx) xb_add(&bar[XB_TOPGEN], 1u);
            else XB_SPIN(xb_ld(&bar[XB_TOPGEN]) == tg, bar);
            __builtin_amdgcn_fence(__ATOMIC_ACQUIRE, "agent");
            xb_add(&bar[XB_XGEN(b.x)], 1u);
            asm volatile("s_waitcnt vmcnt(0)" ::: "memory");
        } else {
            XB_SPIN(xb_ld(&bar[XB_XGEN(b.x)]) == gen, bar);
            __builtin_amdgcn_fence(__ATOMIC_ACQUIRE, "agent");
            asm volatile("s_waitcnt vmcnt(0)" ::: "memory");
        }
    }
    __syncthreads();
}

struct TJob { const float* W; bf16_t* WT; const float* gain; int K, N, mode, pad; };
DEVI int dst_row(int mode, int n) {
    if (mode == 1) return n < 768 ? n : (n < 832 ? 2048 + (n - 768) : n - 64);
    if (mode == 2) { const int h = n >> 8, j = n & 255; return j < 128 ? h * 128 + j : 1024 + h * 128 + (j - 128); }
    return n;
}
DEVI void transpose_item(const float* W, bf16_t* WT, const float* gain, int K, int N, int mode, int item, LAS float* scr, int lane) {
    const int nblk = N / 32, kb = item / nblk, nb = item % nblk, k0 = 64 * kb, n0 = 32 * nb;
    {
        const int kr = lane >> 3, nc = (lane & 7) * 4;
        f32x4 v[8];
#pragma unroll
        for (int i = 0; i < 8; ++i) v[i] = *(const f32x4*)(W + (size_t)(k0 + 8 * i + kr) * N + n0 + nc);
#pragma unroll
        for (int i = 0; i < 8; ++i) { const int kk = 8 * i + kr; const float g = gain ? gain[k0 + kk] : 1.f;
            scr[kk * 33 + nc] = v[i][0] * g; scr[kk * 33 + nc + 1] = v[i][1] * g; scr[kk * 33 + nc + 2] = v[i][2] * g; scr[kk * 33 + nc + 3] = v[i][3] * g; }
    }
    asm volatile("s_waitcnt lgkmcnt(0)" ::: "memory");
    const int c = lane & 7;
#pragma unroll
    for (int jj = 0; jj < 4; ++jj) {
        const int n = (lane >> 3) + 8 * jj; const LAS float* s = scr + (8 * c) * 33 + n;
        u32x4 o; o.x = pk2(s[0 * 33], s[1 * 33]); o.y = pk2(s[2 * 33], s[3 * 33]); o.z = pk2(s[4 * 33], s[5 * 33]); o.w = pk2(s[6 * 33], s[7 * 33]);
        *(u32x4*)(WT + (size_t)dst_row(mode, n0 + n) * K + k0 + 8 * c) = o;
    }
    asm volatile("s_waitcnt lgkmcnt(0)" ::: "memory");
}
DEVI void convert_range(const float* src, bf16_t* dst, size_t n8, const float* gain, int ncols, size_t gtid, size_t nthr) {
    for (size_t i = gtid; i < n8; i += nthr) {
        const f32x4 a = *(const f32x4*)(src + i * 8), b = *(const f32x4*)(src + i * 8 + 4);
        float f[8] = {a.x, a.y, a.z, a.w, b.x, b.y, b.z, b.w};
        if (gain) { const int c = (int)((i * 8) % (size_t)ncols); const f32x4 g0 = *(const f32x4*)(gain + c), g1 = *(const f32x4*)(gain + c + 4);
            f[0] *= g0.x; f[1] *= g0.y; f[2] *= g0.z; f[3] *= g0.w; f[4] *= g1.x; f[5] *= g1.y; f[6] *= g1.z; f[7] *= g1.w; }
        *(u32x4*)(dst + i * 8) = pack8(f);
    }
}
DEVI void norm1_regs(const f32x4 (&v)[8], const float* g, bf16_t* orow, int lane) {
    float s = 0.f;
#pragma unroll
    for (int j = 0; j < 8; ++j) s += v[j].x * v[j].x + v[j].y * v[j].y + v[j].z * v[j].z + v[j].w * v[j].w;
    const float r = 1.f / sqrtf(wave_sum(s) * (1.f / DM) + EPS);
#pragma unroll
    for (int j = 0; j < 8; ++j) { const f32x4 gg = *(const f32x4*)(g + 4 * (lane + 64 * j));
        u32x2 o; o.x = pk2(v[j].x * r * gg.x, v[j].y * r * gg.y); o.y = pk2(v[j].z * r * gg.z, v[j].w * r * gg.w);
        *(u32x2*)(orow + 4 * (lane + 64 * j)) = o; }
}
DEVI void norm1_row(const float* xrow, const float* g, bf16_t* orow, int lane) {
    f32x4 v[8]; float s = 0.f;
#pragma unroll
    for (int j = 0; j < 8; ++j) { v[j] = *(const f32x4*)(xrow + 4 * (lane + 64 * j)); s += v[j].x * v[j].x + v[j].y * v[j].y + v[j].z * v[j].z + v[j].w * v[j].w; }
    const float r = 1.f / sqrtf(wave_sum(s) * (1.f / DM) + EPS);
#pragma unroll
    for (int j = 0; j < 8; ++j) { const f32x4 gg = *(const f32x4*)(g + 4 * (lane + 64 * j));
        u32x2 o; o.x = pk2(v[j].x * r * gg.x, v[j].y * r * gg.y); o.y = pk2(v[j].z * r * gg.z, v[j].w * r * gg.w);
        *(u32x2*)(orow + 4 * (lane + 64 * j)) = o; }
}
DEVI void p2_row(bf16_t* p, const float* sqg, const float* skg, int lane) {
    {
        u32x4 w = *(const u32x4*)(p + C_QLAT + lane * 8); float f[8]; unpack8(w, f); float s = 0.f;
#pragma unroll
        for (int i = 0; i < 8; ++i) s += f[i] * f[i];
        const float r = 1.f / sqrtf(wave_sum(s) * (1.f / 512.f) + EPS);
#pragma unroll
        for (int i = 0; i < 8; ++i) f[i] *= r;
        *(u32x4*)(p + C_QLAT + lane * 8) = pack8(f);
    }
    {
        u32x2 w = *(const u32x2*)(p + C_KVLAT + lane * 4);
        float f0 = __uint_as_float(w.x << 16), f1 = __uint_as_float(w.x & 0xffff0000u), f2 = __uint_as_float(w.y << 16), f3 = __uint_as_float(w.y & 0xffff0000u);
        const float r = 1.f / sqrtf(wave_sum(f0 * f0 + f1 * f1 + f2 * f2 + f3 * f3) * (1.f / 256.f) + EPS);
        u32x2 o; o.x = pk2(f0 * r, f1 * r); o.y = pk2(f2 * r, f3 * r);
        *(u32x2*)(p + C_KVLAT + lane * 4) = o;
    }
    {
        u32x4 w0 = *(const u32x4*)(p + C_SQ + lane * 16), w1 = *(const u32x4*)(p + C_SQ + lane * 16 + 8); float f[16]; unpack8(w0, f); unpack8(w1, f + 8); float s = 0.f;
#pragma unroll
        for (int i = 0; i < 16; ++i) s += f[i] * f[i];
        s += __shfl_xor(s, 1); s += __shfl_xor(s, 2);
        const float r = 0.125f / sqrtf(s * (1.f / 64.f) + EPS);
        const int d0 = (lane & 3) * 16;
#pragma unroll
        for (int i = 0; i < 16; ++i) f[i] *= r * sqg[d0 + i];
        *(u32x4*)(p + C_SQ + lane * 16) = pack8(f); *(u32x4*)(p + C_SQ + lane * 16 + 8) = pack8(f + 8);
    }
    {
        unsigned w = *(const unsigned*)(p + C_SK + lane * 2);
        float f0 = __uint_as_float(w << 16), f1 = __uint_as_float(w & 0xffff0000u);
        float s = f0 * f0 + f1 * f1;
#pragma unroll
        for (int o = 1; o < 32; o <<= 1) s += __shfl_xor(s, o);
        const float r = 1.f / sqrtf(s * (1.f / 64.f) + EPS);
        const int d0 = (lane & 31) * 2;
        *(unsigned*)(p + C_SK + lane * 2) = pk2(f0 * r * skg[d0], f1 * r * skg[d0 + 1]);
    }
}
DEVI void p3_row(const bf16_t* qraw, const bf16_t* kvrow, const bf16_t* kpe, int pos, const float* qg, const float* kg, bf16_t* Qo, bf16_t* Ko, int lane) {
    const int hd = lane >> 3, sub = lane & 7;
    float cs[8], sn[8];
#pragma unroll
    for (int e = 0; e < 8; ++e) {
        const float ang = (float)pos * kInvFreq[8 * (sub & 3) + e];
        const double rev = (double)ang * 0.15915494309189535;
        const float fr = (float)(rev - floor(rev));
        sn[e] = __builtin_amdgcn_sinf(fr); cs[e] = __builtin_amdgcn_cosf(fr);
    }
    const float qscale = 0.07216878364870322f * LOG2E;
#pragma unroll
    for (int which = 0; which < 2; ++which) {
        const float* gn = which ? kg : qg;
        u32x4 w0, w1, w2;
        if (which == 0) { const bf16_t* qh = qraw + hd * 192; w0 = *(const u32x4*)(qh + 8 * sub); w1 = *(const u32x4*)(qh + 64 + 8 * sub); w2 = *(const u32x4*)(qh + 128 + 8 * sub); }
        else { const bf16_t* kh = kvrow + hd * 128; w0 = *(const u32x4*)(kh + 8 * sub); w1 = *(const u32x4*)(kh + 64 + 8 * sub); w2 = *(const u32x4*)(kpe + 8 * sub); }
        float f0[8], f1[8], f2[8]; unpack8(w0, f0); unpack8(w1, f1); unpack8(w2, f2);
        float ss = 0.f;
#pragma unroll
        for (int e = 0; e < 8; ++e) ss += f0[e] * f0[e] + f1[e] * f1[e] + f2[e] * f2[e];
        ss += __shfl_xor(ss, 1); ss += __shfl_xor(ss, 2); ss += __shfl_xor(ss, 4);
        const float r = (which ? 1.f : qscale) / sqrtf(ss * (1.f / 192.f) + EPS);
        const f32x4 ga = *(const f32x4*)(gn + 8 * sub), gb = *(const f32x4*)(gn + 8 * sub + 4), gc = *(const f32x4*)(gn + 64 + 8 * sub), gd = *(const f32x4*)(gn + 64 + 8 * sub + 4),
                    ge = *(const f32x4*)(gn + 128 + 8 * sub), gf = *(const f32x4*)(gn + 128 + 8 * sub + 4);
        const float g0[8] = {ga[0], ga[1], ga[2], ga[3], gb[0], gb[1], gb[2], gb[3]}, g1[8] = {gc[0], gc[1], gc[2], gc[3], gd[0], gd[1], gd[2], gd[3]}, g2[8] = {ge[0], ge[1], ge[2], ge[3], gf[0], gf[1], gf[2], gf[3]};
        float ro[8];
#pragma unroll
        for (int e = 0; e < 8; ++e) { f0[e] *= r * g0[e]; f1[e] *= r * g1[e]; f2[e] *= r * g2[e]; }
#pragma unroll
        for (int e = 0; e < 8; ++e) { const float pr = __shfl_xor(f2[e], 4); ro[e] = (sub < 4) ? (f2[e] * cs[e] - pr * sn[e]) : (f2[e] * cs[e] + pr * sn[e]); }
        bf16_t* dst = (which ? Ko : Qo) + hd * 192;
        *(u32x4*)(dst + 8 * sub) = pack8(f0); *(u32x4*)(dst + 64 + 8 * sub) = pack8(f1); *(u32x4*)(dst + 128 + 8 * sub) = pack8(ro);
    }
}
DEVI void mla_row(const bf16_t* Q, const bf16_t* K, const bf16_t* KV, bf16_t* O, int b, int h, int q, int lane) {
    const size_t t = (size_t)b * SEQ + q;
    const bf16_t* qp = Q + t * QK_LD + h * 192;
    const float q0 = bf2f(qp[lane]), q1 = bf2f(qp[64 + lane]), q2 = bf2f(qp[128 + lane]);
    float m = -INFINITY, l = 0.f, o0 = 0.f, o1 = 0.f;
    const bf16_t* kb = K + (size_t)b * SEQ * QK_LD + h * 192;
    const bf16_t* vb = KV + (size_t)b * SEQ * KV_LD + 1024 + h * 128;
#pragma unroll 4
    for (int j = 0; j <= q; ++j) {
        const bf16_t* kr = kb + (size_t)j * QK_LD; const bf16_t* vr = vb + (size_t)j * KV_LD;
        const float s = wave_sum(q0 * bf2f(kr[lane]) + q1 * bf2f(kr[64 + lane]) + q2 * bf2f(kr[128 + lane]));
        const float v0 = bf2f(vr[lane]), v1 = bf2f(vr[64 + lane]);
        const float mn = fmaxf(m, s), c = exp2f(m - mn), p = exp2f(s - mn);
        l = l * c + p; o0 = o0 * c + p * v0; o1 = o1 * c + p * v1; m = mn;
    }
    const float il = 1.f / l;
    O[t * DM + h * 128 + lane] = (bf16_t)f2bf(o0 * il); O[t * DM + h * 128 + 64 + lane] = (bf16_t)f2bf(o1 * il);
}
DEVI int t5_bucket(int dist) {
    const int n = dist > 0 ? dist : 0;
    if (n < 16) return n;
    const float nf = (float)n;
    int large = 16 + (int)(logf(nf / 16.f) / 2.0794415416798357f * 16.f);
    return large < 31 ? large : 31;
}
DEVI void swa_row(const bf16_t* proj, const int* pos, const float* sinks, const float* rel, bf16_t* O, int b, int hh, int q, int lane) {
    const int kvh = hh >> 3;
    const size_t t = (size_t)b * SEQ + q;
    const float qv = bf2f(proj[t * PROJ_LD + C_SQ + hh * 64 + lane]);
    const float sink = sinks[hh];
    float m = sink, l = 1.f, o = 0.f;
    const int pq = pos[t];
    const int j0 = q - 127 > 0 ? q - 127 : 0;
#pragma unroll 4
    for (int j = j0; j <= q; ++j) {
        const size_t tk = (size_t)b * SEQ + j;
        const float kx = bf2f(proj[tk * PROJ_LD + C_SK + kvh * 64 + lane]), vx = bf2f(proj[tk * PROJ_LD + C_SV + kvh * 64 + lane]);
        const float s = wave_sum(qv * kx) + rel[t5_bucket(pq - pos[tk]) * 16 + hh];
        const float mn = fmaxf(m, s), c = __expf(m - mn), p = __expf(s - mn);
        l = l * c + p; o = o * c + p * vx; m = mn;
    }
    O[t * DM + 1024 + hh * 64 + lane] = (bf16_t)f2bf(o / l);
}
DEVI void p4_row(bf16_t* p, int lane) {
    float f[4][8]; float sa = 0.f, sb = 0.f;
#pragma unroll
    for (int i = 0; i < 4; ++i) { unpack8(*(const u32x4*)(p + lane * 8 + 512 * i), f[i]);
        float s = 0.f;
#pragma unroll
        for (int e = 0; e < 8; ++e) s += f[i][e] * f[i][e];
        if (i < 2) sa += s; else sb += s; }
    const float ra = 1.f / sqrtf(wave_sum(sa) * (1.f / 1024.f) + EPS), rb = 1.f / sqrtf(wave_sum(sb) * (1.f / 1024.f) + EPS);
#pragma unroll
    for (int i = 0; i < 4; ++i) { const float r = i < 2 ? ra : rb;
#pragma unroll
        for (int e = 0; e < 8; ++e) f[i][e] *= r;
        *(u32x4*)(p + lane * 8 + 512 * i) = pack8(f[i]); }
}
DEVI void p5_row(const float* hrow, bf16_t* orow, int lane) {
    f32x4 v[8]; float s = 0.f;
#pragma unroll
    for (int j = 0; j < 8; ++j) { v[j] = *(const f32x4*)(hrow + 4 * (lane + 64 * j)); s += v[j].x * v[j].x + v[j].y * v[j].y + v[j].z * v[j].z + v[j].w * v[j].w; }
    const float r = 1.f / sqrtf(wave_sum(s) * (1.f / DM) + EPS);
#pragma unroll
    for (int j = 0; j < 8; ++j) { u32x2 o; o.x = pk2(v[j].x * r, v[j].y * r); o.y = pk2(v[j].z * r, v[j].w * r); *(u32x2*)(orow + 4 * (lane + 64 * j)) = o; }
}
DEVI void topk_task(const bf16_t* qp, const bf16_t* subk, int* idx, float* gw, size_t t, int h, int lane) {
    float tv[2]; int ti[2];
#pragma unroll
    for (int p = 0; p < 2; ++p) {
        const bf16_t* qs = qp + t * DM + h * 256 + p * 128;
        const float qlo = bf2f(qs[lane]), qhi = bf2f(qs[64 + lane]);
        const bf16_t* k0 = subk + ((size_t)(h * 2 + p) * 128 + lane) * 128; const bf16_t* k1 = k0 + 64 * 128;
        float a0 = 0.f, a1 = 0.f;
        for (int d = 0; d < 64; ++d) { const float qd = __shfl(qlo, d); a0 += qd * bf2f(k0[d]); a1 += qd * bf2f(k1[d]); }
        for (int d = 0; d < 64; ++d) { const float qd = __shfl(qhi, d); a0 += qd * bf2f(k0[64 + d]); a1 += qd * bf2f(k1[64 + d]); }
        float v0 = a0, v1 = a1; float mytv = -INFINITY; int myti = 0;
        for (int r = 0; r < 16; ++r) {
            float bv = v0 >= v1 ? v0 : v1; int bi = v0 >= v1 ? lane : lane + 64;
#pragma unroll
            for (int o = 32; o >= 1; o >>= 1) { const float ov = __shfl_xor(bv, o); const int oi = __shfl_xor(bi, o); if (ov > bv || (ov == bv && oi < bi)) { bv = ov; bi = oi; } }
            if (lane == r) { mytv = bv; myti = bi; }
            if (bi == lane) v0 = -INFINITY;
            if (bi == lane + 64) v1 = -INFINITY;
        }
        tv[p] = mytv; ti[p] = myti;
    }
    float cv[4];
#pragma unroll
    for (int mm = 0; mm < 4; ++mm) { const int c = lane + 64 * mm; cv[mm] = __shfl(tv[0], c >> 4) + __shfl(tv[1], c & 15); }
    float mys = -INFINITY; int myc = 0;
    for (int r = 0; r < 16; ++r) {
        float bv = cv[0]; int bc = lane;
#pragma unroll
        for (int mm = 1; mm < 4; ++mm) if (cv[mm] > bv) { bv = cv[mm]; bc = lane + 64 * mm; }
#pragma unroll
        for (int o = 32; o >= 1; o >>= 1) { const float ov = __shfl_xor(bv, o); const int oc = __shfl_xor(bc, o); if (ov > bv || (ov == bv && oc < bc)) { bv = ov; bc = oc; } }
        if (lane == r) { mys = bv; myc = bc; }
#pragma unroll
        for (int mm = 0; mm < 4; ++mm) if (bc == lane + 64 * mm) cv[mm] = -INFINITY;
    }
    const int i1 = __shfl(ti[0], (myc >> 4) & 15), i2 = __shfl(ti[1], myc & 15);
    float mx = mys;
#pragma unroll
    for (int o = 8; o >= 1; o >>= 1) mx = fmaxf(mx, __shfl_xor(mx, o));
    const float e = __expf(mys - mx); float sm = e;
#pragma unroll
    for (int o = 8; o >= 1; o >>= 1) sm += __shfl_xor(sm, o);
    if (lane < 16) { idx[t * 128 + h * 16 + lane] = i1 * 128 + i2; gw[t * 128 + h * 16 + lane] = e / sm; }
}
DEVI void gather_token(const bf16_t* hn, const bf16_t* Ub, const bf16_t* Vb, const int* idx, const float* gw, float* out, size_t t, int lane) {
    float hv[4][8];
#pragma unroll
    for (int i = 0; i < 4; ++i) unpack8(*(const u32x4*)(hn + t * DM + lane * 8 + 512 * i), hv[i]);
    float y[4][8];
#pragma unroll
    for (int i = 0; i < 4; ++i)
#pragma unroll
        for (int e = 0; e < 8; ++e) y[i][e] = 0.f;
#pragma unroll 2
    for (int k = 0; k < 128; ++k) {
        const int ex = idx[t * 128 + k]; const float g = gw[t * 128 + k];
        const bf16_t* ur = Ub + (size_t)ex * DM + lane * 8; const bf16_t* vr = Vb + (size_t)ex * DM + lane * 8;
        u32x4 uw[4], vw[4];
#pragma unroll
        for (int i = 0; i < 4; ++i) { uw[i] = *(const u32x4*)(ur + 512 * i); vw[i] = *(const u32x4*)(vr + 512 * i); }
        float d = 0.f;
#pragma unroll
        for (int i = 0; i < 4; ++i) { float f[8]; unpack8(uw[i], f);
#pragma unroll
            for (int e = 0; e < 8; ++e) d += f[e] * hv[i][e]; }
        const float a = wave_sum(d);
        const float wgt = g * gelu_tanh(a);
#pragma unroll
        for (int i = 0; i < 4; ++i) { float f[8]; unpack8(vw[i], f);
#pragma unroll
            for (int e = 0; e < 8; ++e) y[i][e] += wgt * f[e]; }
    }
#pragma unroll
    for (int i = 0; i < 4; ++i) { float* o = out + t * DM + lane * 8 + 512 * i;
        f32x4 a = *(const f32x4*)o, b = *(const f32x4*)(o + 4);
        a.x += y[i][0]; a.y += y[i][1]; a.z += y[i][2]; a.w += y[i][3]; b.x += y[i][4]; b.y += y[i][5]; b.z += y[i][6]; b.w += y[i][7];
        *(f32x4*)o = a; *(f32x4*)(o + 4) = b; }
}


typedef float f32x16 __attribute__((ext_vector_type(16)));
typedef short s16x4 __attribute__((ext_vector_type(4)));
namespace mla {
constexpr int SLOT = 40960, KOFF = 0, VOFF = 24576, NSLOT = 3, WS_OFF = NSLOT * SLOT;
DEVI int crow(int r, int hh) { return (r & 3) + 8 * (r >> 2) + 4 * hh; }
DEVI void glds16(const void* gsrc, unsigned lds_dst) { unsigned keep;
    asm volatile("s_mov_b32 %0, m0\n\ts_mov_b32 m0, %2\n\ts_nop 0\n\tglobal_load_lds_dwordx4 %1, off\n\ts_mov_b32 m0, %0" : "=&s"(keep) : "v"(gsrc), "s"(lds_dst) : "memory"); }
DEVI s16x4 vtr(LAS const unsigned char* p) { return __builtin_bit_cast(s16x4, __builtin_amdgcn_ds_read_tr16_b64_v4i16((LAS s16x4*)p)); }

DEVI void unit(LAS unsigned char* lds, const bf16_t* Q, const bf16_t* K, const bf16_t* KV, bf16_t* O, int b, int h, int qb) {
    const int tid = threadIdx.x, lane = tid & 63, w = __builtin_amdgcn_readfirstlane(tid >> 6), r32 = lane & 31, hh = lane >> 5;
    const int grp = w >> 2;
    const int q0 = qb * 256; const size_t rowbase = (size_t)b * SEQ;
    const int NT = (q0 + 256) / 64;
    const int prow = 8 * w + (lane >> 3);
    const char* kg = (const char*)(K + (rowbase + prow) * QK_LD + h * 192 + 8 * ((lane & 7) ^ ((prow >> 1) & 7)));
    const char* vg = (const char*)(KV + (rowbase + prow) * KV_LD + 1024 + h * 128 + 8 * (((((lane & 7) >> 2) ^ ((prow >> 1) & 1)) << 2) | (lane & 3)));
    const unsigned kdst = (unsigned)(KOFF + w * 1024), vdst = (unsigned)(VOFF + w * 1024);
    const unsigned lds0 = (unsigned)(uintptr_t)lds;
#define MLA_ISSUE(t, slotoff) do { \
        const char* kp_ = kg + (size_t)(t) * 64 * QK_LD * 2; const char* vp_ = vg + (size_t)(t) * 64 * KV_LD * 2; \
        _Pragma("unroll") for (int i_ = 0; i_ < 3; ++i_) glds16(kp_ + i_ * 128, (unsigned)__builtin_amdgcn_readfirstlane((int)(lds0 + (slotoff) + kdst + i_ * 8192))); \
        _Pragma("unroll") for (int i_ = 0; i_ < 2; ++i_) glds16(vp_ + i_ * 128, (unsigned)__builtin_amdgcn_readfirstlane((int)(lds0 + (slotoff) + vdst + i_ * 8192))); } while (0)
    MLA_ISSUE(0, 0); MLA_ISSUE(1, SLOT);
    const bf16_t* qrow = Q + (rowbase + q0 + 32 * w + r32) * QK_LD + h * 192 + 8 * hh;
    bf16x8 qf[12];
#pragma unroll
    for (int ks = 0; ks < 12; ++ks) qf[ks] = *(const bf16x8*)(qrow + 16 * ks);
#pragma unroll
    for (int ks = 0; ks < 12; ++ks) asm volatile("" : "+v"(qf[ks]));
    f32x16 o[4];
#pragma unroll
    for (int d = 0; d < 4; ++d)
#pragma unroll
        for (int r = 0; r < 16; ++r) o[d][r] = 0.f;
    float mref = 0.f, lsum = 0.f;
    LAS float* wsf = (LAS float*)(lds + WS_OFF) + w * 32;
    const int ksw = (r32 >> 1) & 7;
    const int vread = VOFF + ((lane >> 4) & 1) * 32 + (lane & 3) * 8 + (4 * hh + ((lane & 15) >> 2)) * 128;
    asm volatile("s_waitcnt vmcnt(5)" ::: "memory");
    __builtin_amdgcn_s_barrier();
    asm volatile("" ::: "memory");
#define MLA_BAR() do { asm volatile("s_waitcnt lgkmcnt(0)" ::: "memory"); __builtin_amdgcn_s_barrier(); asm volatile("" ::: "memory"); } while (0)
#define MLA_PREFETCH(i) do { if ((i) + 2 < NT) { const int so_ = (((i) + 2) % 3) * SLOT; MLA_ISSUE((i) + 2, so_); } } while (0)
#define MLA_LANDED(i) do { if ((i) + 2 < NT) asm volatile("s_waitcnt vmcnt(5)" ::: "memory"); else asm volatile("s_waitcnt vmcnt(0)" ::: "memory"); } while (0)
    if (grp) MLA_BAR();
    for (int t = 0; t < NT; ++t) {
        const int slot = (t % 3) * SLOT;
        if (grp) MLA_PREFETCH(t);
        f32x16 s0, s1;
        {
            unsigned kr[4];
#pragma unroll
            for (int j = 0; j < 4; ++j) kr[j] = lds0 + (unsigned)(slot + KOFF + r32 * 128 + (((2 * j + hh) ^ ksw) * 16));
#define MLA_KLD(ks, d0, d1) do { asm volatile("ds_read_b128 %0, %1 offset:%2" : "=&v"(d0) : "v"(kr[(ks) & 3]), "i"(((ks) >> 2) * 8192)); \
                                 asm volatile("ds_read_b128 %0, %1 offset:%2" : "=&v"(d1) : "v"(kr[(ks) & 3]), "i"(((ks) >> 2) * 8192 + 4096)); } while (0)
            bf16x8 ka[3], kb[3];
            __builtin_amdgcn_s_setprio(1);
            MLA_KLD(0, ka[0], kb[0]); MLA_KLD(1, ka[1], kb[1]);
#pragma unroll
            for (int ks = 0; ks < 12; ++ks) {
                if (ks + 2 < 12) { MLA_KLD(ks + 2, ka[(ks + 2) % 3], kb[(ks + 2) % 3]); asm volatile("s_waitcnt lgkmcnt(4)" : "+v"(ka[ks % 3]), "+v"(kb[ks % 3])); }
                else if (ks + 1 < 12) asm volatile("s_waitcnt lgkmcnt(2)" : "+v"(ka[ks % 3]), "+v"(kb[ks % 3]));
                else asm volatile("s_waitcnt lgkmcnt(0)" : "+v"(ka[ks % 3]), "+v"(kb[ks % 3]));
                if (ks == 0) { f32x16 z;
#pragma unroll
                    for (int r = 0; r < 16; ++r) z[r] = 0.f;
                    s0 = __builtin_amdgcn_mfma_f32_32x32x16_bf16(ka[0], qf[0], z, 0, 0, 0); s1 = __builtin_amdgcn_mfma_f32_32x32x16_bf16(kb[0], qf[0], z, 0, 0, 0); }
                else { s0 = __builtin_amdgcn_mfma_f32_32x32x16_bf16(ka[ks % 3], qf[ks], s0, 0, 0, 0); s1 = __builtin_amdgcn_mfma_f32_32x32x16_bf16(kb[ks % 3], qf[ks], s1, 0, 0, 0); }
            }
#undef MLA_KLD
            __builtin_amdgcn_s_setprio(0);
        }
        if (grp) MLA_LANDED(t);
        MLA_BAR();
        if (!grp) MLA_PREFETCH(t);
        {
            const int jb = t - (NT - 4);
            if (jb >= 0) {
                const int qrel = 32 * w + r32, kb_ = 64 * jb + 4 * hh;
#pragma unroll
                for (int r = 0; r < 16; ++r) { const int kv = kb_ + (r & 3) + 8 * (r >> 2); if (kv > qrel) s0[r] = -INFINITY; if (kv + 32 > qrel) s1[r] = -INFINITY; }
            }
            float ma = fmaxf(fmaxf(s0[0], s0[1]), s1[0]), mb = fmaxf(fmaxf(s0[2], s0[3]), s1[1]);
            ma = fmaxf(fmaxf(ma, s1[2]), s1[3]);
#pragma unroll
            for (int r = 4; r < 16; r += 4) { ma = fmaxf(fmaxf(ma, s0[r]), s0[r + 1]); mb = fmaxf(fmaxf(mb, s0[r + 2]), s0[r + 3]); ma = fmaxf(fmaxf(ma, s1[r]), s1[r + 1]); mb = fmaxf(fmaxf(mb, s1[r + 2]), s1[r + 3]); }
            float rm = fmaxf(ma, mb) - mref;
            rm = fmaxf(rm, __shfl_xor(rm, 32));
            if (__any(rm > 8.f)) {
                const float dl = fmaxf(rm, 0.f);
                mref += dl;
                const float corr = __builtin_amdgcn_exp2f(-dl);
                lsum *= corr;
                if (hh == 0) wsf[r32] = corr;
                asm volatile("s_waitcnt lgkmcnt(0)" ::: "memory");
#pragma unroll
                for (int g = 0; g < 4; ++g) { const f32x4 c4 = *(LAS const f32x4*)(wsf + 8 * g + 4 * hh);
#pragma unroll
                    for (int d = 0; d < 4; ++d) { o[d][4 * g + 0] *= c4[0]; o[d][4 * g + 1] *= c4[1]; o[d][4 * g + 2] *= c4[2]; o[d][4 * g + 3] *= c4[3]; } }
                asm volatile("s_waitcnt lgkmcnt(0)" ::: "memory");
            }
            float ps = 0.f;
#pragma unroll
            for (int r = 0; r < 16; ++r) { s0[r] = __builtin_amdgcn_exp2f(s0[r] - mref); s1[r] = __builtin_amdgcn_exp2f(s1[r] - mref); ps += s0[r] + s1[r]; }
            lsum += ps;
            bf16x8 pf[4];
#pragma unroll
            for (int ks = 0; ks < 4; ++ks) {
                u32x4 wv;
                if (ks < 2) { wv.x = pk2(s0[8 * ks + 0], s0[8 * ks + 1]); wv.y = pk2(s0[8 * ks + 2], s0[8 * ks + 3]); wv.z = pk2(s0[8 * ks + 4], s0[8 * ks + 5]); wv.w = pk2(s0[8 * ks + 6], s0[8 * ks + 7]); }
                else { const int k2 = ks - 2; wv.x = pk2(s1[8 * k2 + 0], s1[8 * k2 + 1]); wv.y = pk2(s1[8 * k2 + 2], s1[8 * k2 + 3]); wv.z = pk2(s1[8 * k2 + 4], s1[8 * k2 + 5]); wv.w = pk2(s1[8 * k2 + 6], s1[8 * k2 + 7]); }
                pf[ks] = __builtin_bit_cast(bf16x8, wv);
            }
            const unsigned rb64 = (unsigned)(((lane >> 3) & 1) * 64);
            const unsigned va0 = lds0 + (unsigned)(slot + vread) + rb64, va1 = lds0 + (unsigned)(slot + vread) + (64u - rb64);
            s16x4 vlo[3], vhi[3];
#define MLA_VLD(i, b) do { if (((i) >> 2) & 1) { asm volatile("ds_read_b64_tr_b16 %0, %1 offset:%2" : "=&v"(vlo[b]) : "v"(va1), "i"(((i) >> 3) * 8192 + ((i) & 3) * 2048)); \
                                                 asm volatile("ds_read_b64_tr_b16 %0, %1 offset:%2" : "=&v"(vhi[b]) : "v"(va1), "i"(((i) >> 3) * 8192 + ((i) & 3) * 2048 + 1024)); } \
                           else { asm volatile("ds_read_b64_tr_b16 %0, %1 offset:%2" : "=&v"(vlo[b]) : "v"(va0), "i"(((i) >> 3) * 8192 + ((i) & 3) * 2048)); \
                                  asm volatile("ds_read_b64_tr_b16 %0, %1 offset:%2" : "=&v"(vhi[b]) : "v"(va0), "i"(((i) >> 3) * 8192 + ((i) & 3) * 2048 + 1024)); } } while (0)
            __builtin_amdgcn_s_setprio(1);
            MLA_VLD(0, 0); MLA_VLD(1, 1);
#pragma unroll
            for (int i = 0; i < 16; ++i) {
                if (i + 2 < 16) { MLA_VLD(i + 2, (i + 2) % 3); asm volatile("s_waitcnt lgkmcnt(4)" : "+v"(vlo[i % 3]), "+v"(vhi[i % 3])); }
                else if (i + 1 < 16) asm volatile("s_waitcnt lgkmcnt(2)" : "+v"(vlo[i % 3]), "+v"(vhi[i % 3]));
                else asm volatile("s_waitcnt lgkmcnt(0)" : "+v"(vlo[i % 3]), "+v"(vhi[i % 3]));
                const s16x4 lo = vlo[i % 3], hi = vhi[i % 3];
                const bf16x8 vf = (bf16x8){lo[0], lo[1], lo[2], lo[3], hi[0], hi[1], hi[2], hi[3]};
                o[i >> 2] = __builtin_amdgcn_mfma_f32_32x32x16_bf16(pf[i & 3], vf, o[i >> 2], 0, 0, 0);
            }
#undef MLA_VLD
            __builtin_amdgcn_s_setprio(0);
        }
        if (!grp) MLA_LANDED(t);
        MLA_BAR();
    }
    if (!grp) MLA_BAR();
#undef MLA_BAR
#undef MLA_PREFETCH
#undef MLA_LANDED
    lsum += __shfl_xor(lsum, 32);
    if (hh == 0) wsf[r32] = 1.f / lsum;
    asm volatile("s_waitcnt lgkmcnt(0)" ::: "memory");
    bf16_t* orow = O + (rowbase + q0 + 32 * w) * DM + h * 128 + r32;
#pragma unroll
    for (int g = 0; g < 4; ++g) { const f32x4 c4 = *(LAS const f32x4*)(wsf + 8 * g + 4 * hh);
#pragma unroll
        for (int e = 0; e < 4; ++e) { const int qr = 8 * g + 4 * hh + e;
#pragma unroll
            for (int d = 0; d < 4; ++d) orow[(size_t)qr * DM + 32 * d] = (bf16_t)f2bf(o[d][4 * g + e] * c4[e]); } }
    asm volatile("s_waitcnt lgkmcnt(0)" ::: "memory");
    __builtin_amdgcn_s_barrier();
    asm volatile("" ::: "memory");
#undef MLA_ISSUE
}
DEVI void phase(LAS unsigned char* lds, const bf16_t* Q, const bf16_t* K, const bf16_t* KV, bf16_t* O, int vcu, int G) {
    for (int p = vcu; p < 256; p += G) {
        const int bh = p >> 3, s = p & 7;
        unit(lds, Q, K, KV, O, bh >> 3, bh & 7, 15 - s);
        unit(lds, Q, K, KV, O, bh >> 3, bh & 7, s);
    }
}
}


namespace peer {
typedef float f32x2 __attribute__((ext_vector_type(2)));
DEVI float rl(float v, int l) { return __builtin_bit_cast(float, __builtin_amdgcn_readlane(__builtin_bit_cast(int, v), l)); }
DEVI void convert_load(f32x4 (&v)[8], const float* src, int lane) {
#pragma unroll
    for (int i = 0; i < 8; ++i) v[i] = *(const f32x4*)(src + 256 * i + 4 * lane);
}
template <bool HAS_GAIN, bool INT8> DEVI void convert_finish(f32x4 (&v)[8], const f32x4 (&gn)[8], unsigned char* dst, float* scale_inv, int lane) {
    float am = 0.f;
#pragma unroll
    for (int i = 0; i < 8; ++i) { f32x4 x = v[i]; if (HAS_GAIN) x = x * gn[i];
        v[i] = x; am = fmaxf(am, fmaxf(fmaxf(fabsf(x[0]), fabsf(x[1])), fmaxf(fabsf(x[2]), fabsf(x[3])))); }
#pragma unroll
    for (int o = 1; o < 64; o <<= 1) am = fmaxf(am, __shfl_xor(am, o));
    const float top = INT8 ? 127.f : 256.f;
    const float sc = am > 0.f ? top / am : 1.f;
#pragma unroll
    for (int i = 0; i < 8; ++i) { const f32x4 x = v[i] * sc; int p;
        if (INT8) { const int q0 = __float2int_rn(x[0]), q1 = __float2int_rn(x[1]), q2 = __float2int_rn(x[2]), q3 = __float2int_rn(x[3]);
                    p = (q0 & 255) | ((q1 & 255) << 8) | ((q2 & 255) << 16) | (q3 << 24); }
        else { p = __builtin_amdgcn_cvt_pk_fp8_f32(x[0], x[1], 0, false); p = __builtin_amdgcn_cvt_pk_fp8_f32(x[2], x[3], p, true); }
        *(int*)(dst + ((size_t)(2 * i + (lane >> 5)) * 16384) * 128 + 4 * (lane & 31)) = p; }
    if (lane == 0) *scale_inv = am > 0.f ? am / top : 1.f;
}
template <bool HAS_GAIN> DEVI void convert_rows(const float* src, const float* gain, unsigned char* dst, float* scale_inv, int first, int stride, int n, int lane) {
    if (first >= n) return;
    f32x4 gn[8];
#pragma unroll
    for (int i = 0; i < 8; ++i) gn[i] = HAS_GAIN ? *(const f32x4*)(gain + 256 * i + 4 * lane) : (f32x4){1.f, 1.f, 1.f, 1.f};
    f32x4 cur[8], nx1[8], nx2[8];
    int r = first;
    if (r + stride < n) {
        convert_load(cur, src + (size_t)r * DM, lane);
        convert_load(nx1, src + (size_t)(r + stride) * DM, lane);
        for (; r + 2 * stride < n; r += stride) {
            convert_load(nx2, src + (size_t)(r + 2 * stride) * DM, lane);
            convert_finish<HAS_GAIN, true>(cur, gn, dst + (size_t)r * 128, scale_inv + r, lane);
#pragma unroll
            for (int i = 0; i < 8; ++i) { cur[i] = nx1[i]; nx1[i] = nx2[i]; }
        }
        convert_finish<HAS_GAIN, true>(cur, gn, dst + (size_t)r * 128, scale_inv + r, lane); r += stride;
        convert_finish<HAS_GAIN, true>(nx1, gn, dst + (size_t)r * 128, scale_inv + r, lane);
    } else {
        convert_load(cur, src + (size_t)r * DM, lane);
        convert_finish<HAS_GAIN, true>(cur, gn, dst + (size_t)r * 128, scale_inv + r, lane);
    }
}
DEVI float reduce4(float p0, float p1, float p2, float p3, int lane) {
    const bool h5 = (lane & 32) != 0, h4 = (lane & 16) != 0;
    float a = h5 ? p2 : p0, b = h5 ? p0 : p2; a += __shfl_xor(b, 32);
    float c = h5 ? p3 : p1, d = h5 ? p1 : p3; c += __shfl_xor(d, 32);
    float x = h4 ? c : a, y = h4 ? a : c; x += __shfl_xor(y, 16);
    x += __shfl_xor(x, 8); x += __shfl_xor(x, 4); x += __shfl_xor(x, 2); x += __shfl_xor(x, 1);
    return x;
}
#define PEER_LOAD4(buf, base, sel, k0) do { _Pragma("unroll") for (int r_ = 0; r_ < 4; ++r_) { \
        const unsigned char* rp_ = (base) + (size_t)__builtin_amdgcn_readlane((sel), ((k0) + r_) & 63) * DM + lane * 16; \
        buf[r_][0] = *(const u32x4*)(rp_); buf[r_][1] = *(const u32x4*)(rp_ + 1024); } } while (0)
DEVI float dotrow(const u32x4 (&row)[2], const f32x2 (&h2)[16]) {
    f32x2 p = (f32x2){0.f, 0.f};
#pragma unroll
    for (int c = 0; c < 2; ++c)
#pragma unroll
        for (int j = 0; j < 4; ++j) { const int wv = (int)row[c][j];
            const f32x2 f01 = __builtin_amdgcn_cvt_pk_f32_fp8(wv, false), f23 = __builtin_amdgcn_cvt_pk_f32_fp8(wv, true);
            p += f01 * h2[8 * c + 2 * j]; p += f23 * h2[8 * c + 2 * j + 1]; }
    return p[0] + p[1];
}
DEVI void axpyrow(f32x2 (&y)[16], const u32x4 (&row)[2], float wk) {
#pragma unroll
    for (int c = 0; c < 2; ++c)
#pragma unroll
        for (int j = 0; j < 4; ++j) { const int wv = (int)row[c][j];
            const f32x2 f01 = __builtin_amdgcn_cvt_pk_f32_fp8(wv, false), f23 = __builtin_amdgcn_cvt_pk_f32_fp8(wv, true);
            y[8 * c + 2 * j] += f01 * wk; y[8 * c + 2 * j + 1] += f23 * wk; }
}
DEVI void token(LAS float* scr, const bf16_t* hn, const unsigned char* U8, const unsigned char* V8, const float* usc, const float* vsc, const int* idx, const float* gw, float* out, size_t t, int lane) {
    f32x2 h2[16];
#pragma unroll
    for (int c = 0; c < 2; ++c)
#pragma unroll
        for (int q = 0; q < 2; ++q) { const u32x4 w = *(const u32x4*)(hn + t * DM + 1024 * c + 16 * lane + 8 * q); float f[8]; unpack8(w, f);
#pragma unroll
            for (int e = 0; e < 4; ++e) h2[8 * c + 4 * q + e] = (f32x2){f[2 * e], f[2 * e + 1]}; }
    const int idlo = idx[t * 128 + lane], idhi = idx[t * 128 + 64 + lane];
    const float glo = gw[t * 128 + lane] * vsc[idlo], ghi = gw[t * 128 + 64 + lane] * vsc[idhi];
    const float ulo = usc[idlo], uhi = usc[idhi];
    u32x4 bA[4][2], bB[4][2];
    PEER_LOAD4(bA, U8, idlo, 0);
    for (int kb = 0; kb < 128; kb += 8) {
        const int sel = kb < 64 ? idlo : idhi;
        PEER_LOAD4(bB, U8, sel, kb + 4);
        { const float x = reduce4(dotrow(bA[0], h2), dotrow(bA[1], h2), dotrow(bA[2], h2), dotrow(bA[3], h2), lane); if ((lane & 15) == 0) scr[kb + (lane >> 4)] = x; }
        if (kb + 8 < 128) { const int sel2 = (kb + 8) < 64 ? idlo : idhi; PEER_LOAD4(bA, U8, sel2, kb + 8); }
        { const float x = reduce4(dotrow(bB[0], h2), dotrow(bB[1], h2), dotrow(bB[2], h2), dotrow(bB[3], h2), lane); if ((lane & 15) == 0) scr[kb + 4 + (lane >> 4)] = x; }
    }
    asm volatile("s_waitcnt lgkmcnt(0)" ::: "memory");
    const float wlo = glo * gelu_tanh(scr[lane] * ulo), whi = ghi * gelu_tanh(scr[64 + lane] * uhi);
    asm volatile("s_waitcnt lgkmcnt(0)" ::: "memory");
    f32x2 y[16];
#pragma unroll
    for (int i = 0; i < 16; ++i) y[i] = (f32x2){0.f, 0.f};
    PEER_LOAD4(bA, V8, idlo, 0);
    for (int kb = 0; kb < 128; kb += 8) {
        const int sel = kb < 64 ? idlo : idhi; const float wsel = kb < 64 ? wlo : whi;
        PEER_LOAD4(bB, V8, sel, kb + 4);
#pragma unroll
        for (int r = 0; r < 4; ++r) axpyrow(y, bA[r], rl(wsel, (kb + r) & 63));
        if (kb + 8 < 128) { const int sel2 = (kb + 8) < 64 ? idlo : idhi; PEER_LOAD4(bA, V8, sel2, kb + 8); }
#pragma unroll
        for (int r = 0; r < 4; ++r) axpyrow(y, bB[r], rl(wsel, (kb + 4 + r) & 63));
    }
#pragma unroll
    for (int c = 0; c < 2; ++c)
#pragma unroll
        for (int j = 0; j < 4; ++j) { float* o = out + t * DM + 1024 * c + 16 * lane + 4 * j;
            f32x4 a = *(const f32x4*)o; a[0] += y[8 * c + 2 * j][0]; a[1] += y[8 * c + 2 * j][1]; a[2] += y[8 * c + 2 * j + 1][0]; a[3] += y[8 * c + 2 * j + 1][1];
            *(f32x4*)o = a; }
}
#undef PEER_LOAD4

DEVI f32x2 dot16(const u32x4 row, const f32x2 (&h2)[8], f32x2 p) {
#pragma unroll
    for (int j = 0; j < 4; ++j) { const int wv = (int)row[j];
        p += __builtin_amdgcn_cvt_pk_f32_fp8(wv, false) * h2[2 * j]; p += __builtin_amdgcn_cvt_pk_f32_fp8(wv, true) * h2[2 * j + 1]; }
    return p;
}
template <int M> DEVI float xshf(float x) {
    if constexpr (M == 1) return __builtin_bit_cast(float, __builtin_amdgcn_update_dpp(0, __builtin_bit_cast(int, x), 0xB1, 0xF, 0xF, false));
    else if constexpr (M == 2) return __builtin_bit_cast(float, __builtin_amdgcn_update_dpp(0, __builtin_bit_cast(int, x), 0x4E, 0xF, 0xF, false));
    else return __shfl_xor(x, M);
}
template <int M> DEVI int xshi(int x) {
    if constexpr (M == 1) return __builtin_amdgcn_update_dpp(0, x, 0xB1, 0xF, 0xF, false);
    else if constexpr (M == 2) return __builtin_amdgcn_update_dpp(0, x, 0x4E, 0xF, 0xF, false);
    else return __shfl_xor(x, M);
}
template <int B2, int B1, int B0> DEVI void reduce16i(const int (&v)[16], int lane, int& o0, int& o1) {
    const bool b2 = (lane & B2) != 0, b1 = (lane & B1) != 0, b0 = (lane & B0) != 0;
    int q[8], r[4];
#pragma unroll
    for (int j = 0; j < 8; ++j) q[j] = (b2 ? v[8 + j] : v[j]) + xshi<B2>(b2 ? v[j] : v[8 + j]);
#pragma unroll
    for (int j = 0; j < 4; ++j) r[j] = (b1 ? q[4 + j] : q[j]) + xshi<B1>(b1 ? q[j] : q[4 + j]);
    o0 = (b0 ? r[2] : r[0]) + xshi<B0>(b0 ? r[0] : r[2]);
    o1 = (b0 ? r[3] : r[1]) + xshi<B0>(b0 ? r[1] : r[3]);
}
template <int B2, int B1, int B0> DEVI f32x2 reduce16(const float (&v)[16], int lane) {
    const bool b2 = (lane & B2) != 0, b1 = (lane & B1) != 0, b0 = (lane & B0) != 0;
    float q[8], r[4];
#pragma unroll
    for (int j = 0; j < 8; ++j) q[j] = (b2 ? v[8 + j] : v[j]) + xshf<B2>(b2 ? v[j] : v[8 + j]);
#pragma unroll
    for (int j = 0; j < 4; ++j) r[j] = (b1 ? q[4 + j] : q[j]) + xshf<B1>(b1 ? q[j] : q[4 + j]);
    f32x2 o;
    o[0] = (b0 ? r[2] : r[0]) + xshf<B0>(b0 ? r[0] : r[2]);
    o[1] = (b0 ? r[3] : r[1]) + xshf<B0>(b0 ? r[1] : r[3]);
    return o;
}
template <int MASK> DEVI u32x4 bcast4(const u32x4 v) {
    u32x4 r;
#pragma unroll
    for (int k = 0; k < 4; ++k) r[k] = (unsigned)__builtin_amdgcn_ds_swizzle((int)v[k], MASK);
    return r;
}
DEVI void unpack_ids(const u32x4 lo, const u32x4 hi, int (&id)[16]) {
#pragma unroll
    for (int k = 0; k < 4; ++k) { id[2 * k] = (int)(lo[k] & 0xffffu); id[2 * k + 1] = (int)(lo[k] >> 16); id[8 + 2 * k] = (int)(hi[k] & 0xffffu); id[8 + 2 * k + 1] = (int)(hi[k] >> 16); }
}
DEVI void h_to_int8(const bf16_t* hrow, const float ssq, signed char* orow, float* hsc_inv, int lane) {
    const float rms = sqrtf(ssq * (1.f / DM) + EPS), sc = 127.f / (6.f * rms);
#pragma unroll
    for (int i = 0; i < 4; ++i) { float f[8]; unpack8(*(const u32x4*)(hrow + 512 * i + 8 * lane), f);
        u32x2 w;
        { const int q0 = max(-127, min(127, __float2int_rn(f[0] * sc))), q1 = max(-127, min(127, __float2int_rn(f[1] * sc))), q2 = max(-127, min(127, __float2int_rn(f[2] * sc))), q3 = max(-127, min(127, __float2int_rn(f[3] * sc)));
          w.x = (unsigned)((q0 & 255) | ((q1 & 255) << 8) | ((q2 & 255) << 16) | (q3 << 24)); }
        { const int q0 = max(-127, min(127, __float2int_rn(f[4] * sc))), q1 = max(-127, min(127, __float2int_rn(f[5] * sc))), q2 = max(-127, min(127, __float2int_rn(f[6] * sc))), q3 = max(-127, min(127, __float2int_rn(f[7] * sc)));
          w.y = (unsigned)((q0 & 255) | ((q1 & 255) << 8) | ((q2 & 255) << 16) | (q3 << 24)); }
        *(u32x2*)(orow + 512 * i + 8 * lane) = w; }
    if (lane == 0) *hsc_inv = 6.f * rms * (1.f / 127.f);
}
DEVI void sliceA(const signed char* h8, const unsigned char* U8, const unsigned short* idx, bf16_t* aP, int s, int t0, int nt, int lane) {
    const int g = lane >> 3, c8 = lane & 7;
    const unsigned char* ub = U8 + (size_t)s * 16384 * 128; const unsigned lo = 16u * (unsigned)c8;
    const bool ldi = (c8 == 0), ldh = ((lane & 0x18) == 0);
    u32x4 il = (u32x4){0u, 0u, 0u, 0u}, ih = il, hw = il;
    if (ldi) { il = *(const u32x4*)(idx + (size_t)t0 * 128 + 16 * g); ih = *(const u32x4*)(idx + (size_t)t0 * 128 + 16 * g + 8); }
    if (ldh) hw = *(const u32x4*)(h8 + (size_t)t0 * DM + 128 * s + 16 * c8);
    u32x4 bil = bcast4<0x18>(il), bih = bcast4<0x18>(ih), hb = bcast4<0x07>(hw);
    for (int tt = 0; tt < nt; ++tt) {
        const size_t t = (size_t)t0 + tt;
        int id[16]; unpack_ids(bil, bih, id);
        u32x4 rows[16];
#pragma unroll
        for (int i = 0; i < 16; ++i) rows[i] = *(const u32x4*)(ub + ((unsigned)id[i] * 128u + lo));
        const u32x4 hcur = hb;
        if (tt + 1 < nt) {
            if (ldi) { il = *(const u32x4*)(idx + (t + 1) * 128 + 16 * g); ih = *(const u32x4*)(idx + (t + 1) * 128 + 16 * g + 8); }
            if (ldh) hw = *(const u32x4*)(h8 + (t + 1) * DM + 128 * s + 16 * c8);
        }
        int p[16];
#pragma unroll
        for (int i = 0; i < 16; ++i) { int acc = __builtin_amdgcn_sdot4((int)rows[i][0], (int)hcur[0], 0, false); acc = __builtin_amdgcn_sdot4((int)rows[i][1], (int)hcur[1], acc, false);
            acc = __builtin_amdgcn_sdot4((int)rows[i][2], (int)hcur[2], acc, false); acc = __builtin_amdgcn_sdot4((int)rows[i][3], (int)hcur[3], acc, false); p[i] = acc; }
        int oi0, oi1; reduce16i<4, 2, 1>(p, lane, oi0, oi1);
        const f32x2 o = (f32x2){(float)oi0, (float)oi1};
        bil = bcast4<0x18>(il); bih = bcast4<0x18>(ih); hb = bcast4<0x07>(hw);
        asm volatile("" : "+v"(bil), "+v"(bih), "+v"(hb));
        *(unsigned*)(aP + (t * 16 + s) * 128 + 2 * lane) = pk2(o[0], o[1]);
    }
}
DEVI void rowA2(const bf16_t* aP, const unsigned short* idx, const float* gw, const float* usc, const float* vsc, const float* ssqh, const float* hsc_inv, signed char* W, float* wsc, size_t t, int lane) {
    const float r2 = hsc_inv[t] / sqrtf(ssqh[t] * (1.f / DM) + EPS);
    f32x2 a = (f32x2){0.f, 0.f};
#pragma unroll
    for (int s = 0; s < 16; ++s) { const unsigned w2 = *(const unsigned*)(aP + (t * 16 + s) * 128 + 2 * lane); a += (f32x2){__uint_as_float(w2 << 16), __uint_as_float(w2 & 0xffff0000u)}; }
    const unsigned ii = *(const unsigned*)(idx + t * 128 + 2 * lane);
    const int i0 = (int)(ii & 0xffffu), i1 = (int)(ii >> 16);
    const f32x2 g = *(const f32x2*)(gw + t * 128 + 2 * lane);
    const float w0 = g[0] * vsc[i0] * gelu_tanh(a[0] * usc[i0] * r2), w1 = g[1] * vsc[i1] * gelu_tanh(a[1] * usc[i1] * r2);
    float am = fmaxf(fabsf(w0), fabsf(w1));
#pragma unroll
    for (int o = 1; o < 64; o <<= 1) am = fmaxf(am, __shfl_xor(am, o));
    const float sc = am > 0.f ? 127.f / am : 0.f;
    const int q0 = __float2int_rn(w0 * sc), q1 = __float2int_rn(w1 * sc);
    *(unsigned short*)(W + t * 128 + 2 * lane) = (unsigned short)((q0 & 255) | ((q1 & 255) << 8));
    if (lane == 0) wsc[t] = am * (1.f / 127.f);
}
DEVI unsigned bperm(unsigned hi, unsigned lo, unsigned sel) { return __builtin_amdgcn_perm(hi, lo, sel); }
DEVI void sliceB(const unsigned char* V8, const unsigned short* idx, const signed char* W, const float* wsc, const bf16_t* hb, float* out, int s, int t0, int nt, int lane) {
    const int g = lane >> 3, c8 = lane & 7;
    const unsigned char* vb = V8 + (size_t)s * 16384 * 128; const unsigned lo = 16u * (unsigned)c8;
    const bool ldi = (c8 == 0);
    u32x4 il = (u32x4){0u, 0u, 0u, 0u}, ih = il, wq = il;
    if (ldi) { il = *(const u32x4*)(idx + (size_t)t0 * 128 + 16 * g); ih = *(const u32x4*)(idx + (size_t)t0 * 128 + 16 * g + 8); wq = *(const u32x4*)(W + (size_t)t0 * 128 + 16 * g); }
    u32x4 bil = bcast4<0x18>(il), bih = bcast4<0x18>(ih), wb = bcast4<0x18>(wq);
    unsigned hw2 = *(const unsigned*)(hb + (size_t)t0 * DM + 128 * s + 16 * c8 + 2 * g);
    float ws = wsc[t0];
    for (int tt = 0; tt < nt; ++tt) {
        const size_t t = (size_t)t0 + tt;
        int id[16]; unpack_ids(bil, bih, id);
        u32x4 rows[16];
#pragma unroll
        for (int i = 0; i < 16; ++i) rows[i] = *(const u32x4*)(vb + ((unsigned)id[i] * 128u + lo));
        float* op = out + t * DM + 128 * s + 16 * c8 + 2 * g;
        const f32x2 hcur = (f32x2){__uint_as_float(hw2 << 16), __uint_as_float(hw2 & 0xffff0000u)};
        const u32x4 wcur = wb; const float wscur = ws;
        if (tt + 1 < nt) {
            if (ldi) { il = *(const u32x4*)(idx + (t + 1) * 128 + 16 * g); ih = *(const u32x4*)(idx + (t + 1) * 128 + 16 * g + 8); wq = *(const u32x4*)(W + (t + 1) * 128 + 16 * g); }
            hw2 = *(const unsigned*)(hb + (t + 1) * DM + 128 * s + 16 * c8 + 2 * g);
            ws = wsc[t + 1];
        }
        int acc[16];
#pragma unroll
        for (int c = 0; c < 16; ++c) acc[c] = 0;
#pragma unroll
        for (int q = 0; q < 4; ++q)
#pragma unroll
            for (int j = 0; j < 4; ++j) {
                const unsigned d0 = rows[4 * q][j], d1 = rows[4 * q + 1][j], d2 = rows[4 * q + 2][j], d3 = rows[4 * q + 3][j];
                const unsigned p01l = bperm(d1, d0, 0x05010400u), p01h = bperm(d1, d0, 0x07030602u);
                const unsigned p23l = bperm(d3, d2, 0x05010400u), p23h = bperm(d3, d2, 0x07030602u);
                const unsigned t0_ = bperm(p23l, p01l, 0x05040100u), t1_ = bperm(p23l, p01l, 0x07060302u);
                const unsigned t2_ = bperm(p23h, p01h, 0x05040100u), t3_ = bperm(p23h, p01h, 0x07060302u);
                acc[4 * j + 0] = __builtin_amdgcn_sdot4((int)t0_, (int)wcur[q], acc[4 * j + 0], false);
                acc[4 * j + 1] = __builtin_amdgcn_sdot4((int)t1_, (int)wcur[q], acc[4 * j + 1], false);
                acc[4 * j + 2] = __builtin_amdgcn_sdot4((int)t2_, (int)wcur[q], acc[4 * j + 2], false);
                acc[4 * j + 3] = __builtin_amdgcn_sdot4((int)t3_, (int)wcur[q], acc[4 * j + 3], false);
            }
        int oi0, oi1; reduce16i<32, 16, 8>(acc, lane, oi0, oi1);
        const f32x2 o = (f32x2){(float)oi0, (float)oi1};
        bil = bcast4<0x18>(il); bih = bcast4<0x18>(ih); wb = bcast4<0x18>(wq);
        asm volatile("" : "+v"(bil), "+v"(bih), "+v"(wb), "+v"(hw2), "+v"(ws));
        *(f32x2*)op = hcur + o * wscur;
    }
}
}


namespace topk {
struct CandTab { int a[50], b[50]; };
constexpr CandTab make_tab() { CandTab t{}; int n = 0; for (int a = 0; a < 16; ++a) for (int b = 0; b < 16; ++b) if ((a + 1) * (b + 1) <= 16) { t.a[n] = a; t.b[n] = b; ++n; } return t; }
constexpr CandTab CT = make_tab();
DEVI void ins16(float (&L)[16], float x) {
#pragma unroll
    for (int k = 0; k < 16; ++k) { const float hi = fmaxf(L[k], x); x = fminf(L[k], x); L[k] = hi; }
}
DEVI void merge_partner(float (&L)[16]) {
    float M[16];
#pragma unroll
    for (int k = 0; k < 16; ++k) M[k] = __shfl_xor(L[k], 32);
#pragma unroll
    for (int k = 0; k < 16; ++k) L[k] = fmaxf(L[k], M[15 - k]);
#pragma unroll
    for (int st = 8; st >= 1; st >>= 1)
#pragma unroll
        for (int i = 0; i < 16; ++i) if ((i & st) == 0) { const float a = L[i], b = L[i + st]; L[i] = fmaxf(a, b); L[i + st] = fminf(a, b); }
}
DEVI void stage_keys(LAS unsigned char* lds, const bf16_t* subk, int h, int tid) {
#pragma unroll
    for (int i = 0; i < 8; ++i) {
        const int c = tid + 512 * i, p = c >> 11, rem = c & 2047, row = rem >> 4, ch = rem & 15, kb = ch >> 2, cq = ch & 3;
        const u32x4 v = *(const u32x4*)(subk + ((size_t)(h * 2 + p) * 128 + row) * 128 + ch * 8);
        *(LAS u32x4*)(lds + p * 32768 + kb * 8192 + row * 64 + ((cq ^ ((row >> 2) & 3)) * 16)) = v;
    }
}
DEVI void unit(LAS unsigned char* lds, const bf16_t* qp, unsigned short* idx, float* gw, int tt, int h) {
    const int tid = threadIdx.x, lane = tid & 63, w = __builtin_amdgcn_readfirstlane(tid >> 6), r32 = lane & 31, hh = lane >> 5;
    const size_t tok = (size_t)tt * 256 + 32 * w + r32;
    const int ksw = (r32 >> 2) & 3;
    float T0[16], T1[16];
#pragma unroll
    for (int p = 0; p < 2; ++p) {
        bf16x8 qf[8];
        const bf16_t* qfrag = qp + ((((size_t)tt * 8 + w) * 8 + h) * 2 + p) * 4096 + hh * 256 + r32 * 8;
#pragma unroll
        for (int ks = 0; ks < 8; ++ks) qf[ks] = *(const bf16x8*)(qfrag + ks * 512);
        f32x16 acc[4];
#pragma unroll
        for (int kt = 0; kt < 4; ++kt)
#pragma unroll
            for (int r = 0; r < 16; ++r) acc[kt][r] = 0.f;
        LAS const unsigned char* kbase = lds + p * 32768 + r32 * 64;
#pragma unroll
        for (int ks = 0; ks < 8; ++ks) {
            const int off = (ks >> 1) * 8192 + (((2 * (ks & 1) + hh) ^ ksw) * 16);
#pragma unroll
            for (int kt = 0; kt < 4; ++kt) { const bf16x8 kf = *(LAS const bf16x8*)(kbase + off + kt * 2048); acc[kt] = __builtin_amdgcn_mfma_f32_32x32x16_bf16(kf, qf[ks], acc[kt], 0, 0, 0); }
        }
        float L[16];
#pragma unroll
        for (int k = 0; k < 16; ++k) L[k] = -INFINITY;
#pragma unroll
        for (int kt = 0; kt < 4; ++kt)
#pragma unroll
            for (int r = 0; r < 16; ++r) { const unsigned key = (unsigned)(32 * kt + (r & 3) + 8 * (r >> 2) + 4 * hh); ins16(L, __uint_as_float((__float_as_uint(acc[kt][r]) & ~127u) | key)); }
        merge_partner(L);
#pragma unroll
        for (int k = 0; k < 16; ++k) { if (p == 0) T0[k] = L[k]; else T1[k] = L[k]; }
    }
    LAS unsigned* tl = (LAS unsigned*)(lds + 65536) + w * 2048 + lane;
#pragma unroll
    for (int k = 0; k < 16; ++k) { tl[k * 64] = __float_as_uint(T0[k]); tl[(16 + k) * 64] = __float_as_uint(T1[k]); }
    float C[16];
#pragma unroll
    for (int k = 0; k < 16; ++k) C[k] = -INFINITY;
#pragma unroll
    for (int i = 0; i < 25; ++i) {
        const float v0 = T0[CT.a[2 * i]] + T1[CT.b[2 * i]], v1 = T0[CT.a[2 * i + 1]] + T1[CT.b[2 * i + 1]];
        const unsigned c0 = (unsigned)(CT.a[2 * i] * 16 + CT.b[2 * i]), c1 = (unsigned)(CT.a[2 * i + 1] * 16 + CT.b[2 * i + 1]);
        const unsigned bits = (__float_as_uint(hh ? v1 : v0) & ~255u) | (hh ? c1 : c0);
        ins16(C, __uint_as_float(bits));
    }
    merge_partner(C);
    const float mx = C[0];
    float sum = 0.f;
#pragma unroll
    for (int k = 0; k < 16; ++k) sum += __expf(C[k] - mx);
    const float inv = 1.f / sum;
    unsigned short io8[8]; f32x4 go4[2];
#pragma unroll
    for (int k = 0; k < 8; ++k) {
        float clo = C[k], chi = C[8 + k]; asm volatile("" : "+v"(clo), "+v"(chi));
        const float cv = hh ? chi : clo;
        const unsigned cb = __float_as_uint(cv), ai = (cb >> 4) & 15u, bi = cb & 15u;
        const unsigned i1 = tl[ai * 64] & 127u, i2 = tl[(16 + bi) * 64] & 127u;
        io8[k] = (unsigned short)((i1 << 7) | i2); go4[k >> 2][k & 3] = __expf(cv - mx) * inv;
    }
    asm volatile("s_waitcnt lgkmcnt(0)" ::: "memory");
    unsigned short* io = idx + tok * 128 + h * 16 + 8 * hh; float* go = gw + tok * 128 + h * 16 + 8 * hh;
    { u32x4 pw; pw.x = io8[0] | ((unsigned)io8[1] << 16); pw.y = io8[2] | ((unsigned)io8[3] << 16); pw.z = io8[4] | ((unsigned)io8[5] << 16); pw.w = io8[6] | ((unsigned)io8[7] << 16); *(u32x4*)io = pw; }
    *(f32x4*)go = go4[0]; *(f32x4*)(go + 4) = go4[1];
}
DEVI void phase(LAS unsigned char* lds, const bf16_t* qp, const bf16_t* subk, unsigned short* idx, float* gw, int vcu, int G) {
    int last_h = -1;
    for (int u = vcu; u < 512; u += G) {
        const int h = u & 7, tt = u >> 3;
        if (h != last_h) {
            asm volatile("s_waitcnt lgkmcnt(0)" ::: "memory"); __builtin_amdgcn_s_barrier(); asm volatile("" ::: "memory");
            stage_keys(lds, subk, h, threadIdx.x); last_h = h;
            asm volatile("s_waitcnt vmcnt(0) lgkmcnt(0)" ::: "memory"); __builtin_amdgcn_s_barrier(); asm volatile("" ::: "memory");
        }
        unit(lds, qp, idx, gw, tt, h);
    }
}
}


namespace swa {
constexpr int KOFF = 0, VOFF = 32768, POFF = 65536, LOFF = 66560, WOFF = 70784;
DEVI s16x4 vtr(LAS const unsigned char* p) { return __builtin_bit_cast(s16x4, __builtin_amdgcn_ds_read_tr16_b64_v4i16((LAS s16x4*)p)); }
DEVI void unit(LAS unsigned char* lds, const bf16_t* proj, const int* pos, const float* sinks, const float* rel, const float* sqg, const float* skg, bf16_t* O, int b, int kvh, int nb) {
    const int tid = threadIdx.x, lane = tid & 63, w = __builtin_amdgcn_readfirstlane(tid >> 6), r32 = lane & 31, hh = lane >> 5;
    const int head = kvh * 8 + w;
    const int tk0 = nb * 128 - 128;
    const size_t rowbase = (size_t)b * SEQ;
    asm volatile("s_waitcnt lgkmcnt(0)" ::: "memory"); __builtin_amdgcn_s_barrier(); asm volatile("" ::: "memory");
#pragma unroll
    for (int i = 0; i < 8; ++i) {
        const int c = tid + 512 * i, isV = c >> 11, rem = c & 2047, row = rem >> 3, ch = rem & 7, kb = ch >> 2, cq = ch & 3;
        const int tk = tk0 + row;
        u32x4 v = (u32x4){0u, 0u, 0u, 0u};
        if (tk >= 0) v = *(const u32x4*)(proj + (rowbase + tk) * PROJ_LD + (isV ? C_SV : C_SK) + kvh * 64 + ch * 8);
        if (i < 4) {
            float f[8]; unpack8(v, f); float ss = 0.f;
#pragma unroll
            for (int e = 0; e < 8; ++e) ss += f[e] * f[e];
            ss += __shfl_xor(ss, 1); ss += __shfl_xor(ss, 2); ss += __shfl_xor(ss, 4);
            const float r = 1.f / sqrtf(ss * (1.f / 64.f) + EPS);
            const f32x4 g0 = *(const f32x4*)(skg + ch * 8), g1 = *(const f32x4*)(skg + ch * 8 + 4);
            f[0] *= r * g0[0]; f[1] *= r * g0[1]; f[2] *= r * g0[2]; f[3] *= r * g0[3]; f[4] *= r * g1[0]; f[5] *= r * g1[1]; f[6] *= r * g1[2]; f[7] *= r * g1[3];
            v = pack8(f);
        }
        const int dst = isV ? (VOFF + kb * 16384 + row * 64 + cq * 16) : (KOFF + kb * 16384 + row * 64 + ((cq ^ ((row >> 2) & 3)) * 16));
        *(LAS u32x4*)(lds + dst) = v;
    }
    LAS int* posk = (LAS int*)(lds + POFF);
    if (tid < 256) posk[tid] = (tk0 + tid >= 0) ? pos[rowbase + tk0 + tid] : 0;
    LAS float* lut = (LAS float*)(lds + LOFF) + w * 132;
    for (int d = lane; d <= 128; d += 64) lut[d] = rel[t5_bucket(d) * 16 + head];
    asm volatile("s_waitcnt vmcnt(0) lgkmcnt(0)" ::: "memory"); __builtin_amdgcn_s_barrier(); asm volatile("" ::: "memory");
    const float sink = sinks[head];
    LAS float* wsf = (LAS float*)(lds + WOFF) + w * 32;
    const int ksw = (r32 >> 2) & 3;
    const int vlane = VOFF + ((lane >> 4) & 1) * 32 + (lane & 3) * 8 + (4 * hh + ((lane & 15) >> 2)) * 64;
#pragma unroll 1
    for (int qs = 0; qs < 4; ++qs) {
        const size_t t = rowbase + nb * 128 + 32 * qs + r32;
        const bf16_t* qrow = proj + t * PROJ_LD + C_SQ + head * 64 + 8 * hh;
        bf16x8 qf[4];
        {
            float qv[4][8]; float ss = 0.f;
#pragma unroll
            for (int ks = 0; ks < 4; ++ks) { unpack8(*(const u32x4*)(qrow + 16 * ks), qv[ks]);
#pragma unroll
                for (int e = 0; e < 8; ++e) ss += qv[ks][e] * qv[ks][e]; }
            ss += __shfl_xor(ss, 32);
            const float r = 0.125f / sqrtf(ss * (1.f / 64.f) + EPS);
#pragma unroll
            for (int ks = 0; ks < 4; ++ks) { const f32x4 g0 = *(const f32x4*)(sqg + 16 * ks + 8 * hh), g1 = *(const f32x4*)(sqg + 16 * ks + 8 * hh + 4);
                qv[ks][0] *= r * g0[0]; qv[ks][1] *= r * g0[1]; qv[ks][2] *= r * g0[2]; qv[ks][3] *= r * g0[3]; qv[ks][4] *= r * g1[0]; qv[ks][5] *= r * g1[1]; qv[ks][6] *= r * g1[2]; qv[ks][7] *= r * g1[3];
                qf[ks] = __builtin_bit_cast(bf16x8, pack8(qv[ks])); }
        }
        const int pq = pos[t];
        f32x16 S[5];
#pragma unroll
        for (int kk = 0; kk < 5; ++kk)
#pragma unroll
            for (int r = 0; r < 16; ++r) S[kk][r] = 0.f;
#pragma unroll
        for (int ks = 0; ks < 4; ++ks) {
            const int off = KOFF + (ks >> 1) * 16384 + (32 * qs + r32) * 64 + (((2 * (ks & 1) + hh) ^ ksw) * 16);
#pragma unroll
            for (int kk = 0; kk < 5; ++kk) { const bf16x8 kf = *(LAS const bf16x8*)(lds + off + kk * 2048); S[kk] = __builtin_amdgcn_mfma_f32_32x32x16_bf16(kf, qf[ks], S[kk], 0, 0, 0); }
        }
        float m = sink;
#pragma unroll
        for (int kk = 0; kk < 5; ++kk)
#pragma unroll
            for (int g = 0; g < 4; ++g) {
                const int jb = 32 * (qs + kk) + 8 * g + 4 * hh;
                const i32x4 pk = *(LAS const i32x4*)(posk + jb);
                const int pkv[4] = {pk[0], pk[1], pk[2], pk[3]};
#pragma unroll
                for (int e = 0; e < 4; ++e) {
                    const int dj = 32 * kk + 8 * g + 4 * hh + e - r32;
                    int d = pq - pkv[e]; d = d < 0 ? 0 : (d > 128 ? 128 : d);
                    const float sv = S[kk][4 * g + e] + lut[d];
                    const bool valid = (dj >= 1) && (dj <= 128) && (tk0 + jb + e >= 0);
                    const float sm = valid ? sv : -INFINITY;
                    S[kk][4 * g + e] = sm; m = fmaxf(m, sm);
                }
            }
        m = fmaxf(m, __shfl_xor(m, 32));
        float ps = 0.f;
#pragma unroll
        for (int kk = 0; kk < 5; ++kk)
#pragma unroll
            for (int r = 0; r < 16; ++r) { const float p = __expf(S[kk][r] - m); S[kk][r] = p; ps += p; }
        ps += __shfl_xor(ps, 32);
        ps += __expf(sink - m);
        f32x16 o[2];
#pragma unroll
        for (int d = 0; d < 2; ++d)
#pragma unroll
            for (int r = 0; r < 16; ++r) o[d][r] = 0.f;
#pragma unroll
        for (int kk = 0; kk < 5; ++kk)
#pragma unroll
            for (int s2 = 0; s2 < 2; ++s2) {
                u32x4 wv; wv.x = pk2(S[kk][8 * s2 + 0], S[kk][8 * s2 + 1]); wv.y = pk2(S[kk][8 * s2 + 2], S[kk][8 * s2 + 3]); wv.z = pk2(S[kk][8 * s2 + 4], S[kk][8 * s2 + 5]); wv.w = pk2(S[kk][8 * s2 + 6], S[kk][8 * s2 + 7]);
                const bf16x8 pf = __builtin_bit_cast(bf16x8, wv);
                LAS const unsigned char* vb = lds + vlane + (32 * (qs + kk) + 16 * s2) * 64;
#pragma unroll
                for (int d = 0; d < 2; ++d) {
                    const s16x4 lo = vtr(vb + d * 16384), hi = vtr(vb + d * 16384 + 512);
                    const bf16x8 vf = (bf16x8){lo[0], lo[1], lo[2], lo[3], hi[0], hi[1], hi[2], hi[3]};
                    o[d] = __builtin_amdgcn_mfma_f32_32x32x16_bf16(pf, vf, o[d], 0, 0, 0);
                }
            }
        if (hh == 0) wsf[r32] = 1.f / ps;
        asm volatile("s_waitcnt lgkmcnt(0)" ::: "memory");
        bf16_t* orow = O + (rowbase + nb * 128 + 32 * qs) * DM + 1024 + head * 64 + r32;
#pragma unroll
        for (int g = 0; g < 4; ++g) { const f32x4 c4 = *(LAS const f32x4*)(wsf + 8 * g + 4 * hh);
#pragma unroll
            for (int e = 0; e < 4; ++e) { const int qr = 8 * g + 4 * hh + e;
#pragma unroll
                for (int d = 0; d < 2; ++d) orow[(size_t)qr * DM + 32 * d] = (bf16_t)f2bf(o[d][4 * g + e] * c4[e]); } }
        asm volatile("s_waitcnt lgkmcnt(0)" ::: "memory");
    }
}
DEVI void phase(LAS unsigned char* lds, const bf16_t* proj, const int* pos, const float* sinks, const float* rel, const float* sqg, const float* skg, bf16_t* O, int vcu, int G) {
    for (int u = vcu; u < 256; u += G) { const int nb = u & 31, bk = u >> 5; unit(lds, proj, pos, sinks, rel, sqg, skg, O, bk >> 1, bk & 1, nb); }
    asm volatile("s_waitcnt lgkmcnt(0)" ::: "memory"); __builtin_amdgcn_s_barrier(); asm volatile("" ::: "memory");
}
}

constexpr int N_PHASES = 14;
struct Args { const void* in[21]; float* out; unsigned char* ws; int ph_lo, ph_hi; };

__global__ void __launch_bounds__(NTHREADS, 2) __attribute__((amdgpu_waves_per_eu(2, 2))) mega_fwd(Args a) {
    extern __shared__ __attribute__((aligned(16))) unsigned char lds_raw[];
    LAS unsigned char* lds = (LAS unsigned char*)lds_raw;
    volatile LAS unsigned* MISC = (volatile LAS unsigned*)(lds + MISC_OFF);
    const int tid = threadIdx.x, lane = tid & 63, wave = __builtin_amdgcn_readfirstlane(tid >> 6);
    const int G = gridDim.x, bx = blockIdx.x;
    const int vcu = (G % 8 == 0) ? (bx % 8) * (G / 8) + bx / 8 : bx;
    const int gw = vcu * NWAVES + wave, NGW = G * NWAVES;

    const float* x = (const float*)a.in[0]; const int* pos = (const int*)a.in[1];
    const float* g1 = (const float*)a.in[2]; const float* w_in = (const float*)a.in[3]; const float* qag = (const float*)a.in[4]; const float* wqb = (const float*)a.in[5];
    const float* kvag = (const float*)a.in[6]; const float* wkvb = (const float*)a.in[7]; const float* mqg = (const float*)a.in[8]; const float* mkg = (const float*)a.in[9];
    const float* sqg = (const float*)a.in[10]; const float* skg = (const float*)a.in[11]; const float* sinks = (const float*)a.in[12]; const float* rel = (const float*)a.in[13];
    const float* gog = (const float*)a.in[14]; const float* wout = (const float*)a.in[15]; const float* g2 = (const float*)a.in[16]; const float* wpq = (const float*)a.in[17];
    const float* subk = (const float*)a.in[18]; const float* pu = (const float*)a.in[19]; const float* pv = (const float*)a.in[20];
    float* out = a.out; unsigned char* ws = a.ws;
    bf16_t* W1T = (bf16_t*)(ws + WS_W1T); bf16_t* WQB = (bf16_t*)(ws + WS_WQB); bf16_t* WKVB = (bf16_t*)(ws + WS_WKVB); bf16_t* WOUT = (bf16_t*)(ws + WS_WOUT);
    bf16_t* WPQ = (bf16_t*)(ws + WS_WPQ); bf16_t* SUBK = (bf16_t*)(ws + WS_SUBK); bf16_t* UB = (bf16_t*)(ws + WS_UB); bf16_t* VB = (bf16_t*)(ws + WS_VB);
    bf16_t* PROJ = (bf16_t*)(ws + WS_PROJ); bf16_t* KV = (bf16_t*)(ws + WS_KV); bf16_t* Q = (bf16_t*)(ws + WS_Q); bf16_t* K = (bf16_t*)(ws + WS_K); bf16_t* ACT = (bf16_t*)(ws + WS_ACT);
    bf16_t* QP = PROJ; unsigned short* IDX = (unsigned short*)(ws + WS_Q); float* GWT = (float*)(ws + WS_Q + 8 * MiB); signed char* WEX = (signed char*)(ws + WS_Q + 16 * MiB); float* WSC = (float*)(ws + WS_CTL + 512 * 1024); bf16_t* AP = (bf16_t*)(ws + WS_PROJ);
    float* LATP = (float*)(ws + WS_CTL + 1024 * 1024);
    bf16_t* HB = (bf16_t*)(ws + WS_Q + 24 * MiB); float* SSQH = (float*)(ws + WS_CTL + 64 * 1024);
    signed char* HB8 = (signed char*)(ws + WS_ACT); float* HSC = (float*)(ws + WS_CTL + 448 * 1024);
    unsigned char* U8 = ws + WS_UB; unsigned char* V8 = ws + WS_VB; float* USC = (float*)(ws + WS_CTL + 256 * 1024); float* VSC = (float*)(ws + WS_CTL + 384 * 1024);

    for (int u = tid; u < (LDS_BYTES - RING_BYTES) / 4; u += NTHREADS) ((LAS unsigned*)(lds + RING_BYTES))[u] = 0u;
    __syncthreads();
    XcdBarrier bar = xcd_barrier_post((unsigned*)(ws + WS_CTL) + 1024, MISC + 8);
    const int lo = a.ph_lo, hi = a.ph_hi;
#define IN(k) (lo <= (k) && (k) < hi)
#define SEAM(k) do { if (IN(k) && IN((k) + 1)) xcd_barrier(bar); } while (0)

    if (IN(0)) {
        LAS float* scr = (LAS float*)(lds + wave * 16384);
        constexpr int I1 = 32 * 66, I2 = 8 * 48, I3 = 4 * 64, I4 = 32 * 64, I5 = 32 * 64;
        for (int it = gw; it < I1 + I2 + I3 + I4 + I5; it += NGW) {
            int r = it;
            if (r < I1) { transpose_item(w_in, W1T, nullptr, 2048, 2112, 1, r, scr, lane); continue; } r -= I1;
            if (r < I2) { transpose_item(wqb, WQB, qag, 512, 1536, 0, r, scr, lane); continue; } r -= I2;
            if (r < I3) { transpose_item(wkvb, WKVB, kvag, 256, 2048, 2, r, scr, lane); continue; } r -= I3;
            if (r < I4) { transpose_item(wout, WOUT, gog, 2048, 2048, 0, r, scr, lane); continue; } r -= I4;
            transpose_item(wpq, WPQ, g2, 2048, 2048, 0, r, scr, lane);
        }
        const size_t gtid = (size_t)vcu * NTHREADS + tid, nthr = (size_t)G * NTHREADS;
        for (size_t i = gtid; i < (size_t)192 * 2048 / 2; i += nthr) ((unsigned*)(W1T + (size_t)2112 * 2048))[i] = 0u;
        convert_range(subk, SUBK, (size_t)8 * 2 * 128 * 128 / 8, nullptr, 128, gtid, nthr);
        { f32x4 cur[8], nxt[8];
          if (gw < T) {
#pragma unroll
              for (int j = 0; j < 8; ++j) cur[j] = *(const f32x4*)(x + (size_t)gw * DM + 4 * (lane + 64 * j));
          }
          for (int t = gw; t < T; t += NGW) {
              const bool more = t + NGW < T;
              if (more) {
#pragma unroll
                  for (int j = 0; j < 8; ++j) nxt[j] = *(const f32x4*)(x + (size_t)(t + NGW) * DM + 4 * (lane + 64 * j));
              }
              norm1_regs(cur, g1, ACT + (size_t)t * DM, lane);
              if (more) {
#pragma unroll
                  for (int j = 0; j < 8; ++j) cur[j] = nxt[j];
              }
          } }
    }
    SEAM(0);
    if (IN(1)) {
        pg8::Gemm g{ACT, W1T, T, PROJ_LD, DM, DM, DM}; pg8::StaticOrder S; S.init(T, PROJ_LD, G, bx);
        pg8::EpiBf16 E{PROJ, PROJ_LD, nullptr, 0.f, nullptr, 0, 0, LATP, 3};
        pg8::gemm_phase<pg8::EpiBf16, pg8::StaticOrder, true>(lds, g, S, E);
        { const int nfull = (T / 256) * (PROJ_LD / 256) % G;
          const int nconv = G - nfull;
          if (nfull == 0 || nconv <= 0) { peer::convert_rows<true>(pu, g2, U8, USC, gw, NGW, 16384, lane); peer::convert_rows<false>(pv, nullptr, V8, VSC, gw, NGW, 16384, lane); }
          else if (bx >= nfull) { const int cw = (bx - nfull) * NWAVES + wave, cs = nconv * NWAVES;
              peer::convert_rows<true>(pu, g2, U8, USC, cw, cs, 16384, lane); peer::convert_rows<false>(pv, nullptr, V8, VSC, cw, cs, 16384, lane); } }
    }
    SEAM(1);
    if (IN(3)) {
        { pg8::Gemm g{PROJ + C_QLAT, WQB, T, 1536, 512, PROJ_LD, 512}; pg8::StaticOrder S; S.init(T, 1536, G, bx);
          pg8::EpiBf16 E{ACT, QK_LD, nullptr, 1.f / 512.f, LATP, 0, 8, nullptr, 0};
          pg8::gemm_phase<pg8::EpiBf16, pg8::StaticOrder, true>(lds, g, S, E); }
        { pg8::Gemm g{PROJ + C_KVLAT, WKVB, T, 2048, 256, PROJ_LD, 256}; pg8::StaticOrder S; S.init(T, 2048, G, bx);
          pg8::EpiBf16 E{KV, KV_LD, nullptr, 1.f / 256.f, LATP, 8, 4, nullptr, 0};
          pg8::gemm_phase<pg8::EpiBf16, pg8::StaticOrder, true>(lds, g, S, E); }
    }
    SEAM(3);
    if (IN(4)) {
        for (int t = gw; t < T; t += NGW)
            p3_row(ACT + (size_t)t * QK_LD, KV + (size_t)t * KV_LD, PROJ + (size_t)t * PROJ_LD + C_KPE, pos[t], mqg, mkg, Q + (size_t)t * QK_LD, K + (size_t)t * QK_LD, lane);
    }
    SEAM(4);
    if (IN(5)) {
        mla::phase(lds, Q, K, KV, ACT, vcu, G);
        swa::phase(lds, PROJ, pos, sinks, rel, sqg, skg, ACT, vcu, G);
    }
    SEAM(5);
    if (IN(6)) { for (int t = gw; t < T; t += NGW) p4_row(ACT + (size_t)t * DM, lane); }
    SEAM(6);
    if (IN(7)) {
        pg8::Gemm g{ACT, WOUT, T, DM, DM, DM, DM}; pg8::StaticOrder S; S.init(T, DM, G, bx);
        pg8::EpiResid E{x, out, HB, SSQH, DM};
        pg8::gemm_phase<pg8::EpiResid, pg8::StaticOrder, true>(lds, g, S, E);
    }
    SEAM(7);
    if (IN(9)) {
        pg8::Gemm g{HB, WPQ, T, DM, DM, DM, DM}; pg8::StaticOrder S; S.init(T, DM, G, bx);
        pg8::EpiQp E{QP, SSQH, 1.f / DM};
        pg8::gemm_phase<pg8::EpiQp, pg8::StaticOrder, true>(lds, g, S, E);
    }
    SEAM(9);
    if (IN(10)) {
        for (int t = gw; t < T; t += NGW) peer::h_to_int8(HB + (size_t)t * DM, SSQH[t], HB8 + (size_t)t * DM, HSC + t, lane);
        topk::phase(lds, QP, SUBK, IDX, GWT, vcu, G);
    }
    SEAM(10);
    if (IN(11)) {
        for (int vb = bx; vb < 256; vb += G) { const int grp = vb & 7, rank = vb >> 3, t0 = rank * 512 + wave * 64;
            peer::sliceA(HB8, U8, IDX, AP, grp, t0, 64, lane); peer::sliceA(HB8, U8, IDX, AP, grp + 8, t0, 64, lane); }
    }
    SEAM(11);
    if (IN(12)) { for (int t = gw; t < T; t += NGW) peer::rowA2(AP, IDX, GWT, USC, VSC, SSQH, HSC, WEX, WSC, (size_t)t, lane); }
    SEAM(12);
    if (IN(13)) {
        for (int vb = bx; vb < 256; vb += G) { const int grp = vb & 7, rank = vb >> 3, t0 = rank * 512 + wave * 64;
            peer::sliceB(V8, IDX, WEX, WSC, HB, out, grp, t0, 64, lane); peer::sliceB(V8, IDX, WEX, WSC, HB, out, grp + 8, t0, 64, lane); }
    }
#undef IN
#undef SEAM
}

#ifndef MK_N_LAUNCHES
#define MK_N_LAUNCHES 1
#endif
extern "C" void kernel_launch(void* const* d_in, const int* in_sizes, int n_in, void* d_out, int out_size, void* d_ws, size_t ws_size, hipStream_t stream) {
    static int grid = 0;
    if (grid == 0) {
        if (n_in != 21 || ws_size < WS_END || out_size != T * DM) { fprintf(stderr, "kernel_launch: unexpected problem (n_in %d, ws %zu, out %d)\n", n_in, ws_size, out_size); grid = -1; return; }
        int dev = 0, cus = 0;
        if (hipGetDevice(&dev) != hipSuccess || hipDeviceGetAttribute(&cus, hipDeviceAttributeMultiprocessorCount, dev) != hipSuccess) { grid = -1; return; }
        if (hipFuncSetAttribute((const void*)mega_fwd, hipFuncAttributeMaxDynamicSharedMemorySize, LDS_BYTES) != hipSuccess) { fprintf(stderr, "kernel_launch: hipFuncSetAttribute failed\n"); grid = -1; return; }
        int per_cu = 0;
        if (hipOccupancyMaxActiveBlocksPerMultiprocessor(&per_cu, (const void*)mega_fwd, NTHREADS, LDS_BYTES) != hipSuccess || per_cu < 1) { fprintf(stderr, "kernel_launch: occupancy query says %d\n", per_cu); }
        (void)hipGetLastError();
        grid = cus;
    }
    if (grid < 0) return;
    (void)hipMemsetAsync((char*)d_ws + WS_CTL, 0, CTL_ZERO_BYTES, stream);
    Args a{};
    for (int i = 0; i < 21; ++i) a.in[i] = d_in[i];
    a.out = (float*)d_out; a.ws = (unsigned char*)d_ws;
    if (MK_N_LAUNCHES == 1) { a.ph_lo = 0; a.ph_hi = N_PHASES; hipLaunchKernelGGL(mega_fwd, dim3(grid), dim3(NTHREADS), LDS_BYTES, stream, a); }
    else for (int p = 0; p < N_PHASES; ++p) { a.ph_lo = p; a.ph_hi = p + 1; hipLaunchKernelGGL(mega_fwd, dim3(grid), dim3(NTHREADS), LDS_BYTES, stream, a); }
}
```

```cpp
#include <hip/hip_runtime.h>
#include <stdint.h>
#include <stdio.h>

#define DEVI __device__ __forceinline__
#define LAS __attribute__((address_space(3)))
typedef unsigned short bf16_t;
typedef short bf16x8 __attribute__((ext_vector_type(8)));
typedef float f32x4 __attribute__((ext_vector_type(4)));
typedef unsigned u32x4 __attribute__((ext_vector_type(4)));
typedef unsigned u32x2 __attribute__((ext_vector_type(2)));
typedef int i32x4 __attribute__((ext_vector_type(4)));

constexpr int BATCH = 4, SEQ = 4096, DM = 2048, T = BATCH * SEQ;
constexpr int PROJ_LD = 2304;
constexpr int C_QLAT = 0, C_KVLAT = 512, C_SQ = 768, C_SK = 1792, C_SV = 1920, C_KPE = 2048;
constexpr int QK_LD = 1536;
constexpr int KV_LD = 2048;
constexpr float EPS = 1e-6f;
constexpr float LOG2E = 1.4426950408889634f;
constexpr int NWAVES = 8, NTHREADS = 512;

constexpr size_t MiB = 1u << 20;
constexpr size_t WS_CTL = 0, CTL_ZERO_BYTES = 128 * 1024;
constexpr size_t WS_W1T = 2 * MiB;
constexpr size_t WS_WQB = 11 * MiB;
constexpr size_t WS_WKVB = 13 * MiB;
constexpr size_t WS_WOUT = 14 * MiB;
constexpr size_t WS_WPQ = 22 * MiB;
constexpr size_t WS_SUBK = 30 * MiB;
constexpr size_t WS_UB = 32 * MiB;
constexpr size_t WS_VB = 96 * MiB;
constexpr size_t WS_PROJ = 160 * MiB;
constexpr size_t WS_KV = 232 * MiB;
constexpr size_t WS_Q = 296 * MiB;
constexpr size_t WS_K = 344 * MiB;
constexpr size_t WS_ACT = 392 * MiB;
constexpr size_t WS_END = 456 * MiB;

constexpr int RING_BYTES = 131072;
constexpr int MISC_OFF = RING_BYTES + 320;
constexpr int LDS_BYTES = 147456;

__device__ const float kInvFreq[32] = {
    1.000000000e+00f, 7.498942018e-01f, 5.623413324e-01f, 4.216965139e-01f, 3.162277639e-01f, 2.371373773e-01f, 1.778279394e-01f, 1.333521456e-01f,
    1.000000015e-01f, 7.498942316e-02f, 5.623413250e-02f, 4.216964915e-02f, 3.162277490e-02f, 2.371373773e-02f, 1.778279431e-02f, 1.333521400e-02f,
    9.999999776e-03f, 7.498942316e-03f, 5.623413250e-03f, 4.216964822e-03f, 3.162277630e-03f, 2.371373819e-03f, 1.778279431e-03f, 1.333521446e-03f,
    1.000000047e-03f, 7.498941850e-04f, 5.623413017e-04f, 4.216965172e-04f, 3.162277571e-04f, 2.371373703e-04f, 1.778279402e-04f, 1.333521504e-04f};

DEVI float bf2f(unsigned h) { return __uint_as_float((h & 0xffffu) << 16); }
typedef float f32x2_t __attribute__((ext_vector_type(2)));
typedef __bf16 bf16x2_t __attribute__((ext_vector_type(2)));
DEVI unsigned pk2(float lo, float hi) { const f32x2_t v = {lo, hi}; const bf16x2_t b = __builtin_convertvector(v, bf16x2_t); return __builtin_bit_cast(unsigned, b); }
DEVI unsigned f2bf(float f) { return pk2(f, 0.f) & 0xffffu; }
DEVI float wave_sum(float v) {
#pragma unroll
    for (int o = 1; o < 64; o <<= 1) v += __shfl_xor(v, o);
    return v;
}
DEVI void unpack8(const u32x4 w, float* f) {
    f[0] = __uint_as_float(w.x << 16); f[1] = __uint_as_float(w.x & 0xffff0000u);
    f[2] = __uint_as_float(w.y << 16); f[3] = __uint_as_float(w.y & 0xffff0000u);
    f[4] = __uint_as_float(w.z << 16); f[5] = __uint_as_float(w.z & 0xffff0000u);
    f[6] = __uint_as_float(w.w << 16); f[7] = __uint_as_float(w.w & 0xffff0000u);
}
DEVI u32x4 pack8(const float* f) { u32x4 w; w.x = pk2(f[0], f[1]); w.y = pk2(f[2], f[3]); w.z = pk2(f[4], f[5]); w.w = pk2(f[6], f[7]); return w; }
DEVI float gelu_tanh(float a) {
    const float z = 0.7978845608028654f * (a + 0.044715f * a * a * a);
    const float e = __expf(2.f * z);
    const float th = 1.f - 2.f / (e + 1.f);
    return 0.5f * a * (1.f + th);
}

namespace pg8 {
constexpr int BM = 256, BK = 64, HALF = 128, HTB = HALF * BK * 2, STAGE_BYTES = 8 * HTB, NXCD = 8, WGM = 8;
DEVI int lds_byte(int r, int c) { const int st = (r >> 4) * 2 + (c >> 5), rr = r & 15, cc = c & 31, ob = rr * 64 + cc * 2; return st * 1024 + (ob ^ (((ob >> 9) & 1) << 5)); }
DEVI void stage_rc(int b, int& R, int& C) { const int st = b / 1024, sb = b % 1024, swz = sb ^ (((sb >> 9) & 1) << 5); R = (st >> 1) * 16 + swz / 64; C = (st & 1) * 32 + (swz % 64) / 2; }
DEVI int perm32(int rho) { const int n = rho >> 4, i = rho & 15; return 8 * (i >> 2) + 4 * n + (i & 3); }
struct Unit { int pm, pn; };
struct Gemm { const bf16_t* A; const bf16_t* Bt; int M, N, K, lda, ldb; };
struct StaticOrder {
    int nM, nN, nwg, G, c;
    DEVI void init(int M, int N, int G_, int c_) { nM = M / BM; nN = N / BM; nwg = nM * nN; G = G_; c = c_; }
    DEVI bool next(int i, Unit& u) const {
        const long L = (long)i * G + c; if (L >= nwg) return false;
        int wgid = (int)L; { const int q = nwg / NXCD, r = nwg % NXCD, xcd = wgid % NXCD, off = wgid / NXCD; wgid = (xcd < r ? xcd * (q + 1) : r * (q + 1) + (xcd - r) * q) + off; }
        const int nig = WGM * nN, gid = wgid / nig, fm = gid * WGM, gsz = (nM - fm) < WGM ? (nM - fm) : WGM;
        u.pm = fm + ((wgid % nig) % gsz); u.pn = (wgid % nig) / gsz; return true;
    }
};
DEVI f32x4 tof(const f32x4 v) { return v; }
DEVI f32x4 tof(const i32x4 v) { return __builtin_convertvector(v, f32x4); }
DEVI unsigned cvt_pk_bf16(float lo, float hi) { unsigned r; asm volatile("v_cvt_pk_bf16_f32 %0, %1, %2" : "=v"(r) : "v"(lo), "v"(hi)); return r; }
template <bool I8> struct EpiBf16 {
    static constexpr bool PERM = true;
    bf16_t* O; int ldc;
    const float* ssq; float inv_n;
    const float* part; int pbase, pcnt;
    float* part_out; int pn_lim;
    const float* rs8; const float* cmax8;
    template <class A4> DEVI void operator()(const A4 (&acc)[2][2][4][2], const Unit& u, int wr, int wc, int fr, int fq) const {
        const int row0 = u.pm * BM + wr * 64 + fr, col0 = u.pn * BM + wc * 32 + 8 * fq;
        const bool wr_part = part_out && u.pn < pn_lim;
        f32x4 cs[2][2];
        if (I8) {
#pragma unroll
            for (int bj = 0; bj < 2; ++bj) { cs[bj][0] = *(const f32x4*)(cmax8 + col0 + bj * HALF) * (1.f / 127.f); cs[bj][1] = *(const f32x4*)(cmax8 + col0 + bj * HALF + 4) * (1.f / 127.f); }
        }
#pragma unroll
        for (int ai = 0; ai < 2; ++ai)
#pragma unroll
            for (int m = 0; m < 4; ++m) { const int row = row0 + ai * HALF + m * 16; bf16_t* rowp = O + (size_t)row * ldc + col0;
                float rs = 1.f;
                if (I8) rs = rs8[row];
                else if (ssq) rs = 1.f / sqrtf(ssq[row] * inv_n + EPS);
                else if (part) { float sq = 0.f; for (int j = 0; j < pcnt; ++j) sq += part[(size_t)row * 12 + pbase + j]; rs = 1.f / sqrtf(sq * inv_n + EPS); }
                float ss = 0.f;
#pragma unroll
                for (int bj = 0; bj < 2; ++bj) { f32x4 v0 = tof(acc[ai][bj][m][0]) * rs, v1 = tof(acc[ai][bj][m][1]) * rs;
                    if (I8) { v0 = v0 * cs[bj][0]; v1 = v1 * cs[bj][1]; }
                    u32x4 w; w.x = cvt_pk_bf16(v0[0], v0[1]); w.y = cvt_pk_bf16(v0[2], v0[3]); w.z = cvt_pk_bf16(v1[0], v1[1]); w.w = cvt_pk_bf16(v1[2], v1[3]);
                    *(u32x4*)(rowp + bj * HALF) = w;
                    ss += v0[0] * v0[0] + v0[1] * v0[1] + v0[2] * v0[2] + v0[3] * v0[3] + v1[0] * v1[0] + v1[1] * v1[1] + v1[2] * v1[2] + v1[3] * v1[3]; }
                if (wr_part) { ss += __shfl_xor(ss, 16); ss += __shfl_xor(ss, 32); if (fq == 0) part_out[(size_t)row * 12 + 4 * u.pn + wc] = ss; } }
    }
};
struct EpiQp {
    static constexpr bool PERM = true;
    bf16_t* O; const float* ssq; float inv_n;
    template <class A4> DEVI void operator()(const A4 (&acc)[2][2][4][2], const Unit& u, int wr, int wc, int fr, int fq) const {
        const int row0 = u.pm * BM + wr * 64 + fr;
#pragma unroll
        for (int ai = 0; ai < 2; ++ai)
#pragma unroll
            for (int m = 0; m < 4; ++m) { const int row = row0 + ai * HALF + m * 16;
                const float rs = 1.f / sqrtf(ssq[row] * inv_n + EPS);
#pragma unroll
                for (int bj = 0; bj < 2; ++bj) { const f32x4 v0 = acc[ai][bj][m][0] * rs, v1 = acc[ai][bj][m][1] * rs;
                    u32x4 w; w.x = cvt_pk_bf16(v0[0], v0[1]); w.y = cvt_pk_bf16(v0[2], v0[3]); w.z = cvt_pk_bf16(v1[0], v1[1]); w.w = cvt_pk_bf16(v1[2], v1[3]);
                    *(u32x4*)(O + ((((size_t)(row >> 5) * 8 + u.pn) * 2 + bj) * 16 + 4 * wc + fq) * 256 + (row & 31) * 8) = w; } }
    }
};
template <bool I8> struct EpiResid {
    static constexpr bool PERM = true;
    const float* X; float* O; bf16_t* HB; float* ssq; int ldc;
    const float* rs8; const float* cmax8;
    template <class A4> DEVI void operator()(const A4 (&acc)[2][2][4][2], const Unit& u, int wr, int wc, int fr, int fq) const {
        const int row0 = u.pm * BM + wr * 64 + fr, col0 = u.pn * BM + wc * 32 + 8 * fq;
        f32x4 cs[2][2];
        if (I8) {
#pragma unroll
            for (int bj = 0; bj < 2; ++bj) { cs[bj][0] = *(const f32x4*)(cmax8 + col0 + bj * HALF) * (1.f / 127.f); cs[bj][1] = *(const f32x4*)(cmax8 + col0 + bj * HALF + 4) * (1.f / 127.f); }
        }
#pragma unroll
        for (int ai = 0; ai < 2; ++ai)
#pragma unroll
            for (int m = 0; m < 4; ++m) { const int row = row0 + ai * HALF + m * 16; const size_t off = (size_t)row * ldc + col0;
                float ss = 0.f; const float rs = I8 ? rs8[row] : 1.f;
#pragma unroll
                for (int bj = 0; bj < 2; ++bj) {
                    f32x4 a0 = tof(acc[ai][bj][m][0]), a1 = tof(acc[ai][bj][m][1]);
                    if (I8) { a0 = a0 * (cs[bj][0] * rs); a1 = a1 * (cs[bj][1] * rs); }
                    const f32x4 h0 = *(const f32x4*)(X + off + bj * HALF) + a0, h1 = *(const f32x4*)(X + off + bj * HALF + 4) + a1;
                    u32x4 w; w.x = cvt_pk_bf16(h0[0], h0[1]); w.y = cvt_pk_bf16(h0[2], h0[3]); w.z = cvt_pk_bf16(h1[0], h1[1]); w.w = cvt_pk_bf16(h1[2], h1[3]);
                    *(u32x4*)(HB + off + bj * HALF) = w;
                    ss += h0[0] * h0[0] + h0[1] * h0[1] + h0[2] * h0[2] + h0[3] * h0[3] + h1[0] * h1[0] + h1[1] * h1[1] + h1[2] * h1[2] + h1[3] * h1[3]; }
                ss += __shfl_xor(ss, 16); ss += __shfl_xor(ss, 32);
                if (fq == 0) atomicAdd(ssq + row, ss); }
    }
};

DEVI f32x4 mma16(const bf16x8 b, const bf16x8 a, const f32x4 c) { return __builtin_amdgcn_mfma_f32_16x16x32_bf16(b, a, c, 0, 0, 0); }
DEVI i32x4 mma16(const bf16x8 b, const bf16x8 a, const i32x4 c) { return __builtin_amdgcn_mfma_i32_16x16x64_i8(__builtin_bit_cast(i32x4, b), __builtin_bit_cast(i32x4, a), c, 0, 0, 0); }
template <bool I8> struct AccT { typedef f32x4 type; };
template <> struct AccT<true> { typedef i32x4 type; };
template <class Epi, class Sched, bool ALIGN_EPI, bool I8 = false>
DEVI void gemm_phase(LAS unsigned char* lds, const Gemm g, const Sched& S, const Epi& E) {
    const int tid = threadIdx.x, wid = __builtin_amdgcn_readfirstlane(tid >> 6), lane = tid & 63, wr = wid >> 2, wc = wid & 3, fr = lane & 15, fq = lane >> 4;
    const int K = g.K, nt = K / BK;
    unsigned voffA[2], voffB[2];
#pragma unroll
    for (int i = 0; i < 2; ++i) { int R, C; stage_rc(tid * 16 + i * 8192, R, C); const int Rb = Epi::PERM ? ((R & ~31) + perm32(R & 31)) : R;
        voffA[i] = (unsigned)(R * g.lda + C) * 2u; voffB[i] = (unsigned)(Rb * g.ldb + C) * 2u; }
    const size_t kstep = (size_t)(BK * 2);
    const size_t hA = (size_t)HALF * g.lda * 2, hB = (size_t)HALF * g.ldb * 2, tA = 2 * hA, tB = 2 * hB;
    const unsigned ldsw = (unsigned)wid * 1024u;
    const int aoff = lds_byte(wr * 64 + fr, fq * 8), boff = lds_byte(wc * 32 + fr, fq * 8);
#define PG8_SA(b, h) (((b) * 2 + (h)) * HTB)
#define PG8_SB(b, h) ((4 + (b) * 2 + (h)) * HTB)
#define PG8_STAGE(bufoff, gbase, voff) do { _Pragma("unroll") for (int _i = 0; _i < 2; ++_i) \
        __builtin_amdgcn_global_load_lds((const unsigned*)((const char*)(gbase) + (voff)[_i]), (LAS unsigned*)(lds + (bufoff) + ldsw + _i * 8192), 16, 0, 0); } while (0)
#define PG8_LDA(dst, b, h) do { _Pragma("unroll") for (int m = 0; m < 4; ++m) _Pragma("unroll") for (int k = 0; k < 2; ++k) dst[m][k] = *(const LAS bf16x8*)(lds + PG8_SA(b, h) + aoff + m * 2048 + k * 1024); } while (0)
#define PG8_LDB(dst, b, h) do { _Pragma("unroll") for (int n = 0; n < 2; ++n) _Pragma("unroll") for (int k = 0; k < 2; ++k) dst[n][k] = *(const LAS bf16x8*)(lds + PG8_SB(b, h) + boff + n * 2048 + k * 1024); } while (0)
#define PG8_MMA(ai, bj, At, Bt) do { __builtin_amdgcn_s_setprio(1); _Pragma("unroll") for (int m = 0; m < 4; ++m) _Pragma("unroll") for (int n = 0; n < 2; ++n) _Pragma("unroll") for (int k = 0; k < 2; ++k) \
        acc[ai][bj][m][n] = mma16(Bt[n][k], At[m][k], acc[ai][bj][m][n]); __builtin_amdgcn_s_setprio(0); } while (0)
#define PG8_WAIT_V(n) asm volatile("s_waitcnt vmcnt(" #n ")" ::: "memory")
#define PG8_WAIT_L(n) asm volatile("s_waitcnt lgkmcnt(" #n ")" ::: "memory")
#define PG8_BAR __builtin_amdgcn_s_barrier()
#define PG8_SCHED __builtin_amdgcn_sched_barrier(0)
    Unit cur, nxt; int ui = 0;
    if (!S.next(0, cur)) return;
    typedef typename AccT<I8>::type acc_t;
    acc_t acc[2][2][4][2];
#pragma unroll
    for (int a = 0; a < 2; ++a)
#pragma unroll
        for (int b = 0; b < 2; ++b)
#pragma unroll
            for (int m = 0; m < 4; ++m)
#pragma unroll
                for (int n = 0; n < 2; ++n) acc[a][b][m][n] = (acc_t){0, 0, 0, 0};
    bf16x8 At[4][2], B0[2][2], B1[2][2];
    const char* cA = (const char*)g.A + (size_t)cur.pm * tA; const char* cB = (const char*)g.Bt + (size_t)cur.pn * tB;
    PG8_STAGE(PG8_SB(0, 0), cB, voffB); PG8_STAGE(PG8_SB(0, 1), cB + hB, voffB); PG8_STAGE(PG8_SA(0, 0), cA, voffA); PG8_STAGE(PG8_SA(0, 1), cA + hA, voffA);
    if (wr == 1) PG8_BAR;
    PG8_WAIT_V(2); PG8_BAR;
    PG8_STAGE(PG8_SB(1, 0), cB + kstep, voffB); PG8_STAGE(PG8_SA(1, 0), cA + kstep, voffA); PG8_STAGE(PG8_SB(1, 1), cB + hB + kstep, voffB);
    PG8_WAIT_V(6); PG8_BAR;
    for (;;) {
        const bool has_next = S.next(ui + 1, nxt);
        const char* nA = has_next ? (const char*)g.A + (size_t)nxt.pm * tA : cA; const char* nB = has_next ? (const char*)g.Bt + (size_t)nxt.pn * tB : cB;
        for (int t = 0; t < nt; t += 2) {
            const bool last = (t == nt - 2);
            const char* a1 = cA + (size_t)(t + 1) * kstep;
            const char* a2 = last ? nA : cA + (size_t)(t + 2) * kstep; const char* b2 = last ? nB : cB + (size_t)(t + 2) * kstep;
            const char* a3 = a2 + kstep; const char* b3 = b2 + kstep;
            PG8_LDB(B0, 0, 0); PG8_LDB(B1, 0, 1); PG8_SCHED; PG8_LDA(At, 0, 0); PG8_STAGE(PG8_SA(1, 1), a1 + hA, voffA);
            PG8_WAIT_V(8); PG8_WAIT_L(0); PG8_BAR; PG8_MMA(0, 0, At, B0); PG8_MMA(0, 1, At, B1); PG8_BAR; PG8_SCHED;
            PG8_LDA(At, 0, 1); PG8_STAGE(PG8_SB(0, 0), b2, voffB); PG8_STAGE(PG8_SB(0, 1), b2 + hB, voffB); PG8_STAGE(PG8_SA(0, 0), a2, voffA);
            PG8_WAIT_V(8); PG8_WAIT_L(0); PG8_BAR; PG8_MMA(1, 0, At, B0); PG8_MMA(1, 1, At, B1); PG8_BAR; PG8_SCHED;
            PG8_LDB(B0, 1, 0); PG8_LDB(B1, 1, 1); PG8_SCHED; PG8_LDA(At, 1, 0); PG8_STAGE(PG8_SA(0, 1), a2 + hA, voffA);
            PG8_WAIT_V(8); PG8_WAIT_L(0); PG8_BAR; PG8_MMA(0, 0, At, B0); PG8_MMA(0, 1, At, B1); PG8_BAR; PG8_SCHED;
            PG8_LDA(At, 1, 1); PG8_STAGE(PG8_SB(1, 0), b3, voffB); PG8_STAGE(PG8_SB(1, 1), b3 + hB, voffB); PG8_STAGE(PG8_SA(1, 0), a3, voffA);
            PG8_WAIT_V(8); PG8_WAIT_L(0); PG8_BAR; PG8_MMA(1, 0, At, B0); PG8_MMA(1, 1, At, B1); PG8_BAR; PG8_SCHED;
        }
        if constexpr (ALIGN_EPI) { if (wr == 0) PG8_BAR; }
        E(acc, cur, wr, wc, fr, fq);
        if (!has_next) break;
#pragma unroll
        for (int a = 0; a < 2; ++a)
#pragma unroll
            for (int b = 0; b < 2; ++b)
#pragma unroll
                for (int m = 0; m < 4; ++m)
#pragma unroll
                    for (int n = 0; n < 2; ++n) acc[a][b][m][n] = (acc_t){0, 0, 0, 0};
        cur = nxt; cA = nA; cB = nB; ++ui;
        if constexpr (ALIGN_EPI) { if (wr == 1) PG8_BAR; }
    }
    PG8_WAIT_V(0);
    if constexpr (!ALIGN_EPI) { if (wr == 0) PG8_BAR; }
    PG8_BAR;
#undef PG8_SA
#undef PG8_SB
#undef PG8_STAGE
#undef PG8_LDA
#undef PG8_LDB
#undef PG8_MMA
#undef PG8_WAIT_V
#undef PG8_WAIT_L
#undef PG8_BAR
#undef PG8_SCHED
}
}

#define XB_TMO      128
#define XB_XCNT(j)  (256  + 64 * (j))
#define XB_XSUB(j)  (1280 + 64 * (j))
#define XB_XGEN(j)  (2304 + 64 * (j))
#define XB_TOP      3328
#define XB_TOPGEN   3392
#define XCD_BAR_WORDS 3456
#define XB_SPIN_CAP (1u << 18)
DEVI unsigned xb_ld(unsigned* p)              { return __hip_atomic_load(p, __ATOMIC_RELAXED, __HIP_MEMORY_SCOPE_AGENT); }
DEVI unsigned xb_add(unsigned* p, unsigned v) { return __hip_atomic_fetch_add(p, v, __ATOMIC_RELAXED, __HIP_MEMORY_SCOPE_AGENT); }
DEVI unsigned xb_xcc_id() { return (unsigned)__builtin_amdgcn_s_getreg((3 << 11) | 20) & 0xFu; }
#define XB_SPIN(cond, bar) do { unsigned _sp = 0; while (cond) { __builtin_amdgcn_s_sleep(1); \
    if ((++_sp & 255u) == 0u) { if (xb_ld(&(bar)[XB_TMO])) break; if (_sp > XB_SPIN_CAP) { atomicAdd(&(bar)[XB_TMO], 1u); break; } } } } while (0)
struct XcdBarrier { unsigned* bar; unsigned x; volatile LAS unsigned* st; };
DEVI XcdBarrier xcd_barrier_post(unsigned* bar, volatile LAS unsigned* st) {
    XcdBarrier b; b.bar = bar; b.x = xb_xcc_id(); b.st = st;
    if (threadIdx.x == 0) (void)xb_add(&bar[XB_XCNT(b.x)], 1u);
    return b;
}
DEVI void xcd_barrier_complete(unsigned* bar, unsigned x, unsigned& nloc, unsigned& nx) {
    const unsigned G = gridDim.x * gridDim.y * gridDim.z;
    unsigned sum, cnt, mine, sp = 0u;
    for (;;) {
        sum = 0u; cnt = 0u; mine = 0u;
#pragma unroll
        for (unsigned j = 0; j < 16; ++j) { const unsigned c = xb_ld(&bar[XB_XCNT(j)]); sum += c; cnt += (c > 0u) ? 1u : 0u; mine = (j == x) ? c : mine; }
        if (sum == G) break;
        __builtin_amdgcn_s_sleep(1);
        if ((++sp & 255u) == 0u) { if (xb_ld(&bar[XB_TMO])) break; if (sp > XB_SPIN_CAP) { atomicAdd(&bar[XB_TMO], 1u); break; } }
    }
    nloc = mine > 0u ? mine : 1u; nx = cnt > 0u ? cnt : 1u;
}
DEVI void xcd_barrier(const XcdBarrier& b) {
    asm volatile("s_waitcnt vmcnt(0)" ::: "memory");
    __syncthreads();
    if (threadIdx.x == 0) {
        unsigned* bar = b.bar;
        __builtin_amdgcn_s_waitcnt(0);
        unsigned nloc = b.st[0], nx = b.st[1];
        if (nloc == 0u) { xcd_barrier_complete(bar, b.x, nloc, nx); b.st[0] = nloc; b.st[1] = nx; }
        const unsigned old = xb_add(&bar[XB_XSUB(b.x)], 1u);
        const unsigned gen = old / nloc;
        if (old + 1u == (gen + 1u) * nloc) {
            __builtin_amdgcn_fence(__ATOMIC_RELEASE, "agent");
            asm volatile("s_waitcnt vmcnt(0)" ::: "memory");
            const unsigned og = xb_add(&bar[XB_TOP], 1u);
            const unsigned tg = og / nx;
            if (og + 1u == (tg + 1u) * nx) xb_add(&bar[XB_TOPGEN], 1u);
            else XB_SPIN(xb_ld(&bar[XB_TOPGEN]) == tg, bar);
            __builtin_amdgcn_fence(__ATOMIC_ACQUIRE, "agent");
            xb_add(&bar[XB_XGEN(b.x)], 1u);
            asm volatile("s_waitcnt vmcnt(0)" ::: "memory");
        } else {
            XB_SPIN(xb_ld(&bar[XB_XGEN(b.x)]) == gen, bar);
            __builtin_amdgcn_fence(__ATOMIC_ACQUIRE, "agent");
            asm volatile("s_waitcnt vmcnt(0)" ::: "memory");
        }
    }
    __syncthreads();
}

struct TJob { const float* W; bf16_t* WT; const float* gain; int K, N, mode, pad; };
DEVI int dst_row(int mode, int n) {
    if (mode == 1) return n < 768 ? n : (n < 832 ? 2048 + (n - 768) : n - 64);
    if (mode == 2) { const int h = n >> 8, j = n & 255; return j < 128 ? h * 128 + j : 1024 + h * 128 + (j - 128); }
    return n;
}
DEVI void transpose_item(const float* W, bf16_t* WT, const float* gain, int K, int N, int mode, int item, LAS float* scr, int lane) {
    const int nblk = N / 32, kb = item / nblk, nb = item % nblk, k0 = 64 * kb, n0 = 32 * nb;
    {
        const int kr = lane >> 3, nc = (lane & 7) * 4;
        f32x4 v[8];
#pragma unroll
        for (int i = 0; i < 8; ++i) v[i] = *(const f32x4*)(W + (size_t)(k0 + 8 * i + kr) * N + n0 + nc);
#pragma unroll
        for (int i = 0; i < 8; ++i) { const int kk = 8 * i + kr; const float g = gain ? gain[k0 + kk] : 1.f;
            scr[kk * 33 + nc] = v[i][0] * g; scr[kk * 33 + nc + 1] = v[i][1] * g; scr[kk * 33 + nc + 2] = v[i][2] * g; scr[kk * 33 + nc + 3] = v[i][3] * g; }
    }
    asm volatile("s_waitcnt lgkmcnt(0)" ::: "memory");
    const int c = lane & 7;
#pragma unroll
    for (int jj = 0; jj < 4; ++jj) {
        const int n = (lane >> 3) + 8 * jj; const LAS float* s = scr + (8 * c) * 33 + n;
        u32x4 o; o.x = pk2(s[0 * 33], s[1 * 33]); o.y = pk2(s[2 * 33], s[3 * 33]); o.z = pk2(s[4 * 33], s[5 * 33]); o.w = pk2(s[6 * 33], s[7 * 33]);
        *(u32x4*)(WT + (size_t)dst_row(mode, n0 + n) * K + k0 + 8 * c) = o;
    }
    asm volatile("s_waitcnt lgkmcnt(0)" ::: "memory");
}
DEVI unsigned pack4_i8(const f32x4 x) { const int q0 = __float2int_rn(x[0]), q1 = __float2int_rn(x[1]), q2 = __float2int_rn(x[2]), q3 = __float2int_rn(x[3]); return (unsigned)((q0 & 255) | ((q1 & 255) << 8) | ((q2 & 255) << 16) | (q3 << 24)); }
DEVI float wave_max(float v) {
#pragma unroll
    for (int o = 1; o < 64; o <<= 1) v = fmaxf(v, __shfl_xor(v, o));
    return v;
}
DEVI void colmax_item(const float* W, const float* gain, float* cmax, int N, int mode, int item, int lane) {
    const int ncb = (N + 255) / 256, kb = item / ncb, cb = item % ncb, k0 = 32 * kb, c = 256 * cb + 4 * lane;
    if (c >= N) return;
    f32x4 m = (f32x4){0.f, 0.f, 0.f, 0.f};
#pragma unroll
    for (int h = 0; h < 2; ++h) { f32x4 v[16];
#pragma unroll
        for (int i = 0; i < 16; ++i) v[i] = *(const f32x4*)(W + (size_t)(k0 + 16 * h + i) * N + c);
#pragma unroll
        for (int i = 0; i < 16; ++i) { const float g = gain ? gain[k0 + 16 * h + i] : 1.f;
#pragma unroll
            for (int e = 0; e < 4; ++e) m[e] = fmaxf(m[e], fabsf(v[i][e] * g)); } }
#pragma unroll
    for (int e = 0; e < 4; ++e) atomicMax((unsigned*)(cmax + dst_row(mode, c + e)), __float_as_uint(m[e]));
}
DEVI void transpose_item_q(const float* W, signed char* WT, const float* gain, const float* cmax, int K, int N, int mode, int item, LAS float* scr, int lane) {
    const int nblk = N / 32, kb = item / nblk, nb = item % nblk, k0 = 64 * kb, n0 = 32 * nb;
    {
        const int kr = lane >> 3, nc = (lane & 7) * 4;
        f32x4 v[8];
#pragma unroll
        for (int i = 0; i < 8; ++i) v[i] = *(const f32x4*)(W + (size_t)(k0 + 8 * i + kr) * N + n0 + nc);
#pragma unroll
        for (int i = 0; i < 8; ++i) { const int kk = 8 * i + kr; const float g = gain ? gain[k0 + kk] : 1.f;
            scr[kk * 33 + nc] = v[i][0] * g; scr[kk * 33 + nc + 1] = v[i][1] * g; scr[kk * 33 + nc + 2] = v[i][2] * g; scr[kk * 33 + nc + 3] = v[i][3] * g; }
    }
    asm volatile("s_waitcnt lgkmcnt(0)" ::: "memory");
    const int c = lane & 7;
#pragma unroll
    for (int jj = 0; jj < 4; ++jj) {
        const int n = (lane >> 3) + 8 * jj, dr = dst_row(mode, n0 + n); const LAS float* s = scr + (8 * c) * 33 + n;
        const float cm = cmax[dr], sc = cm > 0.f ? 127.f / cm : 0.f;
        u32x2 o; o.x = pack4_i8((f32x4){s[0 * 33], s[1 * 33], s[2 * 33], s[3 * 33]} * sc); o.y = pack4_i8((f32x4){s[4 * 33], s[5 * 33], s[6 * 33], s[7 * 33]} * sc);
        *(u32x2*)(WT + (size_t)dr * K + k0 + 8 * c) = o;
    }
    asm volatile("s_waitcnt lgkmcnt(0)" ::: "memory");
}
DEVI void convert_range(const float* src, bf16_t* dst, size_t n8, const float* gain, int ncols, size_t gtid, size_t nthr) {
    for (size_t i = gtid; i < n8; i += nthr) {
        const f32x4 a = *(const f32x4*)(src + i * 8), b = *(const f32x4*)(src + i * 8 + 4);
        float f[8] = {a.x, a.y, a.z, a.w, b.x, b.y, b.z, b.w};
        if (gain) { const int c = (int)((i * 8) % (size_t)ncols); const f32x4 g0 = *(const f32x4*)(gain + c), g1 = *(const f32x4*)(gain + c + 4);
            f[0] *= g0.x; f[1] *= g0.y; f[2] *= g0.z; f[3] *= g0.w; f[4] *= g1.x; f[5] *= g1.y; f[6] *= g1.z; f[7] *= g1.w; }
        *(u32x4*)(dst + i * 8) = pack8(f);
    }
}
DEVI void norm1_regs(const f32x4 (&v)[8], const float* g, bf16_t* orow, int lane) {
    float s = 0.f;
#pragma unroll
    for (int j = 0; j < 8; ++j) s += v[j].x * v[j].x + v[j].y * v[j].y + v[j].z * v[j].z + v[j].w * v[j].w;
    const float r = 1.f / sqrtf(wave_sum(s) * (1.f / DM) + EPS);
#pragma unroll
    for (int j = 0; j < 8; ++j) { const f32x4 gg = *(const f32x4*)(g + 4 * (lane + 64 * j));
        u32x2 o; o.x = pk2(v[j].x * r * gg.x, v[j].y * r * gg.y); o.y = pk2(v[j].z * r * gg.z, v[j].w * r * gg.w);
        *(u32x2*)(orow + 4 * (lane + 64 * j)) = o; }
}
DEVI void norm1_regs_q(const f32x4 (&v)[8], const float* g, signed char* orow, float* rs, int lane) {
    float s = 0.f;
#pragma unroll
    for (int j = 0; j < 8; ++j) s += v[j].x * v[j].x + v[j].y * v[j].y + v[j].z * v[j].z + v[j].w * v[j].w;
    const float r = 1.f / sqrtf(wave_sum(s) * (1.f / DM) + EPS);
    f32x4 y[8]; float am = 0.f;
#pragma unroll
    for (int j = 0; j < 8; ++j) { const f32x4 gg = *(const f32x4*)(g + 4 * (lane + 64 * j)); y[j] = v[j] * r * gg;
        am = fmaxf(am, fmaxf(fmaxf(fabsf(y[j][0]), fabsf(y[j][1])), fmaxf(fabsf(y[j][2]), fabsf(y[j][3])))); }
    am = wave_max(am);
    const float sc = am > 0.f ? 127.f / am : 0.f;
#pragma unroll
    for (int j = 0; j < 8; ++j) *(unsigned*)(orow + 4 * (lane + 64 * j)) = pack4_i8(y[j] * sc);
    if (lane == 0) *rs = am * (1.f / 127.f);
}
DEVI void norm1_row(const float* xrow, const float* g, bf16_t* orow, int lane) {
    f32x4 v[8]; float s = 0.f;
#pragma unroll
    for (int j = 0; j < 8; ++j) { v[j] = *(const f32x4*)(xrow + 4 * (lane + 64 * j)); s += v[j].x * v[j].x + v[j].y * v[j].y + v[j].z * v[j].z + v[j].w * v[j].w; }
    const float r = 1.f / sqrtf(wave_sum(s) * (1.f / DM) + EPS);
#pragma unroll
    for (int j = 0; j < 8; ++j) { const f32x4 gg = *(const f32x4*)(g + 4 * (lane + 64 * j));
        u32x2 o; o.x = pk2(v[j].x * r * gg.x, v[j].y * r * gg.y); o.y = pk2(v[j].z * r * gg.z, v[j].w * r * gg.w);
        *(u32x2*)(orow + 4 * (lane + 64 * j)) = o; }
}
DEVI void p2_row(bf16_t* p, const float* sqg, const float* skg, int lane) {
    {
        u32x4 w = *(const u32x4*)(p + C_QLAT + lane * 8); float f[8]; unpack8(w, f); float s = 0.f;
#pragma unroll
        for (int i = 0; i < 8; ++i) s += f[i] * f[i];
        const float r = 1.f / sqrtf(wave_sum(s) * (1.f / 512.f) + EPS);
#pragma unroll
        for (int i = 0; i < 8; ++i) f[i] *= r;
        *(u32x4*)(p + C_QLAT + lane * 8) = pack8(f);
    }
    {
        u32x2 w = *(const u32x2*)(p + C_KVLAT + lane * 4);
        float f0 = __uint_as_float(w.x << 16), f1 = __uint_as_float(w.x & 0xffff0000u), f2 = __uint_as_float(w.y << 16), f3 = __uint_as_float(w.y & 0xffff0000u);
        const float r = 1.f / sqrtf(wave_sum(f0 * f0 + f1 * f1 + f2 * f2 + f3 * f3) * (1.f / 256.f) + EPS);
        u32x2 o; o.x = pk2(f0 * r, f1 * r); o.y = pk2(f2 * r, f3 * r);
        *(u32x2*)(p + C_KVLAT + lane * 4) = o;
    }
    {
        u32x4 w0 = *(const u32x4*)(p + C_SQ + lane * 16), w1 = *(const u32x4*)(p + C_SQ + lane * 16 + 8); float f[16]; unpack8(w0, f); unpack8(w1, f + 8); float s = 0.f;
#pragma unroll
        for (int i = 0; i < 16; ++i) s += f[i] * f[i];
        s += __shfl_xor(s, 1); s += __shfl_xor(s, 2);
        const float r = 0.125f / sqrtf(s * (1.f / 64.f) + EPS);
        const int d0 = (lane & 3) * 16;
#pragma unroll
        for (int i = 0; i < 16; ++i) f[i] *= r * sqg[d0 + i];
        *(u32x4*)(p + C_SQ + lane * 16) = pack8(f); *(u32x4*)(p + C_SQ + lane * 16 + 8) = pack8(f + 8);
    }
    {
        unsigned w = *(const unsigned*)(p + C_SK + lane * 2);
        float f0 = __uint_as_float(w << 16), f1 = __uint_as_float(w & 0xffff0000u);
        float s = f0 * f0 + f1 * f1;
#pragma unroll
        for (int o = 1; o < 32; o <<= 1) s += __shfl_xor(s, o);
        const float r = 1.f / sqrtf(s * (1.f / 64.f) + EPS);
        const int d0 = (lane & 31) * 2;
        *(unsigned*)(p + C_SK + lane * 2) = pk2(f0 * r * skg[d0], f1 * r * skg[d0 + 1]);
    }
}
DEVI void p3_row(const bf16_t* qraw, const bf16_t* kvrow, const bf16_t* kpe, int pos, const float* qg, const float* kg, bf16_t* Qo, bf16_t* Ko, int lane) {
    const int hd = lane >> 3, sub = lane & 7;
    float cs[8], sn[8];
#pragma unroll
    for (int e = 0; e < 8; ++e) {
        const float ang = (float)pos * kInvFreq[8 * (sub & 3) + e];
        const double rev = (double)ang * 0.15915494309189535;
        const float fr = (float)(rev - floor(rev));
        sn[e] = __builtin_amdgcn_sinf(fr); cs[e] = __builtin_amdgcn_cosf(fr);
    }
    const float qscale = 0.07216878364870322f * LOG2E;
#pragma unroll
    for (int which = 0; which < 2; ++which) {
        const float* gn = which ? kg : qg;
        u32x4 w0, w1, w2;
        if (which == 0) { const bf16_t* qh = qraw + hd * 192; w0 = *(const u32x4*)(qh + 8 * sub); w1 = *(const u32x4*)(qh + 64 + 8 * sub); w2 = *(const u32x4*)(qh + 128 + 8 * sub); }
        else { const bf16_t* kh = kvrow + hd * 128; w0 = *(const u32x4*)(kh + 8 * sub); w1 = *(const u32x4*)(kh + 64 + 8 * sub); w2 = *(const u32x4*)(kpe + 8 * sub); }
        float f0[8], f1[8], f2[8]; unpack8(w0, f0); unpack8(w1, f1); unpack8(w2, f2);
        float ss = 0.f;
#pragma unroll
        for (int e = 0; e < 8; ++e) ss += f0[e] * f0[e] + f1[e] * f1[e] + f2[e] * f2[e];
        ss += __shfl_xor(ss, 1); ss += __shfl_xor(ss, 2); ss += __shfl_xor(ss, 4);
        const float r = (which ? 1.f : qscale) / sqrtf(ss * (1.f / 192.f) + EPS);
        const f32x4 ga = *(const f32x4*)(gn + 8 * sub), gb = *(const f32x4*)(gn + 8 * sub + 4), gc = *(const f32x4*)(gn + 64 + 8 * sub), gd = *(const f32x4*)(gn + 64 + 8 * sub + 4),
                    ge = *(const f32x4*)(gn + 128 + 8 * sub), gf = *(const f32x4*)(gn + 128 + 8 * sub + 4);
        const float g0[8] = {ga[0], ga[1], ga[2], ga[3], gb[0], gb[1], gb[2], gb[3]}, g1[8] = {gc[0], gc[1], gc[2], gc[3], gd[0], gd[1], gd[2], gd[3]}, g2[8] = {ge[0], ge[1], ge[2], ge[3], gf[0], gf[1], gf[2], gf[3]};
        float ro[8];
#pragma unroll
        for (int e = 0; e < 8; ++e) { f0[e] *= r * g0[e]; f1[e] *= r * g1[e]; f2[e] *= r * g2[e]; }
#pragma unroll
        for (int e = 0; e < 8; ++e) { const float pr = __shfl_xor(f2[e], 4); ro[e] = (sub < 4) ? (f2[e] * cs[e] - pr * sn[e]) : (f2[e] * cs[e] + pr * sn[e]); }
        bf16_t* dst = (which ? Ko : Qo) + hd * 192;
        *(u32x4*)(dst + 8 * sub) = pack8(f0); *(u32x4*)(dst + 64 + 8 * sub) = pack8(f1); *(u32x4*)(dst + 128 + 8 * sub) = pack8(ro);
    }
}
DEVI void mla_row(const bf16_t* Q, const bf16_t* K, const bf16_t* KV, bf16_t* O, int b, int h, int q, int lane) {
    const size_t t = (size_t)b * SEQ + q;
    const bf16_t* qp = Q + t * QK_LD + h * 192;
    const float q0 = bf2f(qp[lane]), q1 = bf2f(qp[64 + lane]), q2 = bf2f(qp[128 + lane]);
    float m = -INFINITY, l = 0.f, o0 = 0.f, o1 = 0.f;
    const bf16_t* kb = K + (size_t)b * SEQ * QK_LD + h * 192;
    const bf16_t* vb = KV + (size_t)b * SEQ * KV_LD + 1024 + h * 128;
#pragma unroll 4
    for (int j = 0; j <= q; ++j) {
        const bf16_t* kr = kb + (size_t)j * QK_LD; const bf16_t* vr = vb + (size_t)j * KV_LD;
        const float s = wave_sum(q0 * bf2f(kr[lane]) + q1 * bf2f(kr[64 + lane]) + q2 * bf2f(kr[128 + lane]));
        const float v0 = bf2f(vr[lane]), v1 = bf2f(vr[64 + lane]);
        const float mn = fmaxf(m, s), c = exp2f(m - mn), p = exp2f(s - mn);
        l = l * c + p; o0 = o0 * c + p * v0; o1 = o1 * c + p * v1; m = mn;
    }
    const float il = 1.f / l;
    O[t * DM + h * 128 + lane] = (bf16_t)f2bf(o0 * il); O[t * DM + h * 128 + 64 + lane] = (bf16_t)f2bf(o1 * il);
}
DEVI int t5_bucket(int dist) {
    const int n = dist > 0 ? dist : 0;
    if (n < 16) return n;
    const float nf = (float)n;
    int large = 16 + (int)(logf(nf / 16.f) / 2.0794415416798357f * 16.f);
    return large < 31 ? large : 31;
}
DEVI void swa_row(const bf16_t* proj, const int* pos, const float* sinks, const float* rel, bf16_t* O, int b, int hh, int q, int lane) {
    const int kvh = hh >> 3;
    const size_t t = (size_t)b * SEQ + q;
    const float qv = bf2f(proj[t * PROJ_LD + C_SQ + hh * 64 + lane]);
    const float sink = sinks[hh];
    float m = sink, l = 1.f, o = 0.f;
    const int pq = pos[t];
    const int j0 = q - 127 > 0 ? q - 127 : 0;
#pragma unroll 4
    for (int j = j0; j <= q; ++j) {
        const size_t tk = (size_t)b * SEQ + j;
        const float kx = bf2f(proj[tk * PROJ_LD + C_SK + kvh * 64 + lane]), vx = bf2f(proj[tk * PROJ_LD + C_SV + kvh * 64 + lane]);
        const float s = wave_sum(qv * kx) + rel[t5_bucket(pq - pos[tk]) * 16 + hh];
        const float mn = fmaxf(m, s), c = __expf(m - mn), p = __expf(s - mn);
        l = l * c + p; o = o * c + p * vx; m = mn;
    }
    O[t * DM + 1024 + hh * 64 + lane] = (bf16_t)f2bf(o / l);
}
DEVI void p4_row(bf16_t* p, int lane) {
    float f[4][8]; float sa = 0.f, sb = 0.f;
#pragma unroll
    for (int i = 0; i < 4; ++i) { unpack8(*(const u32x4*)(p + lane * 8 + 512 * i), f[i]);
        float s = 0.f;
#pragma unroll
        for (int e = 0; e < 8; ++e) s += f[i][e] * f[i][e];
        if (i < 2) sa += s; else sb += s; }
    const float ra = 1.f / sqrtf(wave_sum(sa) * (1.f / 1024.f) + EPS), rb = 1.f / sqrtf(wave_sum(sb) * (1.f / 1024.f) + EPS);
#pragma unroll
    for (int i = 0; i < 4; ++i) { const float r = i < 2 ? ra : rb;
#pragma unroll
        for (int e = 0; e < 8; ++e) f[i][e] *= r;
        *(u32x4*)(p + lane * 8 + 512 * i) = pack8(f[i]); }
}
DEVI void p4_row_q(bf16_t* p, float* rs, int lane) {
    float f[4][8]; float sa = 0.f, sb = 0.f;
#pragma unroll
    for (int i = 0; i < 4; ++i) { unpack8(*(const u32x4*)(p + lane * 8 + 512 * i), f[i]);
        float s = 0.f;
#pragma unroll
        for (int e = 0; e < 8; ++e) s += f[i][e] * f[i][e];
        if (i < 2) sa += s; else sb += s; }
    const float ra = 1.f / sqrtf(wave_sum(sa) * (1.f / 1024.f) + EPS), rb = 1.f / sqrtf(wave_sum(sb) * (1.f / 1024.f) + EPS);
    float am = 0.f;
#pragma unroll
    for (int i = 0; i < 4; ++i) { const float r = i < 2 ? ra : rb;
#pragma unroll
        for (int e = 0; e < 8; ++e) { f[i][e] *= r; am = fmaxf(am, fabsf(f[i][e])); } }
    am = wave_max(am);
    const float sc = am > 0.f ? 127.f / am : 0.f;
#pragma unroll
    for (int i = 0; i < 4; ++i) { u32x2 o; o.x = pack4_i8((f32x4){f[i][0], f[i][1], f[i][2], f[i][3]} * sc); o.y = pack4_i8((f32x4){f[i][4], f[i][5], f[i][6], f[i][7]} * sc);
        *(u32x2*)((signed char*)p + lane * 8 + 512 * i) = o; }
    if (lane == 0) *rs = am * (1.f / 127.f);
}
DEVI void p5_row(const float* hrow, bf16_t* orow, int lane) {
    f32x4 v[8]; float s = 0.f;
#pragma unroll
    for (int j = 0; j < 8; ++j) { v[j] = *(const f32x4*)(hrow + 4 * (lane + 64 * j)); s += v[j].x * v[j].x + v[j].y * v[j].y + v[j].z * v[j].z + v[j].w * v[j].w; }
    const float r = 1.f / sqrtf(wave_sum(s) * (1.f / DM) + EPS);
#pragma unroll
    for (int j = 0; j < 8; ++j) { u32x2 o; o.x = pk2(v[j].x * r, v[j].y * r); o.y = pk2(v[j].z * r, v[j].w * r); *(u32x2*)(orow + 4 * (lane + 64 * j)) = o; }
}
DEVI void topk_task(const bf16_t* qp, const bf16_t* subk, int* idx, float* gw, size_t t, int h, int lane) {
    float tv[2]; int ti[2];
#pragma unroll
    for (int p = 0; p < 2; ++p) {
        const bf16_t* qs = qp + t * DM + h * 256 + p * 128;
        const float qlo = bf2f(qs[lane]), qhi = bf2f(qs[64 + lane]);
        const bf16_t* k0 = subk + ((size_t)(h * 2 + p) * 128 + lane) * 128; const bf16_t* k1 = k0 + 64 * 128;
        float a0 = 0.f, a1 = 0.f;
        for (int d = 0; d < 64; ++d) { const float qd = __shfl(qlo, d); a0 += qd * bf2f(k0[d]); a1 += qd * bf2f(k1[d]); }
        for (int d = 0; d < 64; ++d) { const float qd = __shfl(qhi, d); a0 += qd * bf2f(k0[64 + d]); a1 += qd * bf2f(k1[64 + d]); }
        float v0 = a0, v1 = a1; float mytv = -INFINITY; int myti = 0;
        for (int r = 0; r < 16; ++r) {
            float bv = v0 >= v1 ? v0 : v1; int bi = v0 >= v1 ? lane : lane + 64;
#pragma unroll
            for (int o = 32; o >= 1; o >>= 1) { const float ov = __shfl_xor(bv, o); const int oi = __shfl_xor(bi, o); if (ov > bv || (ov == bv && oi < bi)) { bv = ov; bi = oi; } }
            if (lane == r) { mytv = bv; myti = bi; }
            if (bi == lane) v0 = -INFINITY;
            if (bi == lane + 64) v1 = -INFINITY;
        }
        tv[p] = mytv; ti[p] = myti;
    }
    float cv[4];
#pragma unroll
    for (int mm = 0; mm < 4; ++mm) { const int c = lane + 64 * mm; cv[mm] = __shfl(tv[0], c >> 4) + __shfl(tv[1], c & 15); }
    float mys = -INFINITY; int myc = 0;
    for (int r = 0; r < 16; ++r) {
        float bv = cv[0]; int bc = lane;
#pragma unroll
        for (int mm = 1; mm < 4; ++mm) if (cv[mm] > bv) { bv = cv[mm]; bc = lane + 64 * mm; }
#pragma unroll
        for (int o = 32; o >= 1; o >>= 1) { const float ov = __shfl_xor(bv, o); const int oc = __shfl_xor(bc, o); if (ov > bv || (ov == bv && oc < bc)) { bv = ov; bc = oc; } }
        if (lane == r) { mys = bv; myc = bc; }
#pragma unroll
        for (int mm = 0; mm < 4; ++mm) if (bc == lane + 64 * mm) cv[mm] = -INFINITY;
    }
    const int i1 = __shfl(ti[0], (myc >> 4) & 15), i2 = __shfl(ti[1], myc & 15);
    float mx = mys;
#pragma unroll
    for (int o = 8; o >= 1; o >>= 1) mx = fmaxf(mx, __shfl_xor(mx, o));
    const float e = __expf(mys - mx); float sm = e;
#pragma unroll
    for (int o = 8; o >= 1; o >>= 1) sm += __shfl_xor(sm, o);
    if (lane < 16) { idx[t * 128 + h * 16 + lane] = i1 * 128 + i2; gw[t * 128 + h * 16 + lane] = e / sm; }
}
DEVI void gather_token(const bf16_t* hn, const bf16_t* Ub, const bf16_t* Vb, const int* idx, const float* gw, float* out, size_t t, int lane) {
    float hv[4][8];
#pragma unroll
    for (int i = 0; i < 4; ++i) unpack8(*(const u32x4*)(hn + t * DM + lane * 8 + 512 * i), hv[i]);
    float y[4][8];
#pragma unroll
    for (int i = 0; i < 4; ++i)
#pragma unroll
        for (int e = 0; e < 8; ++e) y[i][e] = 0.f;
#pragma unroll 2
    for (int k = 0; k < 128; ++k) {
        const int ex = idx[t * 128 + k]; const float g = gw[t * 128 + k];
        const bf16_t* ur = Ub + (size_t)ex * DM + lane * 8; const bf16_t* vr = Vb + (size_t)ex * DM + lane * 8;
        u32x4 uw[4], vw[4];
#pragma unroll
        for (int i = 0; i < 4; ++i) { uw[i] = *(const u32x4*)(ur + 512 * i); vw[i] = *(const u32x4*)(vr + 512 * i); }
        float d = 0.f;
#pragma unroll
        for (int i = 0; i < 4; ++i) { float f[8]; unpack8(uw[i], f);
#pragma unroll
            for (int e = 0; e < 8; ++e) d += f[e] * hv[i][e]; }
        const float a = wave_sum(d);
        const float wgt = g * gelu_tanh(a);
#pragma unroll
        for (int i = 0; i < 4; ++i) { float f[8]; unpack8(vw[i], f);
#pragma unroll
            for (int e = 0; e < 8; ++e) y[i][e] += wgt * f[e]; }
    }
#pragma unroll
    for (int i = 0; i < 4; ++i) { float* o = out + t * DM + lane * 8 + 512 * i;
        f32x4 a = *(const f32x4*)o, b = *(const f32x4*)(o + 4);
        a.x += y[i][0]; a.y += y[i][1]; a.z += y[i][2]; a.w += y[i][3]; b.x += y[i][4]; b.y += y[i][5]; b.z += y[i][6]; b.w += y[i][7];
        *(f32x4*)o = a; *(f32x4*)(o + 4) = b; }
}


typedef float f32x16 __attribute__((ext_vector_type(16)));
typedef short s16x4 __attribute__((ext_vector_type(4)));
namespace mla {
constexpr int SLOT = 40960, KOFF = 0, VOFF = 24576, NSLOT = 3, WS_OFF = NSLOT * SLOT;
DEVI int crow(int r, int hh) { return (r & 3) + 8 * (r >> 2) + 4 * hh; }
DEVI void glds16(const void* gsrc, unsigned lds_dst) { unsigned keep;
    asm volatile("s_mov_b32 %0, m0\n\ts_mov_b32 m0, %2\n\ts_nop 0\n\tglobal_load_lds_dwordx4 %1, off\n\ts_mov_b32 m0, %0" : "=&s"(keep) : "v"(gsrc), "s"(lds_dst) : "memory"); }
DEVI s16x4 vtr(LAS const unsigned char* p) { return __builtin_bit_cast(s16x4, __builtin_amdgcn_ds_read_tr16_b64_v4i16((LAS s16x4*)p)); }

DEVI void unit(LAS unsigned char* lds, const bf16_t* Q, const bf16_t* K, const bf16_t* KV, bf16_t* O, int b, int h, int qb) {
    const int tid = threadIdx.x, lane = tid & 63, w = __builtin_amdgcn_readfirstlane(tid >> 6), r32 = lane & 31, hh = lane >> 5;
    const int grp = w >> 2;
    const int q0 = qb * 256; const size_t rowbase = (size_t)b * SEQ;
    const int NT = (q0 + 256) / 64;
    const int prow = 8 * w + (lane >> 3);
    const char* kg = (const char*)(K + (rowbase + prow) * QK_LD + h * 192 + 8 * ((lane & 7) ^ ((prow >> 1) & 7)));
    const char* vg = (const char*)(KV + (rowbase + prow) * KV_LD + 1024 + h * 128 + 8 * (((((lane & 7) >> 2) ^ ((prow >> 1) & 1)) << 2) | (lane & 3)));
    const unsigned kdst = (unsigned)(KOFF + w * 1024), vdst = (unsigned)(VOFF + w * 1024);
    const unsigned lds0 = (unsigned)(uintptr_t)lds;
#define MLA_ISSUE(t, slotoff) do { \
        const char* kp_ = kg + (size_t)(t) * 64 * QK_LD * 2; const char* vp_ = vg + (size_t)(t) * 64 * KV_LD * 2; \
        _Pragma("unroll") for (int i_ = 0; i_ < 3; ++i_) glds16(kp_ + i_ * 128, (unsigned)__builtin_amdgcn_readfirstlane((int)(lds0 + (slotoff) + kdst + i_ * 8192))); \
        _Pragma("unroll") for (int i_ = 0; i_ < 2; ++i_) glds16(vp_ + i_ * 128, (unsigned)__builtin_amdgcn_readfirstlane((int)(lds0 + (slotoff) + vdst + i_ * 8192))); } while (0)
    MLA_ISSUE(0, 0); MLA_ISSUE(1, SLOT);
    const bf16_t* qrow = Q + (rowbase + q0 + 32 * w + r32) * QK_LD + h * 192 + 8 * hh;
    bf16x8 qf[12];
#pragma unroll
    for (int ks = 0; ks < 12; ++ks) qf[ks] = *(const bf16x8*)(qrow + 16 * ks);
#pragma unroll
    for (int ks = 0; ks < 12; ++ks) asm volatile("" : "+v"(qf[ks]));
    f32x16 o[4];
#pragma unroll
    for (int d = 0; d < 4; ++d)
#pragma unroll
        for (int r = 0; r < 16; ++r) o[d][r] = 0.f;
    float mref = 0.f, lsum = 0.f;
    LAS float* wsf = (LAS float*)(lds + WS_OFF) + w * 32;
    const int ksw = (r32 >> 1) & 7;
    const int vread = VOFF + ((lane >> 4) & 1) * 32 + (lane & 3) * 8 + (4 * hh + ((lane & 15) >> 2)) * 128;
    asm volatile("s_waitcnt vmcnt(5)" ::: "memory");
    __builtin_amdgcn_s_barrier();
    asm volatile("" ::: "memory");
#define MLA_BAR() do { asm volatile("s_waitcnt lgkmcnt(0)" ::: "memory"); __builtin_amdgcn_s_barrier(); asm volatile("" ::: "memory"); } while (0)
#define MLA_PREFETCH(i) do { if ((i) + 2 < NT) { const int so_ = (((i) + 2) % 3) * SLOT; MLA_ISSUE((i) + 2, so_); } } while (0)
#define MLA_LANDED(i) do { if ((i) + 2 < NT) asm volatile("s_waitcnt vmcnt(5)" ::: "memory"); else asm volatile("s_waitcnt vmcnt(0)" ::: "memory"); } while (0)
    if (grp) MLA_BAR();
    for (int t = 0; t < NT; ++t) {
        const int slot = (t % 3) * SLOT;
        if (grp) MLA_PREFETCH(t);
        f32x16 s0, s1;
        {
            unsigned kr[4];
#pragma unroll
            for (int j = 0; j < 4; ++j) kr[j] = lds0 + (unsigned)(slot + KOFF + r32 * 128 + (((2 * j + hh) ^ ksw) * 16));
#define MLA_KLD(ks, d0, d1) do { asm volatile("ds_read_b128 %0, %1 offset:%2" : "=&v"(d0) : "v"(kr[(ks) & 3]), "i"(((ks) >> 2) * 8192)); \
                                 asm volatile("ds_read_b128 %0, %1 offset:%2" : "=&v"(d1) : "v"(kr[(ks) & 3]), "i"(((ks) >> 2) * 8192 + 4096)); } while (0)
            bf16x8 ka[3], kb[3];
            __builtin_amdgcn_s_setprio(1);
            MLA_KLD(0, ka[0], kb[0]); MLA_KLD(1, ka[1], kb[1]);
#pragma unroll
            for (int ks = 0; ks < 12; ++ks) {
                if (ks + 2 < 12) { MLA_KLD(ks + 2, ka[(ks + 2) % 3], kb[(ks + 2) % 3]); asm volatile("s_waitcnt lgkmcnt(4)" : "+v"(ka[ks % 3]), "+v"(kb[ks % 3])); }
                else if (ks + 1 < 12) asm volatile("s_waitcnt lgkmcnt(2)" : "+v"(ka[ks % 3]), "+v"(kb[ks % 3]));
                else asm volatile("s_waitcnt lgkmcnt(0)" : "+v"(ka[ks % 3]), "+v"(kb[ks % 3]));
                if (ks == 0) { f32x16 z;
#pragma unroll
                    for (int r = 0; r < 16; ++r) z[r] = 0.f;
                    s0 = __builtin_amdgcn_mfma_f32_32x32x16_bf16(ka[0], qf[0], z, 0, 0, 0); s1 = __builtin_amdgcn_mfma_f32_32x32x16_bf16(kb[0], qf[0], z, 0, 0, 0); }
                else { s0 = __builtin_amdgcn_mfma_f32_32x32x16_bf16(ka[ks % 3], qf[ks], s0, 0, 0, 0); s1 = __builtin_amdgcn_mfma_f32_32x32x16_bf16(kb[ks % 3], qf[ks], s1, 0, 0, 0); }
            }
#undef MLA_KLD
            __builtin_amdgcn_s_setprio(0);
        }
        if (grp) MLA_LANDED(t);
        MLA_BAR();
        if (!grp) MLA_PREFETCH(t);
        {
            const int jb = t - (NT - 4);
            if (jb >= 0) {
                const int qrel = 32 * w + r32, kb_ = 64 * jb + 4 * hh;
#pragma unroll
                for (int r = 0; r < 16; ++r) { const int kv = kb_ + (r & 3) + 8 * (r >> 2); if (kv > qrel) s0[r] = -INFINITY; if (kv + 32 > qrel) s1[r] = -INFINITY; }
            }
            float ma = fmaxf(fmaxf(s0[0], s0[1]), s1[0]), mb = fmaxf(fmaxf(s0[2], s0[3]), s1[1]);
            ma = fmaxf(fmaxf(ma, s1[2]), s1[3]);
#pragma unroll
            for (int r = 4; r < 16; r += 4) { ma = fmaxf(fmaxf(ma, s0[r]), s0[r + 1]); mb = fmaxf(fmaxf(mb, s0[r + 2]), s0[r + 3]); ma = fmaxf(fmaxf(ma, s1[r]), s1[r + 1]); mb = fmaxf(fmaxf(mb, s1[r + 2]), s1[r + 3]); }
            float rm = fmaxf(ma, mb) - mref;
            rm = fmaxf(rm, __shfl_xor(rm, 32));
            if (__any(rm > 8.f)) {
                const float dl = fmaxf(rm, 0.f);
                mref += dl;
                const float corr = __builtin_amdgcn_exp2f(-dl);
                lsum *= corr;
                if (hh == 0) wsf[r32] = corr;
                asm volatile("s_waitcnt lgkmcnt(0)" ::: "memory");
#pragma unroll
                for (int g = 0; g < 4; ++g) { const f32x4 c4 = *(LAS const f32x4*)(wsf + 8 * g + 4 * hh);
#pragma unroll
                    for (int d = 0; d < 4; ++d) { o[d][4 * g + 0] *= c4[0]; o[d][4 * g + 1] *= c4[1]; o[d][4 * g + 2] *= c4[2]; o[d][4 * g + 3] *= c4[3]; } }
                asm volatile("s_waitcnt lgkmcnt(0)" ::: "memory");
            }
            float ps = 0.f;
#pragma unroll
            for (int r = 0; r < 16; ++r) { s0[r] = __builtin_amdgcn_exp2f(s0[r] - mref); s1[r] = __builtin_amdgcn_exp2f(s1[r] - mref); ps += s0[r] + s1[r]; }
            lsum += ps;
            bf16x8 pf[4];
#pragma unroll
            for (int ks = 0; ks < 4; ++ks) {
                u32x4 wv;
                if (ks < 2) { wv.x = pk2(s0[8 * ks + 0], s0[8 * ks + 1]); wv.y = pk2(s0[8 * ks + 2], s0[8 * ks + 3]); wv.z = pk2(s0[8 * ks + 4], s0[8 * ks + 5]); wv.w = pk2(s0[8 * ks + 6], s0[8 * ks + 7]); }
                else { const int k2 = ks - 2; wv.x = pk2(s1[8 * k2 + 0], s1[8 * k2 + 1]); wv.y = pk2(s1[8 * k2 + 2], s1[8 * k2 + 3]); wv.z = pk2(s1[8 * k2 + 4], s1[8 * k2 + 5]); wv.w = pk2(s1[8 * k2 + 6], s1[8 * k2 + 7]); }
                pf[ks] = __builtin_bit_cast(bf16x8, wv);
            }
            const unsigned rb64 = (unsigned)(((lane >> 3) & 1) * 64);
            const unsigned va0 = lds0 + (unsigned)(slot + vread) + rb64, va1 = lds0 + (unsigned)(slot + vread) + (64u - rb64);
            s16x4 vlo[3], vhi[3];
#define MLA_VLD(i, b) do { if (((i) >> 2) & 1) { asm volatile("ds_read_b64_tr_b16 %0, %1 offset:%2" : "=&v"(vlo[b]) : "v"(va1), "i"(((i) >> 3) * 8192 + ((i) & 3) * 2048)); \
                                                 asm volatile("ds_read_b64_tr_b16 %0, %1 offset:%2" : "=&v"(vhi[b]) : "v"(va1), "i"(((i) >> 3) * 8192 + ((i) & 3) * 2048 + 1024)); } \
                           else { asm volatile("ds_read_b64_tr_b16 %0, %1 offset:%2" : "=&v"(vlo[b]) : "v"(va0), "i"(((i) >> 3) * 8192 + ((i) & 3) * 2048)); \
                                  asm volatile("ds_read_b64_tr_b16 %0, %1 offset:%2" : "=&v"(vhi[b]) : "v"(va0), "i"(((i) >> 3) * 8192 + ((i) & 3) * 2048 + 1024)); } } while (0)
            __builtin_amdgcn_s_setprio(1);
            MLA_VLD(0, 0); MLA_VLD(1, 1);
#pragma unroll
            for (int i = 0; i < 16; ++i) {
                if (i + 2 < 16) { MLA_VLD(i + 2, (i + 2) % 3); asm volatile("s_waitcnt lgkmcnt(4)" : "+v"(vlo[i % 3]), "+v"(vhi[i % 3])); }
                else if (i + 1 < 16) asm volatile("s_waitcnt lgkmcnt(2)" : "+v"(vlo[i % 3]), "+v"(vhi[i % 3]));
                else asm volatile("s_waitcnt lgkmcnt(0)" : "+v"(vlo[i % 3]), "+v"(vhi[i % 3]));
                const s16x4 lo = vlo[i % 3], hi = vhi[i % 3];
                const bf16x8 vf = (bf16x8){lo[0], lo[1], lo[2], lo[3], hi[0], hi[1], hi[2], hi[3]};
                o[i >> 2] = __builtin_amdgcn_mfma_f32_32x32x16_bf16(pf[i & 3], vf, o[i >> 2], 0, 0, 0);
            }
#undef MLA_VLD
            __builtin_amdgcn_s_setprio(0);
        }
        if (!grp) MLA_LANDED(t);
        MLA_BAR();
    }
    if (!grp) MLA_BAR();
#undef MLA_BAR
#undef MLA_PREFETCH
#undef MLA_LANDED
    lsum += __shfl_xor(lsum, 32);
    if (hh == 0) wsf[r32] = 1.f / lsum;
    asm volatile("s_waitcnt lgkmcnt(0)" ::: "memory");
    bf16_t* orow = O + (rowbase + q0 + 32 * w) * DM + h * 128 + r32;
#pragma unroll
    for (int g = 0; g < 4; ++g) { const f32x4 c4 = *(LAS const f32x4*)(wsf + 8 * g + 4 * hh);
#pragma unroll
        for (int e = 0; e < 4; ++e) { const int qr = 8 * g + 4 * hh + e;
#pragma unroll
            for (int d = 0; d < 4; ++d) orow[(size_t)qr * DM + 32 * d] = (bf16_t)f2bf(o[d][4 * g + e] * c4[e]); } }
    asm volatile("s_waitcnt lgkmcnt(0)" ::: "memory");
    __builtin_amdgcn_s_barrier();
    asm volatile("" ::: "memory");
#undef MLA_ISSUE
}
DEVI void phase(LAS unsigned char* lds, const bf16_t* Q, const bf16_t* K, const bf16_t* KV, bf16_t* O, int vcu, int G) {
    for (int p = vcu; p < 256; p += G) {
        const int bh = p >> 3, s = p & 7;
        unit(lds, Q, K, KV, O, bh >> 3, bh & 7, 15 - s);
        unit(lds, Q, K, KV, O, bh >> 3, bh & 7, s);
    }
}
}


namespace peer {
typedef float f32x2 __attribute__((ext_vector_type(2)));
DEVI float rl(float v, int l) { return __builtin_bit_cast(float, __builtin_amdgcn_readlane(__builtin_bit_cast(int, v), l)); }
DEVI void convert_load(f32x4 (&v)[8], const float* src, int lane) {
#pragma unroll
    for (int i = 0; i < 8; ++i) v[i] = *(const f32x4*)(src + 256 * i + 4 * lane);
}
template <bool HAS_GAIN, bool INT8> DEVI void convert_finish(f32x4 (&v)[8], const f32x4 (&gn)[8], unsigned char* dst, float* scale_inv, int lane) {
    float am = 0.f;
#pragma unroll
    for (int i = 0; i < 8; ++i) { f32x4 x = v[i]; if (HAS_GAIN) x = x * gn[i];
        v[i] = x; am = fmaxf(am, fmaxf(fmaxf(fabsf(x[0]), fabsf(x[1])), fmaxf(fabsf(x[2]), fabsf(x[3])))); }
#pragma unroll
    for (int o = 1; o < 64; o <<= 1) am = fmaxf(am, __shfl_xor(am, o));
    const float top = INT8 ? 127.f : 256.f;
    const float sc = am > 0.f ? top / am : 1.f;
#pragma unroll
    for (int i = 0; i < 8; ++i) { const f32x4 x = v[i] * sc; int p;
        if (INT8) { const int q0 = __float2int_rn(x[0]), q1 = __float2int_rn(x[1]), q2 = __float2int_rn(x[2]), q3 = __float2int_rn(x[3]);
                    p = (q0 & 255) | ((q1 & 255) << 8) | ((q2 & 255) << 16) | (q3 << 24); }
        else { p = __builtin_amdgcn_cvt_pk_fp8_f32(x[0], x[1], 0, false); p = __builtin_amdgcn_cvt_pk_fp8_f32(x[2], x[3], p, true); }
        *(int*)(dst + ((size_t)(2 * i + (lane >> 5)) * 16384) * 128 + 4 * (lane & 31)) = p; }
    if (lane == 0) *scale_inv = am > 0.f ? am / top : 1.f;
}
template <bool HAS_GAIN> DEVI void convert_rows(const float* src, const float* gain, unsigned char* dst, float* scale_inv, int first, int stride, int n, int lane) {
    if (first >= n) return;
    f32x4 gn[8];
#pragma unroll
    for (int i = 0; i < 8; ++i) gn[i] = HAS_GAIN ? *(const f32x4*)(gain + 256 * i + 4 * lane) : (f32x4){1.f, 1.f, 1.f, 1.f};
    f32x4 cur[8], nx1[8], nx2[8];
    int r = first;
    if (r + stride < n) {
        convert_load(cur, src + (size_t)r * DM, lane);
        convert_load(nx1, src + (size_t)(r + stride) * DM, lane);
        for (; r + 2 * stride < n; r += stride) {
            convert_load(nx2, src + (size_t)(r + 2 * stride) * DM, lane);
            convert_finish<HAS_GAIN, true>(cur, gn, dst + (size_t)r * 128, scale_inv + r, lane);
#pragma unroll
            for (int i = 0; i < 8; ++i) { cur[i] = nx1[i]; nx1[i] = nx2[i]; }
        }
        convert_finish<HAS_GAIN, true>(cur, gn, dst + (size_t)r * 128, scale_inv + r, lane); r += stride;
        convert_finish<HAS_GAIN, true>(nx1, gn, dst + (size_t)r * 128, scale_inv + r, lane);
    } else {
        convert_load(cur, src + (size_t)r * DM, lane);
        convert_finish<HAS_GAIN, true>(cur, gn, dst + (size_t)r * 128, scale_inv + r, lane);
    }
}
DEVI float reduce4(float p0, float p1, float p2, float p3, int lane) {
    const bool h5 = (lane & 32) != 0, h4 = (lane & 16) != 0;
    float a = h5 ? p2 : p0, b = h5 ? p0 : p2; a += __shfl_xor(b, 32);
    float c = h5 ? p3 : p1, d = h5 ? p1 : p3; c += __shfl_xor(d, 32);
    float x = h4 ? c : a, y = h4 ? a : c; x += __shfl_xor(y, 16);
    x += __shfl_xor(x, 8); x += __shfl_xor(x, 4); x += __shfl_xor(x, 2); x += __shfl_xor(x, 1);
    return x;
}
#define PEER_LOAD4(buf, base, sel, k0) do { _Pragma("unroll") for (int r_ = 0; r_ < 4; ++r_) { \
        const unsigned char* rp_ = (base) + (size_t)__builtin_amdgcn_readlane((sel), ((k0) + r_) & 63) * DM + lane * 16; \
        buf[r_][0] = *(const u32x4*)(rp_); buf[r_][1] = *(const u32x4*)(rp_ + 1024); } } while (0)
DEVI float dotrow(const u32x4 (&row)[2], const f32x2 (&h2)[16]) {
    f32x2 p = (f32x2){0.f, 0.f};
#pragma unroll
    for (int c = 0; c < 2; ++c)
#pragma unroll
        for (int j = 0; j < 4; ++j) { const int wv = (int)row[c][j];
            const f32x2 f01 = __builtin_amdgcn_cvt_pk_f32_fp8(wv, false), f23 = __builtin_amdgcn_cvt_pk_f32_fp8(wv, true);
            p += f01 * h2[8 * c + 2 * j]; p += f23 * h2[8 * c + 2 * j + 1]; }
    return p[0] + p[1];
}
DEVI void axpyrow(f32x2 (&y)[16], const u32x4 (&row)[2], float wk) {
#pragma unroll
    for (int c = 0; c < 2; ++c)
#pragma unroll
        for (int j = 0; j < 4; ++j) { const int wv = (int)row[c][j];
            const f32x2 f01 = __builtin_amdgcn_cvt_pk_f32_fp8(wv, false), f23 = __builtin_amdgcn_cvt_pk_f32_fp8(wv, true);
            y[8 * c + 2 * j] += f01 * wk; y[8 * c + 2 * j + 1] += f23 * wk; }
}
DEVI void token(LAS float* scr, const bf16_t* hn, const unsigned char* U8, const unsigned char* V8, const float* usc, const float* vsc, const int* idx, const float* gw, float* out, size_t t, int lane) {
    f32x2 h2[16];
#pragma unroll
    for (int c = 0; c < 2; ++c)
#pragma unroll
        for (int q = 0; q < 2; ++q) { const u32x4 w = *(const u32x4*)(hn + t * DM + 1024 * c + 16 * lane + 8 * q); float f[8]; unpack8(w, f);
#pragma unroll
            for (int e = 0; e < 4; ++e) h2[8 * c + 4 * q + e] = (f32x2){f[2 * e], f[2 * e + 1]}; }
    const int idlo = idx[t * 128 + lane], idhi = idx[t * 128 + 64 + lane];
    const float glo = gw[t * 128 + lane] * vsc[idlo], ghi = gw[t * 128 + 64 + lane] * vsc[idhi];
    const float ulo = usc[idlo], uhi = usc[idhi];
    u32x4 bA[4][2], bB[4][2];
    PEER_LOAD4(bA, U8, idlo, 0);
    for (int kb = 0; kb < 128; kb += 8) {
        const int sel = kb < 64 ? idlo : idhi;
        PEER_LOAD4(bB, U8, sel, kb + 4);
        { const float x = reduce4(dotrow(bA[0], h2), dotrow(bA[1], h2), dotrow(bA[2], h2), dotrow(bA[3], h2), lane); if ((lane & 15) == 0) scr[kb + (lane >> 4)] = x; }
        if (kb + 8 < 128) { const int sel2 = (kb + 8) < 64 ? idlo : idhi; PEER_LOAD4(bA, U8, sel2, kb + 8); }
        { const float x = reduce4(dotrow(bB[0], h2), dotrow(bB[1], h2), dotrow(bB[2], h2), dotrow(bB[3], h2), lane); if ((lane & 15) == 0) scr[kb + 4 + (lane >> 4)] = x; }
    }
    asm volatile("s_waitcnt lgkmcnt(0)" ::: "memory");
    const float wlo = glo * gelu_tanh(scr[lane] * ulo), whi = ghi * gelu_tanh(scr[64 + lane] * uhi);
    asm volatile("s_waitcnt lgkmcnt(0)" ::: "memory");
    f32x2 y[16];
#pragma unroll
    for (int i = 0; i < 16; ++i) y[i] = (f32x2){0.f, 0.f};
    PEER_LOAD4(bA, V8, idlo, 0);
    for (int kb = 0; kb < 128; kb += 8) {
        const int sel = kb < 64 ? idlo : idhi; const float wsel = kb < 64 ? wlo : whi;
        PEER_LOAD4(bB, V8, sel, kb + 4);
#pragma unroll
        for (int r = 0; r < 4; ++r) axpyrow(y, bA[r], rl(wsel, (kb + r) & 63));
        if (kb + 8 < 128) { const int sel2 = (kb + 8) < 64 ? idlo : idhi; PEER_LOAD4(bA, V8, sel2, kb + 8); }
#pragma unroll
        for (int r = 0; r < 4; ++r) axpyrow(y, bB[r], rl(wsel, (kb + 4 + r) & 63));
    }
#pragma unroll
    for (int c = 0; c < 2; ++c)
#pragma unroll
        for (int j = 0; j < 4; ++j) { float* o = out + t * DM + 1024 * c + 16 * lane + 4 * j;
            f32x4 a = *(const f32x4*)o; a[0] += y[8 * c + 2 * j][0]; a[1] += y[8 * c + 2 * j][1]; a[2] += y[8 * c + 2 * j + 1][0]; a[3] += y[8 * c + 2 * j + 1][1];
            *(f32x4*)o = a; }
}
#undef PEER_LOAD4

DEVI f32x2 dot16(const u32x4 row, const f32x2 (&h2)[8], f32x2 p) {
#pragma unroll
    for (int j = 0; j < 4; ++j) { const int wv = (int)row[j];
        p += __builtin_amdgcn_cvt_pk_f32_fp8(wv, false) * h2[2 * j]; p += __builtin_amdgcn_cvt_pk_f32_fp8(wv, true) * h2[2 * j + 1]; }
    return p;
}
template <int M> DEVI float xshf(float x) {
    if constexpr (M == 1) return __builtin_bit_cast(float, __builtin_amdgcn_update_dpp(0, __builtin_bit_cast(int, x), 0xB1, 0xF, 0xF, false));
    else if constexpr (M == 2) return __builtin_bit_cast(float, __builtin_amdgcn_update_dpp(0, __builtin_bit_cast(int, x), 0x4E, 0xF, 0xF, false));
    else return __shfl_xor(x, M);
}
template <int M> DEVI int xshi(int x) {
    if constexpr (M == 1) return __builtin_amdgcn_update_dpp(0, x, 0xB1, 0xF, 0xF, false);
    else if constexpr (M == 2) return __builtin_amdgcn_update_dpp(0, x, 0x4E, 0xF, 0xF, false);
    else return __shfl_xor(x, M);
}
template <int B2, int B1, int B0> DEVI void reduce16i(const int (&v)[16], int lane, int& o0, int& o1) {
    const bool b2 = (lane & B2) != 0, b1 = (lane & B1) != 0, b0 = (lane & B0) != 0;
    int q[8], r[4];
#pragma unroll
    for (int j = 0; j < 8; ++j) q[j] = (b2 ? v[8 + j] : v[j]) + xshi<B2>(b2 ? v[j] : v[8 + j]);
#pragma unroll
    for (int j = 0; j < 4; ++j) r[j] = (b1 ? q[4 + j] : q[j]) + xshi<B1>(b1 ? q[j] : q[4 + j]);
    o0 = (b0 ? r[2] : r[0]) + xshi<B0>(b0 ? r[0] : r[2]);
    o1 = (b0 ? r[3] : r[1]) + xshi<B0>(b0 ? r[1] : r[3]);
}
template <int B2, int B1, int B0> DEVI f32x2 reduce16(const float (&v)[16], int lane) {
    const bool b2 = (lane & B2) != 0, b1 = (lane & B1) != 0, b0 = (lane & B0) != 0;
    float q[8], r[4];
#pragma unroll
    for (int j = 0; j < 8; ++j) q[j] = (b2 ? v[8 + j] : v[j]) + xshf<B2>(b2 ? v[j] : v[8 + j]);
#pragma unroll
    for (int j = 0; j < 4; ++j) r[j] = (b1 ? q[4 + j] : q[j]) + xshf<B1>(b1 ? q[j] : q[4 + j]);
    f32x2 o;
    o[0] = (b0 ? r[2] : r[0]) + xshf<B0>(b0 ? r[0] : r[2]);
    o[1] = (b0 ? r[3] : r[1]) + xshf<B0>(b0 ? r[1] : r[3]);
    return o;
}
template <int MASK> DEVI u32x4 bcast4(const u32x4 v) {
    u32x4 r;
#pragma unroll
    for (int k = 0; k < 4; ++k) r[k] = (unsigned)__builtin_amdgcn_ds_swizzle((int)v[k], MASK);
    return r;
}
DEVI void unpack_ids(const u32x4 lo, const u32x4 hi, int (&id)[16]) {
#pragma unroll
    for (int k = 0; k < 4; ++k) { id[2 * k] = (int)(lo[k] & 0xffffu); id[2 * k + 1] = (int)(lo[k] >> 16); id[8 + 2 * k] = (int)(hi[k] & 0xffffu); id[8 + 2 * k + 1] = (int)(hi[k] >> 16); }
}
DEVI void h_to_int8(const bf16_t* hrow, const float ssq, signed char* orow, float* hsc_inv, int lane) {
    const float rms = sqrtf(ssq * (1.f / DM) + EPS), sc = 127.f / (6.f * rms);
#pragma unroll
    for (int i = 0; i < 4; ++i) { float f[8]; unpack8(*(const u32x4*)(hrow + 512 * i + 8 * lane), f);
        u32x2 w;
        { const int q0 = max(-127, min(127, __float2int_rn(f[0] * sc))), q1 = max(-127, min(127, __float2int_rn(f[1] * sc))), q2 = max(-127, min(127, __float2int_rn(f[2] * sc))), q3 = max(-127, min(127, __float2int_rn(f[3] * sc)));
          w.x = (unsigned)((q0 & 255) | ((q1 & 255) << 8) | ((q2 & 255) << 16) | (q3 << 24)); }
        { const int q0 = max(-127, min(127, __float2int_rn(f[4] * sc))), q1 = max(-127, min(127, __float2int_rn(f[5] * sc))), q2 = max(-127, min(127, __float2int_rn(f[6] * sc))), q3 = max(-127, min(127, __float2int_rn(f[7] * sc)));
          w.y = (unsigned)((q0 & 255) | ((q1 & 255) << 8) | ((q2 & 255) << 16) | (q3 << 24)); }
        *(u32x2*)(orow + 512 * i + 8 * lane) = w; }
    if (lane == 0) *hsc_inv = 6.f * rms * (1.f / 127.f);
}
DEVI void sliceA(const signed char* h8, const unsigned char* U8, const unsigned short* idx, bf16_t* aP, int s, int t0, int nt, int lane) {
    const int g = lane >> 3, c8 = lane & 7;
    const unsigned char* ub = U8 + (size_t)s * 16384 * 128; const unsigned lo = 16u * (unsigned)c8;
    const bool ldi = (c8 == 0), ldh = ((lane & 0x18) == 0);
    u32x4 il = (u32x4){0u, 0u, 0u, 0u}, ih = il, hw = il;
    if (ldi) { il = *(const u32x4*)(idx + (size_t)t0 * 128 + 16 * g); ih = *(const u32x4*)(idx + (size_t)t0 * 128 + 16 * g + 8); }
    if (ldh) hw = *(const u32x4*)(h8 + (size_t)t0 * DM + 128 * s + 16 * c8);
    u32x4 bil = bcast4<0x18>(il), bih = bcast4<0x18>(ih), hb = bcast4<0x07>(hw);
    for (int tt = 0; tt < nt; ++tt) {
        const size_t t = (size_t)t0 + tt;
        int id[16]; unpack_ids(bil, bih, id);
        u32x4 rows[16];
#pragma unroll
        for (int i = 0; i < 16; ++i) rows[i] = *(const u32x4*)(ub + ((unsigned)id[i] * 128u + lo));
        const u32x4 hcur = hb;
        if (tt + 1 < nt) {
            if (ldi) { il = *(const u32x4*)(idx + (t + 1) * 128 + 16 * g); ih = *(const u32x4*)(idx + (t + 1) * 128 + 16 * g + 8); }
            if (ldh) hw = *(const u32x4*)(h8 + (t + 1) * DM + 128 * s + 16 * c8);
        }
        int p[16];
#pragma unroll
        for (int i = 0; i < 16; ++i) { int acc = __builtin_amdgcn_sdot4((int)rows[i][0], (int)hcur[0], 0, false); acc = __builtin_amdgcn_sdot4((int)rows[i][1], (int)hcur[1], acc, false);
            acc = __builtin_amdgcn_sdot4((int)rows[i][2], (int)hcur[2], acc, false); acc = __builtin_amdgcn_sdot4((int)rows[i][3], (int)hcur[3], acc, false); p[i] = acc; }
        int oi0, oi1; reduce16i<4, 2, 1>(p, lane, oi0, oi1);
        const f32x2 o = (f32x2){(float)oi0, (float)oi1};
        bil = bcast4<0x18>(il); bih = bcast4<0x18>(ih); hb = bcast4<0x07>(hw);
        asm volatile("" : "+v"(bil), "+v"(bih), "+v"(hb));
        *(unsigned*)(aP + (t * 16 + s) * 128 + 2 * lane) = pk2(o[0], o[1]);
    }
}
DEVI void rowA2(const bf16_t* aP, const unsigned short* idx, const float* gw, const float* usc, const float* vsc, const float* ssqh, const float* hsc_inv, signed char* W, float* wsc, size_t t, int lane) {
    const float r2 = hsc_inv[t] / sqrtf(ssqh[t] * (1.f / DM) + EPS);
    f32x2 a = (f32x2){0.f, 0.f};
#pragma unroll
    for (int s = 0; s < 16; ++s) { const unsigned w2 = *(const unsigned*)(aP + (t * 16 + s) * 128 + 2 * lane); a += (f32x2){__uint_as_float(w2 << 16), __uint_as_float(w2 & 0xffff0000u)}; }
    const unsigned ii = *(const unsigned*)(idx + t * 128 + 2 * lane);
    const int i0 = (int)(ii & 0xffffu), i1 = (int)(ii >> 16);
    const f32x2 g = *(const f32x2*)(gw + t * 128 + 2 * lane);
    const float w0 = g[0] * vsc[i0] * gelu_tanh(a[0] * usc[i0] * r2), w1 = g[1] * vsc[i1] * gelu_tanh(a[1] * usc[i1] * r2);
    float am = fmaxf(fabsf(w0), fabsf(w1));
#pragma unroll
    for (int o = 1; o < 64; o <<= 1) am = fmaxf(am, __shfl_xor(am, o));
    const float sc = am > 0.f ? 127.f / am : 0.f;
    const int q0 = __float2int_rn(w0 * sc), q1 = __float2int_rn(w1 * sc);
    *(unsigned short*)(W + t * 128 + 2 * lane) = (unsigned short)((q0 & 255) | ((q1 & 255) << 8));
    if (lane == 0) wsc[t] = am * (1.f / 127.f);
}
DEVI unsigned bperm(unsigned hi, unsigned lo, unsigned sel) { return __builtin_amdgcn_perm(hi, lo, sel); }
DEVI void sliceB(const unsigned char* V8, const unsigned short* idx, const signed char* W, const float* wsc, const bf16_t* hb, float* out, int s, int t0, int nt, int lane) {
    const int g = lane >> 3, c8 = lane & 7;
    const unsigned char* vb = V8 + (size_t)s * 16384 * 128; const unsigned lo = 16u * (unsigned)c8;
    const bool ldi = (c8 == 0);
    u32x4 il = (u32x4){0u, 0u, 0u, 0u}, ih = il, wq = il;
    if (ldi) { il = *(const u32x4*)(idx + (size_t)t0 * 128 + 16 * g); ih = *(const u32x4*)(idx + (size_t)t0 * 128 + 16 * g + 8); wq = *(const u32x4*)(W + (size_t)t0 * 128 + 16 * g); }
    u32x4 bil = bcast4<0x18>(il), bih = bcast4<0x18>(ih), wb = bcast4<0x18>(wq);
    unsigned hw2 = *(const unsigned*)(hb + (size_t)t0 * DM + 128 * s + 16 * c8 + 2 * g);
    float ws = wsc[t0];
    for (int tt = 0; tt < nt; ++tt) {
        const size_t t = (size_t)t0 + tt;
        int id[16]; unpack_ids(bil, bih, id);
        u32x4 rows[16];
#pragma unroll
        for (int i = 0; i < 16; ++i) rows[i] = *(const u32x4*)(vb + ((unsigned)id[i] * 128u + lo));
        float* op = out + t * DM + 128 * s + 16 * c8 + 2 * g;
        const f32x2 hcur = (f32x2){__uint_as_float(hw2 << 16), __uint_as_float(hw2 & 0xffff0000u)};
        const u32x4 wcur = wb; const float wscur = ws;
        if (tt + 1 < nt) {
            if (ldi) { il = *(const u32x4*)(idx + (t + 1) * 128 + 16 * g); ih = *(const u32x4*)(idx + (t + 1) * 128 + 16 * g + 8); wq = *(const u32x4*)(W + (t + 1) * 128 + 16 * g); }
            hw2 = *(const unsigned*)(hb + (t + 1) * DM + 128 * s + 16 * c8 + 2 * g);
            ws = wsc[t + 1];
        }
        int acc[16];
#pragma unroll
        for (int c = 0; c < 16; ++c) acc[c] = 0;
#pragma unroll
        for (int q = 0; q < 4; ++q)
#pragma unroll
            for (int j = 0; j < 4; ++j) {
                const unsigned d0 = rows[4 * q][j], d1 = rows[4 * q + 1][j], d2 = rows[4 * q + 2][j], d3 = rows[4 * q + 3][j];
                const unsigned p01l = bperm(d1, d0, 0x05010400u), p01h = bperm(d1, d0, 0x07030602u);
                const unsigned p23l = bperm(d3, d2, 0x05010400u), p23h = bperm(d3, d2, 0x07030602u);
                const unsigned t0_ = bperm(p23l, p01l, 0x05040100u), t1_ = bperm(p23l, p01l, 0x07060302u);
                const unsigned t2_ = bperm(p23h, p01h, 0x05040100u), t3_ = bperm(p23h, p01h, 0x07060302u);
                acc[4 * j + 0] = __builtin_amdgcn_sdot4((int)t0_, (int)wcur[q], acc[4 * j + 0], false);
                acc[4 * j + 1] = __builtin_amdgcn_sdot4((int)t1_, (int)wcur[q], acc[4 * j + 1], false);
                acc[4 * j + 2] = __builtin_amdgcn_sdot4((int)t2_, (int)wcur[q], acc[4 * j + 2], false);
                acc[4 * j + 3] = __builtin_amdgcn_sdot4((int)t3_, (int)wcur[q], acc[4 * j + 3], false);
            }
        int oi0, oi1; reduce16i<32, 16, 8>(acc, lane, oi0, oi1);
        const f32x2 o = (f32x2){(float)oi0, (float)oi1};
        bil = bcast4<0x18>(il); bih = bcast4<0x18>(ih); wb = bcast4<0x18>(wq);
        asm volatile("" : "+v"(bil), "+v"(bih), "+v"(wb), "+v"(hw2), "+v"(ws));
        *(f32x2*)op = hcur + o * wscur;
    }
}
}


namespace topk {
struct CandTab { int a[50], b[50]; };
constexpr CandTab make_tab() { CandTab t{}; int n = 0; for (int a = 0; a < 16; ++a) for (int b = 0; b < 16; ++b) if ((a + 1) * (b + 1) <= 16) { t.a[n] = a; t.b[n] = b; ++n; } return t; }
constexpr CandTab CT = make_tab();
DEVI void ins16(float (&L)[16], float x) {
#pragma unroll
    for (int k = 0; k < 16; ++k) { const float hi = fmaxf(L[k], x); x = fminf(L[k], x); L[k] = hi; }
}
DEVI void merge_partner(float (&L)[16]) {
    float M[16];
#pragma unroll
    for (int k = 0; k < 16; ++k) M[k] = __shfl_xor(L[k], 32);
#pragma unroll
    for (int k = 0; k < 16; ++k) L[k] = fmaxf(L[k], M[15 - k]);
#pragma unroll
    for (int st = 8; st >= 1; st >>= 1)
#pragma unroll
        for (int i = 0; i < 16; ++i) if ((i & st) == 0) { const float a = L[i], b = L[i + st]; L[i] = fmaxf(a, b); L[i + st] = fminf(a, b); }
}
DEVI void stage_keys(LAS unsigned char* lds, const bf16_t* subk, int h, int tid) {
#pragma unroll
    for (int i = 0; i < 8; ++i) {
        const int c = tid + 512 * i, p = c >> 11, rem = c & 2047, row = rem >> 4, ch = rem & 15, kb = ch >> 2, cq = ch & 3;
        const u32x4 v = *(const u32x4*)(subk + ((size_t)(h * 2 + p) * 128 + row) * 128 + ch * 8);
        *(LAS u32x4*)(lds + p * 32768 + kb * 8192 + row * 64 + ((cq ^ ((row >> 2) & 3)) * 16)) = v;
    }
}
DEVI void unit(LAS unsigned char* lds, const bf16_t* qp, unsigned short* idx, float* gw, int tt, int h) {
    const int tid = threadIdx.x, lane = tid & 63, w = __builtin_amdgcn_readfirstlane(tid >> 6), r32 = lane & 31, hh = lane >> 5;
    const size_t tok = (size_t)tt * 256 + 32 * w + r32;
    const int ksw = (r32 >> 2) & 3;
    float T0[16], T1[16];
#pragma unroll
    for (int p = 0; p < 2; ++p) {
        bf16x8 qf[8];
        const bf16_t* qfrag = qp + ((((size_t)tt * 8 + w) * 8 + h) * 2 + p) * 4096 + hh * 256 + r32 * 8;
#pragma unroll
        for (int ks = 0; ks < 8; ++ks) qf[ks] = *(const bf16x8*)(qfrag + ks * 512);
        f32x16 acc[4];
#pragma unroll
        for (int kt = 0; kt < 4; ++kt)
#pragma unroll
            for (int r = 0; r < 16; ++r) acc[kt][r] = 0.f;
        LAS const unsigned char* kbase = lds + p * 32768 + r32 * 64;
#pragma unroll
        for (int ks = 0; ks < 8; ++ks) {
            const int off = (ks >> 1) * 8192 + (((2 * (ks & 1) + hh) ^ ksw) * 16);
#pragma unroll
            for (int kt = 0; kt < 4; ++kt) { const bf16x8 kf = *(LAS const bf16x8*)(kbase + off + kt * 2048); acc[kt] = __builtin_amdgcn_mfma_f32_32x32x16_bf16(kf, qf[ks], acc[kt], 0, 0, 0); }
        }
        float L[16];
#pragma unroll
        for (int k = 0; k < 16; ++k) L[k] = -INFINITY;
#pragma unroll
        for (int kt = 0; kt < 4; ++kt)
#pragma unroll
            for (int r = 0; r < 16; ++r) { const unsigned key = (unsigned)(32 * kt + (r & 3) + 8 * (r >> 2) + 4 * hh); ins16(L, __uint_as_float((__float_as_uint(acc[kt][r]) & ~127u) | key)); }
        merge_partner(L);
#pragma unroll
        for (int k = 0; k < 16; ++k) { if (p == 0) T0[k] = L[k]; else T1[k] = L[k]; }
    }
    LAS unsigned* tl = (LAS unsigned*)(lds + 65536) + w * 2048 + lane;
#pragma unroll
    for (int k = 0; k < 16; ++k) { tl[k * 64] = __float_as_uint(T0[k]); tl[(16 + k) * 64] = __float_as_uint(T1[k]); }
    float C[16];
#pragma unroll
    for (int k = 0; k < 16; ++k) C[k] = -INFINITY;
#pragma unroll
    for (int i = 0; i < 25; ++i) {
        const float v0 = T0[CT.a[2 * i]] + T1[CT.b[2 * i]], v1 = T0[CT.a[2 * i + 1]] + T1[CT.b[2 * i + 1]];
        const unsigned c0 = (unsigned)(CT.a[2 * i] * 16 + CT.b[2 * i]), c1 = (unsigned)(CT.a[2 * i + 1] * 16 + CT.b[2 * i + 1]);
        const unsigned bits = (__float_as_uint(hh ? v1 : v0) & ~255u) | (hh ? c1 : c0);
        ins16(C, __uint_as_float(bits));
    }
    merge_partner(C);
    const float mx = C[0];
    float sum = 0.f;
#pragma unroll
    for (int k = 0; k < 16; ++k) sum += __expf(C[k] - mx);
    const float inv = 1.f / sum;
    unsigned short io8[8]; f32x4 go4[2];
#pragma unroll
    for (int k = 0; k < 8; ++k) {
        float clo = C[k], chi = C[8 + k]; asm volatile("" : "+v"(clo), "+v"(chi));
        const float cv = hh ? chi : clo;
        const unsigned cb = __float_as_uint(cv), ai = (cb >> 4) & 15u, bi = cb & 15u;
        const unsigned i1 = tl[ai * 64] & 127u, i2 = tl[(16 + bi) * 64] & 127u;
        io8[k] = (unsigned short)((i1 << 7) | i2); go4[k >> 2][k & 3] = __expf(cv - mx) * inv;
    }
    asm volatile("s_waitcnt lgkmcnt(0)" ::: "memory");
    unsigned short* io = idx + tok * 128 + h * 16 + 8 * hh; float* go = gw + tok * 128 + h * 16 + 8 * hh;
    { u32x4 pw; pw.x = io8[0] | ((unsigned)io8[1] << 16); pw.y = io8[2] | ((unsigned)io8[3] << 16); pw.z = io8[4] | ((unsigned)io8[5] << 16); pw.w = io8[6] | ((unsigned)io8[7] << 16); *(u32x4*)io = pw; }
    *(f32x4*)go = go4[0]; *(f32x4*)(go + 4) = go4[1];
}
DEVI void phase(LAS unsigned char* lds, const bf16_t* qp, const bf16_t* subk, unsigned short* idx, float* gw, int vcu, int G) {
    int last_h = -1;
    for (int u = vcu; u < 512; u += G) {
        const int h = u & 7, tt = u >> 3;
        if (h != last_h) {
            asm volatile("s_waitcnt lgkmcnt(0)" ::: "memory"); __builtin_amdgcn_s_barrier(); asm volatile("" ::: "memory");
            stage_keys(lds, subk, h, threadIdx.x); last_h = h;
            asm volatile("s_waitcnt vmcnt(0) lgkmcnt(0)" ::: "memory"); __builtin_amdgcn_s_barrier(); asm volatile("" ::: "memory");
        }
        unit(lds, qp, idx, gw, tt, h);
    }
}
}


namespace swa {
constexpr int KOFF = 0, VOFF = 32768, POFF = 65536, LOFF = 66560, WOFF = 70784;
DEVI s16x4 vtr(LAS const unsigned char* p) { return __builtin_bit_cast(s16x4, __builtin_amdgcn_ds_read_tr16_b64_v4i16((LAS s16x4*)p)); }
DEVI void unit(LAS unsigned char* lds, const bf16_t* proj, const int* pos, const float* sinks, const float* rel, const float* sqg, const float* skg, bf16_t* O, int b, int kvh, int nb) {
    const int tid = threadIdx.x, lane = tid & 63, w = __builtin_amdgcn_readfirstlane(tid >> 6), r32 = lane & 31, hh = lane >> 5;
    const int head = kvh * 8 + w;
    const int tk0 = nb * 128 - 128;
    const size_t rowbase = (size_t)b * SEQ;
    asm volatile("s_waitcnt lgkmcnt(0)" ::: "memory"); __builtin_amdgcn_s_barrier(); asm volatile("" ::: "memory");
#pragma unroll
    for (int i = 0; i < 8; ++i) {
        const int c = tid + 512 * i, isV = c >> 11, rem = c & 2047, row = rem >> 3, ch = rem & 7, kb = ch >> 2, cq = ch & 3;
        const int tk = tk0 + row;
        u32x4 v = (u32x4){0u, 0u, 0u, 0u};
        if (tk >= 0) v = *(const u32x4*)(proj + (rowbase + tk) * PROJ_LD + (isV ? C_SV : C_SK) + kvh * 64 + ch * 8);
        if (i < 4) {
            float f[8]; unpack8(v, f); float ss = 0.f;
#pragma unroll
            for (int e = 0; e < 8; ++e) ss += f[e] * f[e];
            ss += __shfl_xor(ss, 1); ss += __shfl_xor(ss, 2); ss += __shfl_xor(ss, 4);
            const float r = 1.f / sqrtf(ss * (1.f / 64.f) + EPS);
            const f32x4 g0 = *(const f32x4*)(skg + ch * 8), g1 = *(const f32x4*)(skg + ch * 8 + 4);
            f[0] *= r * g0[0]; f[1] *= r * g0[1]; f[2] *= r * g0[2]; f[3] *= r * g0[3]; f[4] *= r * g1[0]; f[5] *= r * g1[1]; f[6] *= r * g1[2]; f[7] *= r * g1[3];
            v = pack8(f);
        }
        const int dst = isV ? (VOFF + kb * 16384 + row * 64 + cq * 16) : (KOFF + kb * 16384 + row * 64 + ((cq ^ ((row >> 2) & 3)) * 16));
        *(LAS u32x4*)(lds + dst) = v;
    }
    LAS int* posk = (LAS int*)(lds + POFF);
    if (tid < 256) posk[tid] = (tk0 + tid >= 0) ? pos[rowbase + tk0 + tid] : 0;
    LAS float* lut = (LAS float*)(lds + LOFF) + w * 132;
    for (int d = lane; d <= 128; d += 64) lut[d] = rel[t5_bucket(d) * 16 + head];
    asm volatile("s_waitcnt vmcnt(0) lgkmcnt(0)" ::: "memory"); __builtin_amdgcn_s_barrier(); asm volatile("" ::: "memory");
    const float sink = sinks[head];
    LAS float* wsf = (LAS float*)(lds + WOFF) + w * 32;
    const int ksw = (r32 >> 2) & 3;
    const int vlane = VOFF + ((lane >> 4) & 1) * 32 + (lane & 3) * 8 + (4 * hh + ((lane & 15) >> 2)) * 64;
#pragma unroll 1
    for (int qs = 0; qs < 4; ++qs) {
        const size_t t = rowbase + nb * 128 + 32 * qs + r32;
        const bf16_t* qrow = proj + t * PROJ_LD + C_SQ + head * 64 + 8 * hh;
        bf16x8 qf[4];
        {
            float qv[4][8]; float ss = 0.f;
#pragma unroll
            for (int ks = 0; ks < 4; ++ks) { unpack8(*(const u32x4*)(qrow + 16 * ks), qv[ks]);
#pragma unroll
                for (int e = 0; e < 8; ++e) ss += qv[ks][e] * qv[ks][e]; }
            ss += __shfl_xor(ss, 32);
            const float r = 0.125f / sqrtf(ss * (1.f / 64.f) + EPS);
#pragma unroll
            for (int ks = 0; ks < 4; ++ks) { const f32x4 g0 = *(const f32x4*)(sqg + 16 * ks + 8 * hh), g1 = *(const f32x4*)(sqg + 16 * ks + 8 * hh + 4);
                qv[ks][0] *= r * g0[0]; qv[ks][1] *= r * g0[1]; qv[ks][2] *= r * g0[2]; qv[ks][3] *= r * g0[3]; qv[ks][4] *= r * g1[0]; qv[ks][5] *= r * g1[1]; qv[ks][6] *= r * g1[2]; qv[ks][7] *= r * g1[3];
                qf[ks] = __builtin_bit_cast(bf16x8, pack8(qv[ks])); }
        }
        const int pq = pos[t];
        f32x16 S[5];
#pragma unroll
        for (int kk = 0; kk < 5; ++kk)
#pragma unroll
            for (int r = 0; r < 16; ++r) S[kk][r] = 0.f;
#pragma unroll
        for (int ks = 0; ks < 4; ++ks) {
            const int off = KOFF + (ks >> 1) * 16384 + (32 * qs + r32) * 64 + (((2 * (ks & 1) + hh) ^ ksw) * 16);
#pragma unroll
            for (int kk = 0; kk < 5; ++kk) { const bf16x8 kf = *(LAS const bf16x8*)(lds + off + kk * 2048); S[kk] = __builtin_amdgcn_mfma_f32_32x32x16_bf16(kf, qf[ks], S[kk], 0, 0, 0); }
        }
        float m = sink;
#pragma unroll
        for (int kk = 0; kk < 5; ++kk)
#pragma unroll
            for (int g = 0; g < 4; ++g) {
                const int jb = 32 * (qs + kk) + 8 * g + 4 * hh;
                const i32x4 pk = *(LAS const i32x4*)(posk + jb);
                const int pkv[4] = {pk[0], pk[1], pk[2], pk[3]};
#pragma unroll
                for (int e = 0; e < 4; ++e) {
                    const int dj = 32 * kk + 8 * g + 4 * hh + e - r32;
                    int d = pq - pkv[e]; d = d < 0 ? 0 : (d > 128 ? 128 : d);
                    const float sv = S[kk][4 * g + e] + lut[d];
                    const bool valid = (dj >= 1) && (dj <= 128) && (tk0 + jb + e >= 0);
                    const float sm = valid ? sv : -INFINITY;
                    S[kk][4 * g + e] = sm; m = fmaxf(m, sm);
                }
            }
        m = fmaxf(m, __shfl_xor(m, 32));
        float ps = 0.f;
#pragma unroll
        for (int kk = 0; kk < 5; ++kk)
#pragma unroll
            for (int r = 0; r < 16; ++r) { const float p = __expf(S[kk][r] - m); S[kk][r] = p; ps += p; }
        ps += __shfl_xor(ps, 32);
        ps += __expf(sink - m);
        f32x16 o[2];
#pragma unroll
        for (int d = 0; d < 2; ++d)
#pragma unroll
            for (int r = 0; r < 16; ++r) o[d][r] = 0.f;
#pragma unroll
        for (int kk = 0; kk < 5; ++kk)
#pragma unroll
            for (int s2 = 0; s2 < 2; ++s2) {
                u32x4 wv; wv.x = pk2(S[kk][8 * s2 + 0], S[kk][8 * s2 + 1]); wv.y = pk2(S[kk][8 * s2 + 2], S[kk][8 * s2 + 3]); wv.z = pk2(S[kk][8 * s2 + 4], S[kk][8 * s2 + 5]); wv.w = pk2(S[kk][8 * s2 + 6], S[kk][8 * s2 + 7]);
                const bf16x8 pf = __builtin_bit_cast(bf16x8, wv);
                LAS const unsigned char* vb = lds + vlane + (32 * (qs + kk) + 16 * s2) * 64;
#pragma unroll
                for (int d = 0; d < 2; ++d) {
                    const s16x4 lo = vtr(vb + d * 16384), hi = vtr(vb + d * 16384 + 512);
                    const bf16x8 vf = (bf16x8){lo[0], lo[1], lo[2], lo[3], hi[0], hi[1], hi[2], hi[3]};
                    o[d] = __builtin_amdgcn_mfma_f32_32x32x16_bf16(pf, vf, o[d], 0, 0, 0);
                }
            }
        if (hh == 0) wsf[r32] = 1.f / ps;
        asm volatile("s_waitcnt lgkmcnt(0)" ::: "memory");
        bf16_t* orow = O + (rowbase + nb * 128 + 32 * qs) * DM + 1024 + head * 64 + r32;
#pragma unroll
        for (int g = 0; g < 4; ++g) { const f32x4 c4 = *(LAS const f32x4*)(wsf + 8 * g + 4 * hh);
#pragma unroll
            for (int e = 0; e < 4; ++e) { const int qr = 8 * g + 4 * hh + e;
#pragma unroll
                for (int d = 0; d < 2; ++d) orow[(size_t)qr * DM + 32 * d] = (bf16_t)f2bf(o[d][4 * g + e] * c4[e]); } }
        asm volatile("s_waitcnt lgkmcnt(0)" ::: "memory");
    }
}
DEVI void phase(LAS unsigned char* lds, const bf16_t* proj, const int* pos, const float* sinks, const float* rel, const float* sqg, const float* skg, bf16_t* O, int vcu, int G) {
    for (int u = vcu; u < 256; u += G) { const int nb = u & 31, bk = u >> 5; unit(lds, proj, pos, sinks, rel, sqg, skg, O, bk >> 1, bk & 1, nb); }
    asm volatile("s_waitcnt lgkmcnt(0)" ::: "memory"); __builtin_amdgcn_s_barrier(); asm volatile("" ::: "memory");
}
}

constexpr int N_PHASES = 14;
struct Args { const void* in[21]; float* out; unsigned char* ws; int ph_lo, ph_hi; };

__global__ void __launch_bounds__(NTHREADS, 2) __attribute__((amdgpu_waves_per_eu(2, 2))) mega_fwd(Args a) {
    extern __shared__ __attribute__((aligned(16))) unsigned char lds_raw[];
    LAS unsigned char* lds = (LAS unsigned char*)lds_raw;
    volatile LAS unsigned* MISC = (volatile LAS unsigned*)(lds + MISC_OFF);
    const int tid = threadIdx.x, lane = tid & 63, wave = __builtin_amdgcn_readfirstlane(tid >> 6);
    const int G = gridDim.x, bx = blockIdx.x;
    const int vcu = (G % 8 == 0) ? (bx % 8) * (G / 8) + bx / 8 : bx;
    const int gw = vcu * NWAVES + wave, NGW = G * NWAVES;

    const float* x = (const float*)a.in[0]; const int* pos = (const int*)a.in[1];
    const float* g1 = (const float*)a.in[2]; const float* w_in = (const float*)a.in[3]; const float* qag = (const float*)a.in[4]; const float* wqb = (const float*)a.in[5];
    const float* kvag = (const float*)a.in[6]; const float* wkvb = (const float*)a.in[7]; const float* mqg = (const float*)a.in[8]; const float* mkg = (const float*)a.in[9];
    const float* sqg = (const float*)a.in[10]; const float* skg = (const float*)a.in[11]; const float* sinks = (const float*)a.in[12]; const float* rel = (const float*)a.in[13];
    const float* gog = (const float*)a.in[14]; const float* wout = (const float*)a.in[15]; const float* g2 = (const float*)a.in[16]; const float* wpq = (const float*)a.in[17];
    const float* subk = (const float*)a.in[18]; const float* pu = (const float*)a.in[19]; const float* pv = (const float*)a.in[20];
    float* out = a.out; unsigned char* ws = a.ws;
    bf16_t* W1T = (bf16_t*)(ws + WS_W1T); bf16_t* WQB = (bf16_t*)(ws + WS_WQB); bf16_t* WKVB = (bf16_t*)(ws + WS_WKVB); bf16_t* WOUT = (bf16_t*)(ws + WS_WOUT);
    bf16_t* WPQ = (bf16_t*)(ws + WS_WPQ); bf16_t* SUBK = (bf16_t*)(ws + WS_SUBK); bf16_t* UB = (bf16_t*)(ws + WS_UB); bf16_t* VB = (bf16_t*)(ws + WS_VB);
    bf16_t* PROJ = (bf16_t*)(ws + WS_PROJ); bf16_t* KV = (bf16_t*)(ws + WS_KV); bf16_t* Q = (bf16_t*)(ws + WS_Q); bf16_t* K = (bf16_t*)(ws + WS_K); bf16_t* ACT = (bf16_t*)(ws + WS_ACT);
    bf16_t* QP = PROJ; unsigned short* IDX = (unsigned short*)(ws + WS_Q); float* GWT = (float*)(ws + WS_Q + 8 * MiB); signed char* WEX = (signed char*)(ws + WS_Q + 16 * MiB); float* WSC = (float*)(ws + WS_CTL + 512 * 1024); bf16_t* AP = (bf16_t*)(ws + WS_PROJ);
    float* LATP = (float*)(ws + WS_CTL + 1024 * 1024);
    bf16_t* HB = (bf16_t*)(ws + WS_Q + 24 * MiB); float* SSQH = (float*)(ws + WS_CTL + 64 * 1024);
    signed char* HB8 = (signed char*)(ws + WS_ACT); float* HSC = (float*)(ws + WS_CTL + 448 * 1024);
    signed char* W1T8 = (signed char*)(ws + WS_W1T); signed char* WOUT8 = (signed char*)(ws + WS_WOUT); signed char* A8 = (signed char*)(ws + WS_ACT);
    float* CM_IN = (float*)(ws + WS_CTL + 20 * 1024); float* CM_OUT = (float*)(ws + WS_CTL + 32 * 1024);
    float* SA1 = (float*)(ws + WS_CTL + 128 * 1024); float* SA7 = (float*)(ws + WS_CTL + 192 * 1024);
    unsigned char* U8 = ws + WS_UB; unsigned char* V8 = ws + WS_VB; float* USC = (float*)(ws + WS_CTL + 256 * 1024); float* VSC = (float*)(ws + WS_CTL + 384 * 1024);

    for (int u = tid; u < (LDS_BYTES - RING_BYTES) / 4; u += NTHREADS) ((LAS unsigned*)(lds + RING_BYTES))[u] = 0u;
    __syncthreads();
    XcdBarrier bar = xcd_barrier_post((unsigned*)(ws + WS_CTL) + 1024, MISC + 8);
    const int lo = a.ph_lo, hi = a.ph_hi;
#define IN(k) (lo <= (k) && (k) < hi)
#define SEAM(k) do { if (IN(k) && IN((k) + 1)) xcd_barrier(bar); } while (0)

    if (IN(0)) {
        LAS float* scr = (LAS float*)(lds + wave * 16384);
        constexpr int C1 = 64 * 9, C4 = 64 * 8, I2 = 8 * 48, I3 = 4 * 64, I5 = 32 * 64;
        for (int it = gw; it < C1 + C4 + I2 + I3 + I5; it += NGW) {
            int r = it;
            if (r < C1) { colmax_item(w_in, nullptr, CM_IN, 2112, 1, r, lane); continue; } r -= C1;
            if (r < C4) { colmax_item(wout, gog, CM_OUT, 2048, 0, r, lane); continue; } r -= C4;
            if (r < I2) { transpose_item(wqb, WQB, qag, 512, 1536, 0, r, scr, lane); continue; } r -= I2;
            if (r < I3) { transpose_item(wkvb, WKVB, kvag, 256, 2048, 2, r, scr, lane); continue; } r -= I3;
            transpose_item(wpq, WPQ, g2, 2048, 2048, 0, r, scr, lane);
        }
        const size_t gtid = (size_t)vcu * NTHREADS + tid, nthr = (size_t)G * NTHREADS;
        for (size_t i = gtid; i < (size_t)192 * 2048 / 4; i += nthr) ((unsigned*)(W1T8 + (size_t)2112 * 2048))[i] = 0u;
        convert_range(subk, SUBK, (size_t)8 * 2 * 128 * 128 / 8, nullptr, 128, gtid, nthr);
        { f32x4 cur[8], nxt[8];
          if (gw < T) {
#pragma unroll
              for (int j = 0; j < 8; ++j) cur[j] = *(const f32x4*)(x + (size_t)gw * DM + 4 * (lane + 64 * j));
          }
          for (int t = gw; t < T; t += NGW) {
              const bool more = t + NGW < T;
              if (more) {
#pragma unroll
                  for (int j = 0; j < 8; ++j) nxt[j] = *(const f32x4*)(x + (size_t)(t + NGW) * DM + 4 * (lane + 64 * j));
              }
              norm1_regs_q(cur, g1, A8 + (size_t)t * DM, SA1 + t, lane);
              if (more) {
#pragma unroll
                  for (int j = 0; j < 8; ++j) cur[j] = nxt[j];
              }
          } }
    }
    SEAM(0);
    if (IN(1)) {
        LAS float* scr = (LAS float*)(lds + wave * 16384);
        constexpr int I1 = 32 * 66, I4 = 32 * 64;
        for (int it = gw; it < I1 + I4; it += NGW) {
            if (it < I1) transpose_item_q(w_in, W1T8, nullptr, CM_IN, 2048, 2112, 1, it, scr, lane);
            else transpose_item_q(wout, WOUT8, gog, CM_OUT, 2048, 2048, 0, it - I1, scr, lane);
        }
    }
    SEAM(1);
    if (IN(2)) {
        pg8::Gemm g{(const bf16_t*)A8, (const bf16_t*)W1T8, T, PROJ_LD, DM / 2, DM / 2, DM / 2}; pg8::StaticOrder S; S.init(T, PROJ_LD, G, bx);
        pg8::EpiBf16<true> E{PROJ, PROJ_LD, nullptr, 0.f, nullptr, 0, 0, LATP, 3, SA1, CM_IN};
        pg8::gemm_phase<pg8::EpiBf16<true>, pg8::StaticOrder, true, true>(lds, g, S, E);
        { const int nfull = (T / 256) * (PROJ_LD / 256) % G;
          const int nconv = G - nfull;
          if (nfull == 0 || nconv <= 0) { peer::convert_rows<true>(pu, g2, U8, USC, gw, NGW, 16384, lane); peer::convert_rows<false>(pv, nullptr, V8, VSC, gw, NGW, 16384, lane); }
          else if (bx >= nfull) { const int cw = (bx - nfull) * NWAVES + wave, cs = nconv * NWAVES;
              peer::convert_rows<true>(pu, g2, U8, USC, cw, cs, 16384, lane); peer::convert_rows<false>(pv, nullptr, V8, VSC, cw, cs, 16384, lane); } }
    }
    SEAM(2);
    if (IN(3)) {
        { pg8::Gemm g{PROJ + C_QLAT, WQB, T, 1536, 512, PROJ_LD, 512}; pg8::StaticOrder S; S.init(T, 1536, G, bx);
          pg8::EpiBf16<false> E{ACT, QK_LD, nullptr, 1.f / 512.f, LATP, 0, 8, nullptr, 0, nullptr, nullptr};
          pg8::gemm_phase<pg8::EpiBf16<false>, pg8::StaticOrder, true>(lds, g, S, E); }
        { pg8::Gemm g{PROJ + C_KVLAT, WKVB, T, 2048, 256, PROJ_LD, 256}; pg8::StaticOrder S; S.init(T, 2048, G, bx);
          pg8::EpiBf16<false> E{KV, KV_LD, nullptr, 1.f / 256.f, LATP, 8, 4, nullptr, 0, nullptr, nullptr};
          pg8::gemm_phase<pg8::EpiBf16<false>, pg8::StaticOrder, true>(lds, g, S, E); }
    }
    SEAM(3);
    if (IN(4)) {
        for (int t = gw; t < T; t += NGW)
            p3_row(ACT + (size_t)t * QK_LD, KV + (size_t)t * KV_LD, PROJ + (size_t)t * PROJ_LD + C_KPE, pos[t], mqg, mkg, Q + (size_t)t * QK_LD, K + (size_t)t * QK_LD, lane);
    }
    SEAM(4);
    if (IN(5)) {
        mla::phase(lds, Q, K, KV, ACT, vcu, G);
        swa::phase(lds, PROJ, pos, sinks, rel, sqg, skg, ACT, vcu, G);
    }
    SEAM(5);
    if (IN(6)) { for (int t = gw; t < T; t += NGW) p4_row_q(ACT + (size_t)t * DM, SA7 + t, lane); }
    SEAM(6);
    if (IN(7)) {
        pg8::Gemm g{ACT, (const bf16_t*)WOUT8, T, DM, DM / 2, DM, DM / 2}; pg8::StaticOrder S; S.init(T, DM, G, bx);
        pg8::EpiResid<true> E{x, out, HB, SSQH, DM, SA7, CM_OUT};
        pg8::gemm_phase<pg8::EpiResid<true>, pg8::StaticOrder, true, true>(lds, g, S, E);
    }
    SEAM(7);
    if (IN(9)) {
        pg8::Gemm g{HB, WPQ, T, DM, DM, DM, DM}; pg8::StaticOrder S; S.init(T, DM, G, bx);
        pg8::EpiQp E{QP, SSQH, 1.f / DM};
        pg8::gemm_phase<pg8::EpiQp, pg8::StaticOrder, true>(lds, g, S, E);
    }
    SEAM(9);
    if (IN(10)) {
        for (int t = gw; t < T; t += NGW) peer::h_to_int8(HB + (size_t)t * DM, SSQH[t], HB8 + (size_t)t * DM, HSC + t, lane);
        topk::phase(lds, QP, SUBK, IDX, GWT, vcu, G);
    }
    SEAM(10);
    if (IN(11)) {
        for (int vb = bx; vb < 256; vb += G) { const int grp = vb & 7, rank = vb >> 3, t0 = rank * 512 + wave * 64;
            peer::sliceA(HB8, U8, IDX, AP, grp, t0, 64, lane); peer::sliceA(HB8, U8, IDX, AP, grp + 8, t0, 64, lane); }
    }
    SEAM(11);
    if (IN(12)) { for (int t = gw; t < T; t += NGW) peer::rowA2(AP, IDX, GWT, USC, VSC, SSQH, HSC, WEX, WSC, (size_t)t, lane); }
    SEAM(12);
    if (IN(13)) {
        for (int vb = bx; vb < 256; vb += G) { const int grp = vb & 7, rank = vb >> 3, t0 = rank * 512 + wave * 64;
            peer::sliceB(V8, IDX, WEX, WSC, HB, out, grp, t0, 64, lane); peer::sliceB(V8, IDX, WEX, WSC, HB, out, grp + 8, t0, 64, lane); }
    }
#undef IN
#undef SEAM
}

#ifndef MK_N_LAUNCHES
#define MK_N_LAUNCHES 1
#endif
extern "C" void kernel_launch(void* const* d_in, const int* in_sizes, int n_in, void* d_out, int out_size, void* d_ws, size_t ws_size, hipStream_t stream) {
    static int grid = 0;
    if (grid == 0) {
        if (n_in != 21 || ws_size < WS_END || out_size != T * DM) { fprintf(stderr, "kernel_launch: unexpected problem (n_in %d, ws %zu, out %d)\n", n_in, ws_size, out_size); grid = -1; return; }
        int dev = 0, cus = 0;
        if (hipGetDevice(&dev) != hipSuccess || hipDeviceGetAttribute(&cus, hipDeviceAttributeMultiprocessorCount, dev) != hipSuccess) { grid = -1; return; }
        if (hipFuncSetAttribute((const void*)mega_fwd, hipFuncAttributeMaxDynamicSharedMemorySize, LDS_BYTES) != hipSuccess) { fprintf(stderr, "kernel_launch: hipFuncSetAttribute failed\n"); grid = -1; return; }
        int per_cu = 0;
        if (hipOccupancyMaxActiveBlocksPerMultiprocessor(&per_cu, (const void*)mega_fwd, NTHREADS, LDS_BYTES) != hipSuccess || per_cu < 1) { fprintf(stderr, "kernel_launch: occupancy query says %d\n", per_cu); }
        (void)hipGetLastError();
        grid = cus;
    }
    if (grid < 0) return;
    (void)hipMemsetAsync((char*)d_ws + WS_CTL, 0, CTL_ZERO_BYTES, stream);
    Args a{};
    for (int i = 0; i < 21; ++i) a.in[i] = d_in[i];
    a.out = (float*)d_out; a.ws = (unsigned char*)d_ws;
    if (MK_N_LAUNCHES == 1) { a.ph_lo = 0; a.ph_hi = N_PHASES; hipLaunchKernelGGL(mega_fwd, dim3(grid), dim3(NTHREADS), LDS_BYTES, stream, a); }
    else for (int p = 0; p < N_PHASES; ++p) { a.ph_lo = p; a.ph_hi = p + 1; hipLaunchKernelGGL(mega_fwd, dim3(grid), dim3(NTHREADS), LDS_BYTES, stream, a); }
}
```

```cpp
#include <hip/hip_runtime.h>
#include <stdint.h>
#include <stdio.h>

#define DEVI __device__ __forceinline__
#define LAS __attribute__((address_space(3)))
typedef unsigned short bf16_t;
typedef short bf16x8 __attribute__((ext_vector_type(8)));
typedef float f32x4 __attribute__((ext_vector_type(4)));
typedef unsigned u32x4 __attribute__((ext_vector_type(4)));
typedef unsigned u32x2 __attribute__((ext_vector_type(2)));
typedef int i32x4 __attribute__((ext_vector_type(4)));

constexpr int BATCH = 4, SEQ = 4096, DM = 2048, T = BATCH * SEQ;
constexpr int PROJ_LD = 2304;
constexpr int C_QLAT = 0, C_KVLAT = 512, C_SQ = 768, C_SK = 1792, C_SV = 1920, C_KPE = 2048;
constexpr int QK_LD = 1536;
constexpr int KV_LD = 2048;
constexpr float EPS = 1e-6f;
constexpr float LOG2E = 1.4426950408889634f;
constexpr int NWAVES = 8, NTHREADS = 512;

constexpr size_t MiB = 1u << 20;
constexpr size_t WS_CTL = 0, CTL_ZERO_BYTES = 128 * 1024;
constexpr size_t WS_W1T = 2 * MiB;
constexpr size_t WS_WQB = 11 * MiB;
constexpr size_t WS_WKVB = 13 * MiB;
constexpr size_t WS_WOUT = 14 * MiB;
constexpr size_t WS_WPQ = 22 * MiB;
constexpr size_t WS_SUBK = 30 * MiB;
constexpr size_t WS_UB = 32 * MiB;
constexpr size_t WS_VB = 96 * MiB;
constexpr size_t WS_PROJ = 160 * MiB;
constexpr size_t WS_KV = 232 * MiB;
constexpr size_t WS_Q = 296 * MiB;
constexpr size_t WS_K = 344 * MiB;
constexpr size_t WS_ACT = 392 * MiB;
constexpr size_t WS_END = 456 * MiB;

constexpr int RING_BYTES = 131072;
constexpr int MISC_OFF = RING_BYTES + 320;
constexpr int LDS_BYTES = 147456;

__device__ const float kInvFreq[32] = {
    1.000000000e+00f, 7.498942018e-01f, 5.623413324e-01f, 4.216965139e-01f, 3.162277639e-01f, 2.371373773e-01f, 1.778279394e-01f, 1.333521456e-01f,
    1.000000015e-01f, 7.498942316e-02f, 5.623413250e-02f, 4.216964915e-02f, 3.162277490e-02f, 2.371373773e-02f, 1.778279431e-02f, 1.333521400e-02f,
    9.999999776e-03f, 7.498942316e-03f, 5.623413250e-03f, 4.216964822e-03f, 3.162277630e-03f, 2.371373819e-03f, 1.778279431e-03f, 1.333521446e-03f,
    1.000000047e-03f, 7.498941850e-04f, 5.623413017e-04f, 4.216965172e-04f, 3.162277571e-04f, 2.371373703e-04f, 1.778279402e-04f, 1.333521504e-04f};

DEVI float bf2f(unsigned h) { return __uint_as_float((h & 0xffffu) << 16); }
typedef float f32x2_t __attribute__((ext_vector_type(2)));
typedef __bf16 bf16x2_t __attribute__((ext_vector_type(2)));
DEVI unsigned pk2(float lo, float hi) { const f32x2_t v = {lo, hi}; const bf16x2_t b = __builtin_convertvector(v, bf16x2_t); return __builtin_bit_cast(unsigned, b); }
DEVI unsigned f2bf(float f) { return pk2(f, 0.f) & 0xffffu; }
DEVI float wave_sum(float v) {
#pragma unroll
    for (int o = 1; o < 64; o <<= 1) v += __shfl_xor(v, o);
    return v;
}
DEVI void unpack8(const u32x4 w, float* f) {
    f[0] = __uint_as_float(w.x << 16); f[1] = __uint_as_float(w.x & 0xffff0000u);
    f[2] = __uint_as_float(w.y << 16); f[3] = __uint_as_float(w.y & 0xffff0000u);
    f[4] = __uint_as_float(w.z << 16); f[5] = __uint_as_float(w.z & 0xffff0000u);
    f[6] = __uint_as_float(w.w << 16); f[7] = __uint_as_float(w.w & 0xffff0000u);
}
DEVI u32x4 pack8(const float* f) { u32x4 w; w.x = pk2(f[0], f[1]); w.y = pk2(f[2], f[3]); w.z = pk2(f[4], f[5]); w.w = pk2(f[6], f[7]); return w; }
DEVI float gelu_tanh(float a) {
    const float z = 0.7978845608028654f * (a + 0.044715f * a * a * a);
    const float e = __expf(2.f * z);
    const float th = 1.f - 2.f / (e + 1.f);
    return 0.5f * a * (1.f + th);
}

namespace pg8 {
constexpr int BM = 256, BK = 64, HALF = 128, HTB = HALF * BK * 2, STAGE_BYTES = 8 * HTB, NXCD = 8, WGM = 8;
DEVI int lds_byte(int r, int c) { const int st = (r >> 4) * 2 + (c >> 5), rr = r & 15, cc = c & 31, ob = rr * 64 + cc * 2; return st * 1024 + (ob ^ (((ob >> 9) & 1) << 5)); }
DEVI void stage_rc(int b, int& R, int& C) { const int st = b / 1024, sb = b % 1024, swz = sb ^ (((sb >> 9) & 1) << 5); R = (st >> 1) * 16 + swz / 64; C = (st & 1) * 32 + (swz % 64) / 2; }
DEVI int perm32(int rho) { const int n = rho >> 4, i = rho & 15; return 8 * (i >> 2) + 4 * n + (i & 3); }
struct Unit { int pm, pn; };
struct Gemm { const bf16_t* A; const bf16_t* Bt; int M, N, K, lda, ldb; };
struct StaticOrder {
    int nM, nN, nwg, G, c;
    DEVI void init(int M, int N, int G_, int c_) { nM = M / BM; nN = N / BM; nwg = nM * nN; G = G_; c = c_; }
    DEVI bool next(int i, Unit& u) const {
        const long L = (long)i * G + c; if (L >= nwg) return false;
        int wgid = (int)L; { const int q = nwg / NXCD, r = nwg % NXCD, xcd = wgid % NXCD, off = wgid / NXCD; wgid = (xcd < r ? xcd * (q + 1) : r * (q + 1) + (xcd - r) * q) + off; }
        const int nig = WGM * nN, gid = wgid / nig, fm = gid * WGM, gsz = (nM - fm) < WGM ? (nM - fm) : WGM;
        u.pm = fm + ((wgid % nig) % gsz); u.pn = (wgid % nig) / gsz; return true;
    }
};
DEVI f32x4 tof(const f32x4 v) { return v; }
DEVI f32x4 tof(const i32x4 v) { return __builtin_convertvector(v, f32x4); }
DEVI unsigned cvt_pk_bf16(float lo, float hi) { unsigned r; asm volatile("v_cvt_pk_bf16_f32 %0, %1, %2" : "=v"(r) : "v"(lo), "v"(hi)); return r; }
template <bool I8> struct EpiBf16 {
    static constexpr bool PERM = true;
    bf16_t* O; int ldc;
    const float* ssq; float inv_n;
    const float* part; int pbase, pcnt;
    float* part_out; int pn_lim;
    const float* rs8; const float* cmax8;
    template <class A4> DEVI void operator()(const A4 (&acc)[2][2][4][2], const Unit& u, int wr, int wc, int fr, int fq) const {
        const int row0 = u.pm * BM + wr * 64 + fr, col0 = u.pn * BM + wc * 32 + 8 * fq;
        const bool wr_part = part_out && u.pn < pn_lim;
        f32x4 cs[2][2];
        if (I8) {
#pragma unroll
            for (int bj = 0; bj < 2; ++bj) { cs[bj][0] = *(const f32x4*)(cmax8 + col0 + bj * HALF) * (1.f / 127.f); cs[bj][1] = *(const f32x4*)(cmax8 + col0 + bj * HALF + 4) * (1.f / 127.f); }
        }
#pragma unroll
        for (int ai = 0; ai < 2; ++ai)
#pragma unroll
            for (int m = 0; m < 4; ++m) { const int row = row0 + ai * HALF + m * 16; bf16_t* rowp = O + (size_t)row * ldc + col0;
                float rs = 1.f;
                if (I8) rs = rs8[row];
                else if (ssq) rs = 1.f / sqrtf(ssq[row] * inv_n + EPS);
                else if (part) { float sq = 0.f; for (int j = 0; j < pcnt; ++j) sq += part[(size_t)row * 12 + pbase + j]; rs = 1.f / sqrtf(sq * inv_n + EPS); }
                float ss = 0.f;
#pragma unroll
                for (int bj = 0; bj < 2; ++bj) { f32x4 v0 = tof(acc[ai][bj][m][0]) * rs, v1 = tof(acc[ai][bj][m][1]) * rs;
                    if (I8) { v0 = v0 * cs[bj][0]; v1 = v1 * cs[bj][1]; }
                    u32x4 w; w.x = cvt_pk_bf16(v0[0], v0[1]); w.y = cvt_pk_bf16(v0[2], v0[3]); w.z = cvt_pk_bf16(v1[0], v1[1]); w.w = cvt_pk_bf16(v1[2], v1[3]);
                    *(u32x4*)(rowp + bj * HALF) = w;
                    ss += v0[0] * v0[0] + v0[1] * v0[1] + v0[2] * v0[2] + v0[3] * v0[3] + v1[0] * v1[0] + v1[1] * v1[1] + v1[2] * v1[2] + v1[3] * v1[3]; }
                if (wr_part) { ss += __shfl_xor(ss, 16); ss += __shfl_xor(ss, 32); if (fq == 0) part_out[(size_t)row * 12 + 4 * u.pn + wc] = ss; } }
    }
};
template <bool I8> struct EpiQp {
    static constexpr bool PERM = true;
    bf16_t* O; const float* ssq; float inv_n;
    const float* rs8; const float* cmax8;
    template <class A4> DEVI void operator()(const A4 (&acc)[2][2][4][2], const Unit& u, int wr, int wc, int fr, int fq) const {
        const int row0 = u.pm * BM + wr * 64 + fr;
        f32x4 cs[2][2];
        if (I8) { const int col0 = u.pn * BM + wc * 32 + 8 * fq;
#pragma unroll
            for (int bj = 0; bj < 2; ++bj) { cs[bj][0] = *(const f32x4*)(cmax8 + col0 + bj * HALF) * (1.f / 127.f); cs[bj][1] = *(const f32x4*)(cmax8 + col0 + bj * HALF + 4) * (1.f / 127.f); }
        }
#pragma unroll
        for (int ai = 0; ai < 2; ++ai)
#pragma unroll
            for (int m = 0; m < 4; ++m) { const int row = row0 + ai * HALF + m * 16;
                float rs = 1.f / sqrtf(ssq[row] * inv_n + EPS);
                if (I8) rs *= rs8[row];
#pragma unroll
                for (int bj = 0; bj < 2; ++bj) { f32x4 v0 = tof(acc[ai][bj][m][0]) * rs, v1 = tof(acc[ai][bj][m][1]) * rs;
                    if (I8) { v0 = v0 * cs[bj][0]; v1 = v1 * cs[bj][1]; }
                    u32x4 w; w.x = cvt_pk_bf16(v0[0], v0[1]); w.y = cvt_pk_bf16(v0[2], v0[3]); w.z = cvt_pk_bf16(v1[0], v1[1]); w.w = cvt_pk_bf16(v1[2], v1[3]);
                    *(u32x4*)(O + ((((size_t)(row >> 5) * 8 + u.pn) * 2 + bj) * 16 + 4 * wc + fq) * 256 + (row & 31) * 8) = w; } }
    }
};
template <bool I8> struct EpiResid {
    static constexpr bool PERM = true;
    const float* X; float* O; bf16_t* HB; float* ssq; int ldc;
    const float* rs8; const float* cmax8;
    template <class A4> DEVI void operator()(const A4 (&acc)[2][2][4][2], const Unit& u, int wr, int wc, int fr, int fq) const {
        const int row0 = u.pm * BM + wr * 64 + fr, col0 = u.pn * BM + wc * 32 + 8 * fq;
        f32x4 cs[2][2];
        if (I8) {
#pragma unroll
            for (int bj = 0; bj < 2; ++bj) { cs[bj][0] = *(const f32x4*)(cmax8 + col0 + bj * HALF) * (1.f / 127.f); cs[bj][1] = *(const f32x4*)(cmax8 + col0 + bj * HALF + 4) * (1.f / 127.f); }
        }
#pragma unroll
        for (int ai = 0; ai < 2; ++ai)
#pragma unroll
            for (int m = 0; m < 4; ++m) { const int row = row0 + ai * HALF + m * 16; const size_t off = (size_t)row * ldc + col0;
                float ss = 0.f; const float rs = I8 ? rs8[row] : 1.f;
#pragma unroll
                for (int bj = 0; bj < 2; ++bj) {
                    f32x4 a0 = tof(acc[ai][bj][m][0]), a1 = tof(acc[ai][bj][m][1]);
                    if (I8) { a0 = a0 * (cs[bj][0] * rs); a1 = a1 * (cs[bj][1] * rs); }
                    const f32x4 h0 = *(const f32x4*)(X + off + bj * HALF) + a0, h1 = *(const f32x4*)(X + off + bj * HALF + 4) + a1;
                    u32x4 w; w.x = cvt_pk_bf16(h0[0], h0[1]); w.y = cvt_pk_bf16(h0[2], h0[3]); w.z = cvt_pk_bf16(h1[0], h1[1]); w.w = cvt_pk_bf16(h1[2], h1[3]);
                    *(u32x4*)(HB + off + bj * HALF) = w;
                    ss += h0[0] * h0[0] + h0[1] * h0[1] + h0[2] * h0[2] + h0[3] * h0[3] + h1[0] * h1[0] + h1[1] * h1[1] + h1[2] * h1[2] + h1[3] * h1[3]; }
                ss += __shfl_xor(ss, 16); ss += __shfl_xor(ss, 32);
                if (fq == 0) atomicAdd(ssq + row, ss); }
    }
};

DEVI f32x4 mma16(const bf16x8 b, const bf16x8 a, const f32x4 c) { return __builtin_amdgcn_mfma_f32_16x16x32_bf16(b, a, c, 0, 0, 0); }
DEVI i32x4 mma16(const bf16x8 b, const bf16x8 a, const i32x4 c) { return __builtin_amdgcn_mfma_i32_16x16x64_i8(__builtin_bit_cast(i32x4, b), __builtin_bit_cast(i32x4, a), c, 0, 0, 0); }
template <bool I8> struct AccT { typedef f32x4 type; };
template <> struct AccT<true> { typedef i32x4 type; };
template <class Epi, class Sched, bool ALIGN_EPI, bool I8 = false>
DEVI void gemm_phase(LAS unsigned char* lds, const Gemm g, const Sched& S, const Epi& E) {
    const int tid = threadIdx.x, wid = __builtin_amdgcn_readfirstlane(tid >> 6), lane = tid & 63, wr = wid >> 2, wc = wid & 3, fr = lane & 15, fq = lane >> 4;
    const int K = g.K, nt = K / BK;
    unsigned voffA[2], voffB[2];
#pragma unroll
    for (int i = 0; i < 2; ++i) { int R, C; stage_rc(tid * 16 + i * 8192, R, C); const int Rb = Epi::PERM ? ((R & ~31) + perm32(R & 31)) : R;
        voffA[i] = (unsigned)(R * g.lda + C) * 2u; voffB[i] = (unsigned)(Rb * g.ldb + C) * 2u; }
    const size_t kstep = (size_t)(BK * 2);
    const size_t hA = (size_t)HALF * g.lda * 2, hB = (size_t)HALF * g.ldb * 2, tA = 2 * hA, tB = 2 * hB;
    const unsigned ldsw = (unsigned)wid * 1024u;
    const int aoff = lds_byte(wr * 64 + fr, fq * 8), boff = lds_byte(wc * 32 + fr, fq * 8);
#define PG8_SA(b, h) (((b) * 2 + (h)) * HTB)
#define PG8_SB(b, h) ((4 + (b) * 2 + (h)) * HTB)
#define PG8_STAGE(bufoff, gbase, voff) do { _Pragma("unroll") for (int _i = 0; _i < 2; ++_i) \
        __builtin_amdgcn_global_load_lds((const unsigned*)((const char*)(gbase) + (voff)[_i]), (LAS unsigned*)(lds + (bufoff) + ldsw + _i * 8192), 16, 0, 0); } while (0)
#define PG8_LDA(dst, b, h) do { _Pragma("unroll") for (int m = 0; m < 4; ++m) _Pragma("unroll") for (int k = 0; k < 2; ++k) dst[m][k] = *(const LAS bf16x8*)(lds + PG8_SA(b, h) + aoff + m * 2048 + k * 1024); } while (0)
#define PG8_LDB(dst, b, h) do { _Pragma("unroll") for (int n = 0; n < 2; ++n) _Pragma("unroll") for (int k = 0; k < 2; ++k) dst[n][k] = *(const LAS bf16x8*)(lds + PG8_SB(b, h) + boff + n * 2048 + k * 1024); } while (0)
#define PG8_MMA(ai, bj, At, Bt) do { __builtin_amdgcn_s_setprio(1); _Pragma("unroll") for (int m = 0; m < 4; ++m) _Pragma("unroll") for (int n = 0; n < 2; ++n) _Pragma("unroll") for (int k = 0; k < 2; ++k) \
        acc[ai][bj][m][n] = mma16(Bt[n][k], At[m][k], acc[ai][bj][m][n]); __builtin_amdgcn_s_setprio(0); } while (0)
#define PG8_WAIT_V(n) asm volatile("s_waitcnt vmcnt(" #n ")" ::: "memory")
#define PG8_WAIT_L(n) asm volatile("s_waitcnt lgkmcnt(" #n ")" ::: "memory")
#define PG8_BAR __builtin_amdgcn_s_barrier()
#define PG8_SCHED __builtin_amdgcn_sched_barrier(0)
    Unit cur, nxt; int ui = 0;
    if (!S.next(0, cur)) return;
    typedef typename AccT<I8>::type acc_t;
    acc_t acc[2][2][4][2];
#pragma unroll
    for (int a = 0; a < 2; ++a)
#pragma unroll
        for (int b = 0; b < 2; ++b)
#pragma unroll
            for (int m = 0; m < 4; ++m)
#pragma unroll
                for (int n = 0; n < 2; ++n) acc[a][b][m][n] = (acc_t){0, 0, 0, 0};
    bf16x8 At[4][2], B0[2][2], B1[2][2];
    const char* cA = (const char*)g.A + (size_t)cur.pm * tA; const char* cB = (const char*)g.Bt + (size_t)cur.pn * tB;
    PG8_STAGE(PG8_SB(0, 0), cB, voffB); PG8_STAGE(PG8_SB(0, 1), cB + hB, voffB); PG8_STAGE(PG8_SA(0, 0), cA, voffA); PG8_STAGE(PG8_SA(0, 1), cA + hA, voffA);
    if (wr == 1) PG8_BAR;
    PG8_WAIT_V(2); PG8_BAR;
    PG8_STAGE(PG8_SB(1, 0), cB + kstep, voffB); PG8_STAGE(PG8_SA(1, 0), cA + kstep, voffA); PG8_STAGE(PG8_SB(1, 1), cB + hB + kstep, voffB);
    PG8_WAIT_V(6); PG8_BAR;
    for (;;) {
        const bool has_next = S.next(ui + 1, nxt);
        const char* nA = has_next ? (const char*)g.A + (size_t)nxt.pm * tA : cA; const char* nB = has_next ? (const char*)g.Bt + (size_t)nxt.pn * tB : cB;
        for (int t = 0; t < nt; t += 2) {
            const bool last = (t == nt - 2);
            const char* a1 = cA + (size_t)(t + 1) * kstep;
            const char* a2 = last ? nA : cA + (size_t)(t + 2) * kstep; const char* b2 = last ? nB : cB + (size_t)(t + 2) * kstep;
            const char* a3 = a2 + kstep; const char* b3 = b2 + kstep;
            PG8_LDB(B0, 0, 0); PG8_LDB(B1, 0, 1); PG8_SCHED; PG8_LDA(At, 0, 0); PG8_STAGE(PG8_SA(1, 1), a1 + hA, voffA);
            PG8_WAIT_V(8); PG8_WAIT_L(0); PG8_BAR; PG8_MMA(0, 0, At, B0); PG8_MMA(0, 1, At, B1); PG8_BAR; PG8_SCHED;
            PG8_LDA(At, 0, 1); PG8_STAGE(PG8_SB(0, 0), b2, voffB); PG8_STAGE(PG8_SB(0, 1), b2 + hB, voffB); PG8_STAGE(PG8_SA(0, 0), a2, voffA);
            PG8_WAIT_V(8); PG8_WAIT_L(0); PG8_BAR; PG8_MMA(1, 0, At, B0); PG8_MMA(1, 1, At, B1); PG8_BAR; PG8_SCHED;
            PG8_LDB(B0, 1, 0); PG8_LDB(B1, 1, 1); PG8_SCHED; PG8_LDA(At, 1, 0); PG8_STAGE(PG8_SA(0, 1), a2 + hA, voffA);
            PG8_WAIT_V(8); PG8_WAIT_L(0); PG8_BAR; PG8_MMA(0, 0, At, B0); PG8_MMA(0, 1, At, B1); PG8_BAR; PG8_SCHED;
            PG8_LDA(At, 1, 1); PG8_STAGE(PG8_SB(1, 0), b3, voffB); PG8_STAGE(PG8_SB(1, 1), b3 + hB, voffB); PG8_STAGE(PG8_SA(1, 0), a3, voffA);
            PG8_WAIT_V(8); PG8_WAIT_L(0); PG8_BAR; PG8_MMA(1, 0, At, B0); PG8_MMA(1, 1, At, B1); PG8_BAR; PG8_SCHED;
        }
        if constexpr (ALIGN_EPI) { if (wr == 0) PG8_BAR; }
        E(acc, cur, wr, wc, fr, fq);
        if (!has_next) break;
#pragma unroll
        for (int a = 0; a < 2; ++a)
#pragma unroll
            for (int b = 0; b < 2; ++b)
#pragma unroll
                for (int m = 0; m < 4; ++m)
#pragma unroll
                    for (int n = 0; n < 2; ++n) acc[a][b][m][n] = (acc_t){0, 0, 0, 0};
        cur = nxt; cA = nA; cB = nB; ++ui;
        if constexpr (ALIGN_EPI) { if (wr == 1) PG8_BAR; }
    }
    PG8_WAIT_V(0);
    if constexpr (!ALIGN_EPI) { if (wr == 0) PG8_BAR; }
    PG8_BAR;
#undef PG8_SA
#undef PG8_SB
#undef PG8_STAGE
#undef PG8_LDA
#undef PG8_LDB
#undef PG8_MMA
#undef PG8_WAIT_V
#undef PG8_WAIT_L
#undef PG8_BAR
#undef PG8_SCHED
}
}

#define XB_TMO      128
#define XB_XCNT(j)  (256  + 64 * (j))
#define XB_XSUB(j)  (1280 + 64 * (j))
#define XB_XGEN(j)  (2304 + 64 * (j))
#define XB_TOP      3328
#define XB_TOPGEN   3392
#define XCD_BAR_WORDS 3456
#define XB_SPIN_CAP (1u << 18)
DEVI unsigned xb_ld(unsigned* p)              { return __hip_atomic_load(p, __ATOMIC_RELAXED, __HIP_MEMORY_SCOPE_AGENT); }
DEVI unsigned xb_add(unsigned* p, unsigned v) { return __hip_atomic_fetch_add(p, v, __ATOMIC_RELAXED, __HIP_MEMORY_SCOPE_AGENT); }
DEVI unsigned xb_xcc_id() { return (unsigned)__builtin_amdgcn_s_getreg((3 << 11) | 20) & 0xFu; }
#define XB_SPIN(cond, bar) do { unsigned _sp = 0; while (cond) { __builtin_amdgcn_s_sleep(1); \
    if ((++_sp & 255u) == 0u) { if (xb_ld(&(bar)[XB_TMO])) break; if (_sp > XB_SPIN_CAP) { atomicAdd(&(bar)[XB_TMO], 1u); break; } } } } while (0)
struct XcdBarrier { unsigned* bar; unsigned x; volatile LAS unsigned* st; };
DEVI XcdBarrier xcd_barrier_post(unsigned* bar, volatile LAS unsigned* st) {
    XcdBarrier b; b.bar = bar; b.x = xb_xcc_id(); b.st = st;
    if (threadIdx.x == 0) (void)xb_add(&bar[XB_XCNT(b.x)], 1u);
    return b;
}
DEVI void xcd_barrier_complete(unsigned* bar, unsigned x, unsigned& nloc, unsigned& nx) {
    const unsigned G = gridDim.x * gridDim.y * gridDim.z;
    unsigned sum, cnt, mine, sp = 0u;
    for (;;) {
        sum = 0u; cnt = 0u; mine = 0u;
#pragma unroll
        for (unsigned j = 0; j < 16; ++j) { const unsigned c = xb_ld(&bar[XB_XCNT(j)]); sum += c; cnt += (c > 0u) ? 1u : 0u; mine = (j == x) ? c : mine; }
        if (sum == G) break;
        __builtin_amdgcn_s_sleep(1);
        if ((++sp & 255u) == 0u) { if (xb_ld(&bar[XB_TMO])) break; if (sp > XB_SPIN_CAP) { atomicAdd(&bar[XB_TMO], 1u); break; } }
    }
    nloc = mine > 0u ? mine : 1u; nx = cnt > 0u ? cnt : 1u;
}
DEVI void xcd_barrier(const XcdBarrier& b) {
    asm volatile("s_waitcnt vmcnt(0)" ::: "memory");
    __syncthreads();
    if (threadIdx.x == 0) {
        unsigned* bar = b.bar;
        __builtin_amdgcn_s_waitcnt(0);
        unsigned nloc = b.st[0], nx = b.st[1];
        if (nloc == 0u) { xcd_barrier_complete(bar, b.x, nloc, nx); b.st[0] = nloc; b.st[1] = nx; }
        const unsigned old = xb_add(&bar[XB_XSUB(b.x)], 1u);
        const unsigned gen = old / nloc;
        if (old + 1u == (gen + 1u) * nloc) {
            __builtin_amdgcn_fence(__ATOMIC_RELEASE, "agent");
            asm volatile("s_waitcnt vmcnt(0)" ::: "memory");
            const unsigned og = xb_add(&bar[XB_TOP], 1u);
            const unsigned tg = og / nx;
            if (og + 1u == (tg + 1u) * nx) xb_add(&bar[XB_TOPGEN], 1u);
            else XB_SPIN(xb_ld(&bar[XB_TOPGEN]) == tg, bar);
            __builtin_amdgcn_fence(__ATOMIC_ACQUIRE, "agent");
            xb_add(&bar[XB_XGEN(b.x)], 1u);
            asm volatile("s_waitcnt vmcnt(0)" ::: "memory");
        } else {
            XB_SPIN(xb_ld(&bar[XB_XGEN(b.x)]) == gen, bar);
            __builtin_amdgcn_fence(__ATOMIC_ACQUIRE, "agent");
            asm volatile("s_waitcnt vmcnt(0)" ::: "memory");
        }
    }
    __syncthreads();
}

struct TJob { const float* W; bf16_t* WT; const float* gain; int K, N, mode, pad; };
DEVI int dst_row(int mode, int n) {
    if (mode == 1) return n < 768 ? n : (n < 832 ? 2048 + (n - 768) : n - 64);
    if (mode == 2) { const int h = n >> 8, j = n & 255; return j < 128 ? h * 128 + j : 1024 + h * 128 + (j - 128); }
    return n;
}
DEVI void transpose_item(const float* W, bf16_t* WT, const float* gain, int K, int N, int mode, int item, LAS float* scr, int lane) {
    const int nblk = N / 32, kb = item / nblk, nb = item % nblk, k0 = 64 * kb, n0 = 32 * nb;
    {
        const int kr = lane >> 3, nc = (lane & 7) * 4;
        f32x4 v[8];
#pragma unroll
        for (int i = 0; i < 8; ++i) v[i] = *(const f32x4*)(W + (size_t)(k0 + 8 * i + kr) * N + n0 + nc);
#pragma unroll
        for (int i = 0; i < 8; ++i) { const int kk = 8 * i + kr; const float g = gain ? gain[k0 + kk] : 1.f;
            scr[kk * 33 + nc] = v[i][0] * g; scr[kk * 33 + nc + 1] = v[i][1] * g; scr[kk * 33 + nc + 2] = v[i][2] * g; scr[kk * 33 + nc + 3] = v[i][3] * g; }
    }
    asm volatile("s_waitcnt lgkmcnt(0)" ::: "memory");
    const int c = lane & 7;
#pragma unroll
    for (int jj = 0; jj < 4; ++jj) {
        const int n = (lane >> 3) + 8 * jj; const LAS float* s = scr + (8 * c) * 33 + n;
        u32x4 o; o.x = pk2(s[0 * 33], s[1 * 33]); o.y = pk2(s[2 * 33], s[3 * 33]); o.z = pk2(s[4 * 33], s[5 * 33]); o.w = pk2(s[6 * 33], s[7 * 33]);
        *(u32x4*)(WT + (size_t)dst_row(mode, n0 + n) * K + k0 + 8 * c) = o;
    }
    asm volatile("s_waitcnt lgkmcnt(0)" ::: "memory");
}
DEVI unsigned pack4_i8(const f32x4 x) { const int q0 = __float2int_rn(x[0]), q1 = __float2int_rn(x[1]), q2 = __float2int_rn(x[2]), q3 = __float2int_rn(x[3]); return (unsigned)((q0 & 255) | ((q1 & 255) << 8) | ((q2 & 255) << 16) | (q3 << 24)); }
DEVI float wave_max(float v) {
#pragma unroll
    for (int o = 1; o < 64; o <<= 1) v = fmaxf(v, __shfl_xor(v, o));
    return v;
}
DEVI void colmax_item(const float* W, const float* gain, float* cmax, int N, int mode, int item, int lane) {
    const int ncb = (N + 255) / 256, kb = item / ncb, cb = item % ncb, k0 = 32 * kb, c = 256 * cb + 4 * lane;
    if (c >= N) return;
    f32x4 m = (f32x4){0.f, 0.f, 0.f, 0.f};
#pragma unroll
    for (int h = 0; h < 2; ++h) { f32x4 v[16];
#pragma unroll
        for (int i = 0; i < 16; ++i) v[i] = *(const f32x4*)(W + (size_t)(k0 + 16 * h + i) * N + c);
#pragma unroll
        for (int i = 0; i < 16; ++i) { const float g = gain ? gain[k0 + 16 * h + i] : 1.f;
#pragma unroll
            for (int e = 0; e < 4; ++e) m[e] = fmaxf(m[e], fabsf(v[i][e] * g)); } }
#pragma unroll
    for (int e = 0; e < 4; ++e) atomicMax((unsigned*)(cmax + dst_row(mode, c + e)), __float_as_uint(m[e]));
}
DEVI void transpose_item_q(const float* W, signed char* WT, const float* gain, const float* cmax, int K, int N, int mode, int item, LAS float* scr, int lane) {
    const int nblk = N / 32, kb = item / nblk, nb = item % nblk, k0 = 64 * kb, n0 = 32 * nb;
    {
        const int kr = lane >> 3, nc = (lane & 7) * 4;
        f32x4 v[8];
#pragma unroll
        for (int i = 0; i < 8; ++i) v[i] = *(const f32x4*)(W + (size_t)(k0 + 8 * i + kr) * N + n0 + nc);
#pragma unroll
        for (int i = 0; i < 8; ++i) { const int kk = 8 * i + kr; const float g = gain ? gain[k0 + kk] : 1.f;
            scr[kk * 33 + nc] = v[i][0] * g; scr[kk * 33 + nc + 1] = v[i][1] * g; scr[kk * 33 + nc + 2] = v[i][2] * g; scr[kk * 33 + nc + 3] = v[i][3] * g; }
    }
    asm volatile("s_waitcnt lgkmcnt(0)" ::: "memory");
    const int c = lane & 7;
#pragma unroll
    for (int jj = 0; jj < 4; ++jj) {
        const int n = (lane >> 3) + 8 * jj, dr = dst_row(mode, n0 + n); const LAS float* s = scr + (8 * c) * 33 + n;
        const float cm = cmax[dr], sc = cm > 0.f ? 127.f / cm : 0.f;
        u32x2 o; o.x = pack4_i8((f32x4){s[0 * 33], s[1 * 33], s[2 * 33], s[3 * 33]} * sc); o.y = pack4_i8((f32x4){s[4 * 33], s[5 * 33], s[6 * 33], s[7 * 33]} * sc);
        *(u32x2*)(WT + (size_t)dr * K + k0 + 8 * c) = o;
    }
    asm volatile("s_waitcnt lgkmcnt(0)" ::: "memory");
}
DEVI void convert_range(const float* src, bf16_t* dst, size_t n8, const float* gain, int ncols, size_t gtid, size_t nthr) {
    for (size_t i = gtid; i < n8; i += nthr) {
        const f32x4 a = *(const f32x4*)(src + i * 8), b = *(const f32x4*)(src + i * 8 + 4);
        float f[8] = {a.x, a.y, a.z, a.w, b.x, b.y, b.z, b.w};
        if (gain) { const int c = (int)((i * 8) % (size_t)ncols); const f32x4 g0 = *(const f32x4*)(gain + c), g1 = *(const f32x4*)(gain + c + 4);
            f[0] *= g0.x; f[1] *= g0.y; f[2] *= g0.z; f[3] *= g0.w; f[4] *= g1.x; f[5] *= g1.y; f[6] *= g1.z; f[7] *= g1.w; }
        *(u32x4*)(dst + i * 8) = pack8(f);
    }
}
DEVI void norm1_regs(const f32x4 (&v)[8], const float* g, bf16_t* orow, int lane) {
    float s = 0.f;
#pragma unroll
    for (int j = 0; j < 8; ++j) s += v[j].x * v[j].x + v[j].y * v[j].y + v[j].z * v[j].z + v[j].w * v[j].w;
    const float r = 1.f / sqrtf(wave_sum(s) * (1.f / DM) + EPS);
#pragma unroll
    for (int j = 0; j < 8; ++j) { const f32x4 gg = *(const f32x4*)(g + 4 * (lane + 64 * j));
        u32x2 o; o.x = pk2(v[j].x * r * gg.x, v[j].y * r * gg.y); o.y = pk2(v[j].z * r * gg.z, v[j].w * r * gg.w);
        *(u32x2*)(orow + 4 * (lane + 64 * j)) = o; }
}
DEVI void norm1_regs_q(const f32x4 (&v)[8], const float* g, signed char* orow, float* rs, int lane) {
    float s = 0.f;
#pragma unroll
    for (int j = 0; j < 8; ++j) s += v[j].x * v[j].x + v[j].y * v[j].y + v[j].z * v[j].z + v[j].w * v[j].w;
    const float r = 1.f / sqrtf(wave_sum(s) * (1.f / DM) + EPS);
    f32x4 y[8]; float am = 0.f;
#pragma unroll
    for (int j = 0; j < 8; ++j) { const f32x4 gg = *(const f32x4*)(g + 4 * (lane + 64 * j)); y[j] = v[j] * r * gg;
        am = fmaxf(am, fmaxf(fmaxf(fabsf(y[j][0]), fabsf(y[j][1])), fmaxf(fabsf(y[j][2]), fabsf(y[j][3])))); }
    am = wave_max(am);
    const float sc = am > 0.f ? 127.f / am : 0.f;
#pragma unroll
    for (int j = 0; j < 8; ++j) *(unsigned*)(orow + 4 * (lane + 64 * j)) = pack4_i8(y[j] * sc);
    if (lane == 0) *rs = am * (1.f / 127.f);
}
DEVI void norm1_row(const float* xrow, const float* g, bf16_t* orow, int lane) {
    f32x4 v[8]; float s = 0.f;
#pragma unroll
    for (int j = 0; j < 8; ++j) { v[j] = *(const f32x4*)(xrow + 4 * (lane + 64 * j)); s += v[j].x * v[j].x + v[j].y * v[j].y + v[j].z * v[j].z + v[j].w * v[j].w; }
    const float r = 1.f / sqrtf(wave_sum(s) * (1.f / DM) + EPS);
#pragma unroll
    for (int j = 0; j < 8; ++j) { const f32x4 gg = *(const f32x4*)(g + 4 * (lane + 64 * j));
        u32x2 o; o.x = pk2(v[j].x * r * gg.x, v[j].y * r * gg.y); o.y = pk2(v[j].z * r * gg.z, v[j].w * r * gg.w);
        *(u32x2*)(orow + 4 * (lane + 64 * j)) = o; }
}
DEVI void p2_row(bf16_t* p, const float* sqg, const float* skg, int lane) {
    {
        u32x4 w = *(const u32x4*)(p + C_QLAT + lane * 8); float f[8]; unpack8(w, f); float s = 0.f;
#pragma unroll
        for (int i = 0; i < 8; ++i) s += f[i] * f[i];
        const float r = 1.f / sqrtf(wave_sum(s) * (1.f / 512.f) + EPS);
#pragma unroll
        for (int i = 0; i < 8; ++i) f[i] *= r;
        *(u32x4*)(p + C_QLAT + lane * 8) = pack8(f);
    }
    {
        u32x2 w = *(const u32x2*)(p + C_KVLAT + lane * 4);
        float f0 = __uint_as_float(w.x << 16), f1 = __uint_as_float(w.x & 0xffff0000u), f2 = __uint_as_float(w.y << 16), f3 = __uint_as_float(w.y & 0xffff0000u);
        const float r = 1.f / sqrtf(wave_sum(f0 * f0 + f1 * f1 + f2 * f2 + f3 * f3) * (1.f / 256.f) + EPS);
        u32x2 o; o.x = pk2(f0 * r, f1 * r); o.y = pk2(f2 * r, f3 * r);
        *(u32x2*)(p + C_KVLAT + lane * 4) = o;
    }
    {
        u32x4 w0 = *(const u32x4*)(p + C_SQ + lane * 16), w1 = *(const u32x4*)(p + C_SQ + lane * 16 + 8); float f[16]; unpack8(w0, f); unpack8(w1, f + 8); float s = 0.f;
#pragma unroll
        for (int i = 0; i < 16; ++i) s += f[i] * f[i];
        s += __shfl_xor(s, 1); s += __shfl_xor(s, 2);
        const float r = 0.125f / sqrtf(s * (1.f / 64.f) + EPS);
        const int d0 = (lane & 3) * 16;
#pragma unroll
        for (int i = 0; i < 16; ++i) f[i] *= r * sqg[d0 + i];
        *(u32x4*)(p + C_SQ + lane * 16) = pack8(f); *(u32x4*)(p + C_SQ + lane * 16 + 8) = pack8(f + 8);
    }
    {
        unsigned w = *(const unsigned*)(p + C_SK + lane * 2);
        float f0 = __uint_as_float(w << 16), f1 = __uint_as_float(w & 0xffff0000u);
        float s = f0 * f0 + f1 * f1;
#pragma unroll
        for (int o = 1; o < 32; o <<= 1) s += __shfl_xor(s, o);
        const float r = 1.f / sqrtf(s * (1.f / 64.f) + EPS);
        const int d0 = (lane & 31) * 2;
        *(unsigned*)(p + C_SK + lane * 2) = pk2(f0 * r * skg[d0], f1 * r * skg[d0 + 1]);
    }
}
DEVI void p3_row(const bf16_t* qraw, const bf16_t* kvrow, const bf16_t* kpe, int pos, const float* qg, const float* kg, bf16_t* Qo, bf16_t* Ko, int lane) {
    const int hd = lane >> 3, sub = lane & 7;
    float cs[8], sn[8];
#pragma unroll
    for (int e = 0; e < 8; ++e) {
        const float ang = (float)pos * kInvFreq[8 * (sub & 3) + e];
        const double rev = (double)ang * 0.15915494309189535;
        const float fr = (float)(rev - floor(rev));
        sn[e] = __builtin_amdgcn_sinf(fr); cs[e] = __builtin_amdgcn_cosf(fr);
    }
    const float qscale = 0.07216878364870322f * LOG2E;
#pragma unroll
    for (int which = 0; which < 2; ++which) {
        const float* gn = which ? kg : qg;
        u32x4 w0, w1, w2;
        if (which == 0) { const bf16_t* qh = qraw + hd * 192; w0 = *(const u32x4*)(qh + 8 * sub); w1 = *(const u32x4*)(qh + 64 + 8 * sub); w2 = *(const u32x4*)(qh + 128 + 8 * sub); }
        else { const bf16_t* kh = kvrow + hd * 128; w0 = *(const u32x4*)(kh + 8 * sub); w1 = *(const u32x4*)(kh + 64 + 8 * sub); w2 = *(const u32x4*)(kpe + 8 * sub); }
        float f0[8], f1[8], f2[8]; unpack8(w0, f0); unpack8(w1, f1); unpack8(w2, f2);
        float ss = 0.f;
#pragma unroll
        for (int e = 0; e < 8; ++e) ss += f0[e] * f0[e] + f1[e] * f1[e] + f2[e] * f2[e];
        ss += __shfl_xor(ss, 1); ss += __shfl_xor(ss, 2); ss += __shfl_xor(ss, 4);
        const float r = (which ? 1.f : qscale) / sqrtf(ss * (1.f / 192.f) + EPS);
        const f32x4 ga = *(const f32x4*)(gn + 8 * sub), gb = *(const f32x4*)(gn + 8 * sub + 4), gc = *(const f32x4*)(gn + 64 + 8 * sub), gd = *(const f32x4*)(gn + 64 + 8 * sub + 4),
                    ge = *(const f32x4*)(gn + 128 + 8 * sub), gf = *(const f32x4*)(gn + 128 + 8 * sub + 4);
        const float g0[8] = {ga[0], ga[1], ga[2], ga[3], gb[0], gb[1], gb[2], gb[3]}, g1[8] = {gc[0], gc[1], gc[2], gc[3], gd[0], gd[1], gd[2], gd[3]}, g2[8] = {ge[0], ge[1], ge[2], ge[3], gf[0], gf[1], gf[2], gf[3]};
        float ro[8];
#pragma unroll
        for (int e = 0; e < 8; ++e) { f0[e] *= r * g0[e]; f1[e] *= r * g1[e]; f2[e] *= r * g2[e]; }
#pragma unroll
        for (int e = 0; e < 8; ++e) { const float pr = __shfl_xor(f2[e], 4); ro[e] = (sub < 4) ? (f2[e] * cs[e] - pr * sn[e]) : (f2[e] * cs[e] + pr * sn[e]); }
        bf16_t* dst = (which ? Ko : Qo) + hd * 192;
        *(u32x4*)(dst + 8 * sub) = pack8(f0); *(u32x4*)(dst + 64 + 8 * sub) = pack8(f1); *(u32x4*)(dst + 128 + 8 * sub) = pack8(ro);
    }
}
DEVI void mla_row(const bf16_t* Q, const bf16_t* K, const bf16_t* KV, bf16_t* O, int b, int h, int q, int lane) {
    const size_t t = (size_t)b * SEQ + q;
    const bf16_t* qp = Q + t * QK_LD + h * 192;
    const float q0 = bf2f(qp[lane]), q1 = bf2f(qp[64 + lane]), q2 = bf2f(qp[128 + lane]);
    float m = -INFINITY, l = 0.f, o0 = 0.f, o1 = 0.f;
    const bf16_t* kb = K + (size_t)b * SEQ * QK_LD + h * 192;
    const bf16_t* vb = KV + (size_t)b * SEQ * KV_LD + 1024 + h * 128;
#pragma unroll 4
    for (int j = 0; j <= q; ++j) {
        const bf16_t* kr = kb + (size_t)j * QK_LD; const bf16_t* vr = vb + (size_t)j * KV_LD;
        const float s = wave_sum(q0 * bf2f(kr[lane]) + q1 * bf2f(kr[64 + lane]) + q2 * bf2f(kr[128 + lane]));
        const float v0 = bf2f(vr[lane]), v1 = bf2f(vr[64 + lane]);
        const float mn = fmaxf(m, s), c = exp2f(m - mn), p = exp2f(s - mn);
        l = l * c + p; o0 = o0 * c + p * v0; o1 = o1 * c + p * v1; m = mn;
    }
    const float il = 1.f / l;
    O[t * DM + h * 128 + lane] = (bf16_t)f2bf(o0 * il); O[t * DM + h * 128 + 64 + lane] = (bf16_t)f2bf(o1 * il);
}
DEVI int t5_bucket(int dist) {
    const int n = dist > 0 ? dist : 0;
    if (n < 16) return n;
    const float nf = (float)n;
    int large = 16 + (int)(logf(nf / 16.f) / 2.0794415416798357f * 16.f);
    return large < 31 ? large : 31;
}
DEVI void swa_row(const bf16_t* proj, const int* pos, const float* sinks, const float* rel, bf16_t* O, int b, int hh, int q, int lane) {
    const int kvh = hh >> 3;
    const size_t t = (size_t)b * SEQ + q;
    const float qv = bf2f(proj[t * PROJ_LD + C_SQ + hh * 64 + lane]);
    const float sink = sinks[hh];
    float m = sink, l = 1.f, o = 0.f;
    const int pq = pos[t];
    const int j0 = q - 127 > 0 ? q - 127 : 0;
#pragma unroll 4
    for (int j = j0; j <= q; ++j) {
        const size_t tk = (size_t)b * SEQ + j;
        const float kx = bf2f(proj[tk * PROJ_LD + C_SK + kvh * 64 + lane]), vx = bf2f(proj[tk * PROJ_LD + C_SV + kvh * 64 + lane]);
        const float s = wave_sum(qv * kx) + rel[t5_bucket(pq - pos[tk]) * 16 + hh];
        const float mn = fmaxf(m, s), c = __expf(m - mn), p = __expf(s - mn);
        l = l * c + p; o = o * c + p * vx; m = mn;
    }
    O[t * DM + 1024 + hh * 64 + lane] = (bf16_t)f2bf(o / l);
}
DEVI void p4_row(bf16_t* p, int lane) {
    float f[4][8]; float sa = 0.f, sb = 0.f;
#pragma unroll
    for (int i = 0; i < 4; ++i) { unpack8(*(const u32x4*)(p + lane * 8 + 512 * i), f[i]);
        float s = 0.f;
#pragma unroll
        for (int e = 0; e < 8; ++e) s += f[i][e] * f[i][e];
        if (i < 2) sa += s; else sb += s; }
    const float ra = 1.f / sqrtf(wave_sum(sa) * (1.f / 1024.f) + EPS), rb = 1.f / sqrtf(wave_sum(sb) * (1.f / 1024.f) + EPS);
#pragma unroll
    for (int i = 0; i < 4; ++i) { const float r = i < 2 ? ra : rb;
#pragma unroll
        for (int e = 0; e < 8; ++e) f[i][e] *= r;
        *(u32x4*)(p + lane * 8 + 512 * i) = pack8(f[i]); }
}
DEVI void p4_row_q(bf16_t* p, float* rs, int lane) {
    float f[4][8]; float sa = 0.f, sb = 0.f;
#pragma unroll
    for (int i = 0; i < 4; ++i) { unpack8(*(const u32x4*)(p + lane * 8 + 512 * i), f[i]);
        float s = 0.f;
#pragma unroll
        for (int e = 0; e < 8; ++e) s += f[i][e] * f[i][e];
        if (i < 2) sa += s; else sb += s; }
    const float ra = 1.f / sqrtf(wave_sum(sa) * (1.f / 1024.f) + EPS), rb = 1.f / sqrtf(wave_sum(sb) * (1.f / 1024.f) + EPS);
    float am = 0.f;
#pragma unroll
    for (int i = 0; i < 4; ++i) { const float r = i < 2 ? ra : rb;
#pragma unroll
        for (int e = 0; e < 8; ++e) { f[i][e] *= r; am = fmaxf(am, fabsf(f[i][e])); } }
    am = wave_max(am);
    const float sc = am > 0.f ? 127.f / am : 0.f;
#pragma unroll
    for (int i = 0; i < 4; ++i) { u32x2 o; o.x = pack4_i8((f32x4){f[i][0], f[i][1], f[i][2], f[i][3]} * sc); o.y = pack4_i8((f32x4){f[i][4], f[i][5], f[i][6], f[i][7]} * sc);
        *(u32x2*)((signed char*)p + lane * 8 + 512 * i) = o; }
    if (lane == 0) *rs = am * (1.f / 127.f);
}
DEVI void p5_row(const float* hrow, bf16_t* orow, int lane) {
    f32x4 v[8]; float s = 0.f;
#pragma unroll
    for (int j = 0; j < 8; ++j) { v[j] = *(const f32x4*)(hrow + 4 * (lane + 64 * j)); s += v[j].x * v[j].x + v[j].y * v[j].y + v[j].z * v[j].z + v[j].w * v[j].w; }
    const float r = 1.f / sqrtf(wave_sum(s) * (1.f / DM) + EPS);
#pragma unroll
    for (int j = 0; j < 8; ++j) { u32x2 o; o.x = pk2(v[j].x * r, v[j].y * r); o.y = pk2(v[j].z * r, v[j].w * r); *(u32x2*)(orow + 4 * (lane + 64 * j)) = o; }
}
DEVI void topk_task(const bf16_t* qp, const bf16_t* subk, int* idx, float* gw, size_t t, int h, int lane) {
    float tv[2]; int ti[2];
#pragma unroll
    for (int p = 0; p < 2; ++p) {
        const bf16_t* qs = qp + t * DM + h * 256 + p * 128;
        const float qlo = bf2f(qs[lane]), qhi = bf2f(qs[64 + lane]);
        const bf16_t* k0 = subk + ((size_t)(h * 2 + p) * 128 + lane) * 128; const bf16_t* k1 = k0 + 64 * 128;
        float a0 = 0.f, a1 = 0.f;
        for (int d = 0; d < 64; ++d) { const float qd = __shfl(qlo, d); a0 += qd * bf2f(k0[d]); a1 += qd * bf2f(k1[d]); }
        for (int d = 0; d < 64; ++d) { const float qd = __shfl(qhi, d); a0 += qd * bf2f(k0[64 + d]); a1 += qd * bf2f(k1[64 + d]); }
        float v0 = a0, v1 = a1; float mytv = -INFINITY; int myti = 0;
        for (int r = 0; r < 16; ++r) {
            float bv = v0 >= v1 ? v0 : v1; int bi = v0 >= v1 ? lane : lane + 64;
#pragma unroll
            for (int o = 32; o >= 1; o >>= 1) { const float ov = __shfl_xor(bv, o); const int oi = __shfl_xor(bi, o); if (ov > bv || (ov == bv && oi < bi)) { bv = ov; bi = oi; } }
            if (lane == r) { mytv = bv; myti = bi; }
            if (bi == lane) v0 = -INFINITY;
            if (bi == lane + 64) v1 = -INFINITY;
        }
        tv[p] = mytv; ti[p] = myti;
    }
    float cv[4];
#pragma unroll
    for (int mm = 0; mm < 4; ++mm) { const int c = lane + 64 * mm; cv[mm] = __shfl(tv[0], c >> 4) + __shfl(tv[1], c & 15); }
    float mys = -INFINITY; int myc = 0;
    for (int r = 0; r < 16; ++r) {
        float bv = cv[0]; int bc = lane;
#pragma unroll
        for (int mm = 1; mm < 4; ++mm) if (cv[mm] > bv) { bv = cv[mm]; bc = lane + 64 * mm; }
#pragma unroll
        for (int o = 32; o >= 1; o >>= 1) { const float ov = __shfl_xor(bv, o); const int oc = __shfl_xor(bc, o); if (ov > bv || (ov == bv && oc < bc)) { bv = ov; bc = oc; } }
        if (lane == r) { mys = bv; myc = bc; }
#pragma unroll
        for (int mm = 0; mm < 4; ++mm) if (bc == lane + 64 * mm) cv[mm] = -INFINITY;
    }
    const int i1 = __shfl(ti[0], (myc >> 4) & 15), i2 = __shfl(ti[1], myc & 15);
    float mx = mys;
#pragma unroll
    for (int o = 8; o >= 1; o >>= 1) mx = fmaxf(mx, __shfl_xor(mx, o));
    const float e = __expf(mys - mx); float sm = e;
#pragma unroll
    for (int o = 8; o >= 1; o >>= 1) sm += __shfl_xor(sm, o);
    if (lane < 16) { idx[t * 128 + h * 16 + lane] = i1 * 128 + i2; gw[t * 128 + h * 16 + lane] = e / sm; }
}
DEVI void gather_token(const bf16_t* hn, const bf16_t* Ub, const bf16_t* Vb, const int* idx, const float* gw, float* out, size_t t, int lane) {
    float hv[4][8];
#pragma unroll
    for (int i = 0; i < 4; ++i) unpack8(*(const u32x4*)(hn + t * DM + lane * 8 + 512 * i), hv[i]);
    float y[4][8];
#pragma unroll
    for (int i = 0; i < 4; ++i)
#pragma unroll
        for (int e = 0; e < 8; ++e) y[i][e] = 0.f;
#pragma unroll 2
    for (int k = 0; k < 128; ++k) {
        const int ex = idx[t * 128 + k]; const float g = gw[t * 128 + k];
        const bf16_t* ur = Ub + (size_t)ex * DM + lane * 8; const bf16_t* vr = Vb + (size_t)ex * DM + lane * 8;
        u32x4 uw[4], vw[4];
#pragma unroll
        for (int i = 0; i < 4; ++i) { uw[i] = *(const u32x4*)(ur + 512 * i); vw[i] = *(const u32x4*)(vr + 512 * i); }
        float d = 0.f;
#pragma unroll
        for (int i = 0; i < 4; ++i) { float f[8]; unpack8(uw[i], f);
#pragma unroll
            for (int e = 0; e < 8; ++e) d += f[e] * hv[i][e]; }
        const float a = wave_sum(d);
        const float wgt = g * gelu_tanh(a);
#pragma unroll
        for (int i = 0; i < 4; ++i) { float f[8]; unpack8(vw[i], f);
#pragma unroll
            for (int e = 0; e < 8; ++e) y[i][e] += wgt * f[e]; }
    }
#pragma unroll
    for (int i = 0; i < 4; ++i) { float* o = out + t * DM + lane * 8 + 512 * i;
        f32x4 a = *(const f32x4*)o, b = *(const f32x4*)(o + 4);
        a.x += y[i][0]; a.y += y[i][1]; a.z += y[i][2]; a.w += y[i][3]; b.x += y[i][4]; b.y += y[i][5]; b.z += y[i][6]; b.w += y[i][7];
        *(f32x4*)o = a; *(f32x4*)(o + 4) = b; }
}


typedef float f32x16 __attribute__((ext_vector_type(16)));
typedef short s16x4 __attribute__((ext_vector_type(4)));
namespace mla {
constexpr int SLOT = 40960, KOFF = 0, VOFF = 24576, NSLOT = 3, WS_OFF = NSLOT * SLOT;
DEVI int crow(int r, int hh) { return (r & 3) + 8 * (r >> 2) + 4 * hh; }
DEVI void glds16(const void* gsrc, unsigned lds_dst) { unsigned keep;
    asm volatile("s_mov_b32 %0, m0\n\ts_mov_b32 m0, %2\n\ts_nop 0\n\tglobal_load_lds_dwordx4 %1, off\n\ts_mov_b32 m0, %0" : "=&s"(keep) : "v"(gsrc), "s"(lds_dst) : "memory"); }
DEVI s16x4 vtr(LAS const unsigned char* p) { return __builtin_bit_cast(s16x4, __builtin_amdgcn_ds_read_tr16_b64_v4i16((LAS s16x4*)p)); }

DEVI void unit(LAS unsigned char* lds, const bf16_t* Q, const bf16_t* K, const bf16_t* KV, bf16_t* O, int b, int h, int qb) {
    const int tid = threadIdx.x, lane = tid & 63, w = __builtin_amdgcn_readfirstlane(tid >> 6), r32 = lane & 31, hh = lane >> 5;
    const int grp = w >> 2;
    const int q0 = qb * 256; const size_t rowbase = (size_t)b * SEQ;
    const int NT = (q0 + 256) / 64;
    const int prow = 8 * w + (lane >> 3);
    const char* kg = (const char*)(K + (rowbase + prow) * QK_LD + h * 192 + 8 * ((lane & 7) ^ ((prow >> 1) & 7)));
    const char* vg = (const char*)(KV + (rowbase + prow) * KV_LD + 1024 + h * 128 + 8 * (((((lane & 7) >> 2) ^ ((prow >> 1) & 1)) << 2) | (lane & 3)));
    const unsigned kdst = (unsigned)(KOFF + w * 1024), vdst = (unsigned)(VOFF + w * 1024);
    const unsigned lds0 = (unsigned)(uintptr_t)lds;
#define MLA_ISSUE(t, slotoff) do { \
        const char* kp_ = kg + (size_t)(t) * 64 * QK_LD * 2; const char* vp_ = vg + (size_t)(t) * 64 * KV_LD * 2; \
        _Pragma("unroll") for (int i_ = 0; i_ < 3; ++i_) glds16(kp_ + i_ * 128, (unsigned)__builtin_amdgcn_readfirstlane((int)(lds0 + (slotoff) + kdst + i_ * 8192))); \
        _Pragma("unroll") for (int i_ = 0; i_ < 2; ++i_) glds16(vp_ + i_ * 128, (unsigned)__builtin_amdgcn_readfirstlane((int)(lds0 + (slotoff) + vdst + i_ * 8192))); } while (0)
    MLA_ISSUE(0, 0); MLA_ISSUE(1, SLOT);
    const bf16_t* qrow = Q + (rowbase + q0 + 32 * w + r32) * QK_LD + h * 192 + 8 * hh;
    bf16x8 qf[12];
#pragma unroll
    for (int ks = 0; ks < 12; ++ks) qf[ks] = *(const bf16x8*)(qrow + 16 * ks);
#pragma unroll
    for (int ks = 0; ks < 12; ++ks) asm volatile("" : "+v"(qf[ks]));
    f32x16 o[4];
#pragma unroll
    for (int d = 0; d < 4; ++d)
#pragma unroll
        for (int r = 0; r < 16; ++r) o[d][r] = 0.f;
    float mref = 0.f, lsum = 0.f;
    LAS float* wsf = (LAS float*)(lds + WS_OFF) + w * 32;
    const int ksw = (r32 >> 1) & 7;
    const int vread = VOFF + ((lane >> 4) & 1) * 32 + (lane & 3) * 8 + (4 * hh + ((lane & 15) >> 2)) * 128;
    asm volatile("s_waitcnt vmcnt(5)" ::: "memory");
    __builtin_amdgcn_s_barrier();
    asm volatile("" ::: "memory");
#define MLA_BAR() do { asm volatile("s_waitcnt lgkmcnt(0)" ::: "memory"); __builtin_amdgcn_s_barrier(); asm volatile("" ::: "memory"); } while (0)
#define MLA_PREFETCH(i) do { if ((i) + 2 < NT) { const int so_ = (((i) + 2) % 3) * SLOT; MLA_ISSUE((i) + 2, so_); } } while (0)
#define MLA_LANDED(i) do { if ((i) + 2 < NT) asm volatile("s_waitcnt vmcnt(5)" ::: "memory"); else asm volatile("s_waitcnt vmcnt(0)" ::: "memory"); } while (0)
    if (grp) MLA_BAR();
    for (int t = 0; t < NT; ++t) {
        const int slot = (t % 3) * SLOT;
        if (grp) MLA_PREFETCH(t);
        f32x16 s0, s1;
        {
            unsigned kr[4];
#pragma unroll
            for (int j = 0; j < 4; ++j) kr[j] = lds0 + (unsigned)(slot + KOFF + r32 * 128 + (((2 * j + hh) ^ ksw) * 16));
#define MLA_KLD(ks, d0, d1) do { asm volatile("ds_read_b128 %0, %1 offset:%2" : "=&v"(d0) : "v"(kr[(ks) & 3]), "i"(((ks) >> 2) * 8192)); \
                                 asm volatile("ds_read_b128 %0, %1 offset:%2" : "=&v"(d1) : "v"(kr[(ks) & 3]), "i"(((ks) >> 2) * 8192 + 4096)); } while (0)
            bf16x8 ka[3], kb[3];
            __builtin_amdgcn_s_setprio(1);
            MLA_KLD(0, ka[0], kb[0]); MLA_KLD(1, ka[1], kb[1]);
#pragma unroll
            for (int ks = 0; ks < 12; ++ks) {
                if (ks + 2 < 12) { MLA_KLD(ks + 2, ka[(ks + 2) % 3], kb[(ks + 2) % 3]); asm volatile("s_waitcnt lgkmcnt(4)" : "+v"(ka[ks % 3]), "+v"(kb[ks % 3])); }
                else if (ks + 1 < 12) asm volatile("s_waitcnt lgkmcnt(2)" : "+v"(ka[ks % 3]), "+v"(kb[ks % 3]));
                else asm volatile("s_waitcnt lgkmcnt(0)" : "+v"(ka[ks % 3]), "+v"(kb[ks % 3]));
                if (ks == 0) { f32x16 z;
#pragma unroll
                    for (int r = 0; r < 16; ++r) z[r] = 0.f;
                    s0 = __builtin_amdgcn_mfma_f32_32x32x16_bf16(ka[0], qf[0], z, 0, 0, 0); s1 = __builtin_amdgcn_mfma_f32_32x32x16_bf16(kb[0], qf[0], z, 0, 0, 0); }
                else { s0 = __builtin_amdgcn_mfma_f32_32x32x16_bf16(ka[ks % 3], qf[ks], s0, 0, 0, 0); s1 = __builtin_amdgcn_mfma_f32_32x32x16_bf16(kb[ks % 3], qf[ks], s1, 0, 0, 0); }
            }
#undef MLA_KLD
            __builtin_amdgcn_s_setprio(0);
        }
        if (grp) MLA_LANDED(t);
        MLA_BAR();
        if (!grp) MLA_PREFETCH(t);
        {
            const int jb = t - (NT - 4);
            if (jb >= 0) {
                const int qrel = 32 * w + r32, kb_ = 64 * jb + 4 * hh;
#pragma unroll
                for (int r = 0; r < 16; ++r) { const int kv = kb_ + (r & 3) + 8 * (r >> 2); if (kv > qrel) s0[r] = -INFINITY; if (kv + 32 > qrel) s1[r] = -INFINITY; }
            }
            float ma = fmaxf(fmaxf(s0[0], s0[1]), s1[0]), mb = fmaxf(fmaxf(s0[2], s0[3]), s1[1]);
            ma = fmaxf(fmaxf(ma, s1[2]), s1[3]);
#pragma unroll
            for (int r = 4; r < 16; r += 4) { ma = fmaxf(fmaxf(ma, s0[r]), s0[r + 1]); mb = fmaxf(fmaxf(mb, s0[r + 2]), s0[r + 3]); ma = fmaxf(fmaxf(ma, s1[r]), s1[r + 1]); mb = fmaxf(fmaxf(mb, s1[r + 2]), s1[r + 3]); }
            float rm = fmaxf(ma, mb) - mref;
            rm = fmaxf(rm, __shfl_xor(rm, 32));
            if (__any(rm > 8.f)) {
                const float dl = fmaxf(rm, 0.f);
                mref += dl;
                const float corr = __builtin_amdgcn_exp2f(-dl);
                lsum *= corr;
                if (hh == 0) wsf[r32] = corr;
                asm volatile("s_waitcnt lgkmcnt(0)" ::: "memory");
#pragma unroll
                for (int g = 0; g < 4; ++g) { const f32x4 c4 = *(LAS const f32x4*)(wsf + 8 * g + 4 * hh);
#pragma unroll
                    for (int d = 0; d < 4; ++d) { o[d][4 * g + 0] *= c4[0]; o[d][4 * g + 1] *= c4[1]; o[d][4 * g + 2] *= c4[2]; o[d][4 * g + 3] *= c4[3]; } }
                asm volatile("s_waitcnt lgkmcnt(0)" ::: "memory");
            }
            float ps = 0.f;
#pragma unroll
            for (int r = 0; r < 16; ++r) { s0[r] = __builtin_amdgcn_exp2f(s0[r] - mref); s1[r] = __builtin_amdgcn_exp2f(s1[r] - mref); ps += s0[r] + s1[r]; }
            lsum += ps;
            bf16x8 pf[4];
#pragma unroll
            for (int ks = 0; ks < 4; ++ks) {
                u32x4 wv;
                if (ks < 2) { wv.x = pk2(s0[8 * ks + 0], s0[8 * ks + 1]); wv.y = pk2(s0[8 * ks + 2], s0[8 * ks + 3]); wv.z = pk2(s0[8 * ks + 4], s0[8 * ks + 5]); wv.w = pk2(s0[8 * ks + 6], s0[8 * ks + 7]); }
                else { const int k2 = ks - 2; wv.x = pk2(s1[8 * k2 + 0], s1[8 * k2 + 1]); wv.y = pk2(s1[8 * k2 + 2], s1[8 * k2 + 3]); wv.z = pk2(s1[8 * k2 + 4], s1[8 * k2 + 5]); wv.w = pk2(s1[8 * k2 + 6], s1[8 * k2 + 7]); }
                pf[ks] = __builtin_bit_cast(bf16x8, wv);
            }
            const unsigned rb64 = (unsigned)(((lane >> 3) & 1) * 64);
            const unsigned va0 = lds0 + (unsigned)(slot + vread) + rb64, va1 = lds0 + (unsigned)(slot + vread) + (64u - rb64);
            s16x4 vlo[3], vhi[3];
#define MLA_VLD(i, b) do { if (((i) >> 2) & 1) { asm volatile("ds_read_b64_tr_b16 %0, %1 offset:%2" : "=&v"(vlo[b]) : "v"(va1), "i"(((i) >> 3) * 8192 + ((i) & 3) * 2048)); \
                                                 asm volatile("ds_read_b64_tr_b16 %0, %1 offset:%2" : "=&v"(vhi[b]) : "v"(va1), "i"(((i) >> 3) * 8192 + ((i) & 3) * 2048 + 1024)); } \
                           else { asm volatile("ds_read_b64_tr_b16 %0, %1 offset:%2" : "=&v"(vlo[b]) : "v"(va0), "i"(((i) >> 3) * 8192 + ((i) & 3) * 2048)); \
                                  asm volatile("ds_read_b64_tr_b16 %0, %1 offset:%2" : "=&v"(vhi[b]) : "v"(va0), "i"(((i) >> 3) * 8192 + ((i) & 3) * 2048 + 1024)); } } while (0)
            __builtin_amdgcn_s_setprio(1);
            MLA_VLD(0, 0); MLA_VLD(1, 1);
#pragma unroll
            for (int i = 0; i < 16; ++i) {
                if (i + 2 < 16) { MLA_VLD(i + 2, (i + 2) % 3); asm volatile("s_waitcnt lgkmcnt(4)" : "+v"(vlo[i % 3]), "+v"(vhi[i % 3])); }
                else if (i + 1 < 16) asm volatile("s_waitcnt lgkmcnt(2)" : "+v"(vlo[i % 3]), "+v"(vhi[i % 3]));
                else asm volatile("s_waitcnt lgkmcnt(0)" : "+v"(vlo[i % 3]), "+v"(vhi[i % 3]));
                const s16x4 lo = vlo[i % 3], hi = vhi[i % 3];
                const bf16x8 vf = (bf16x8){lo[0], lo[1], lo[2], lo[3], hi[0], hi[1], hi[2], hi[3]};
                o[i >> 2] = __builtin_amdgcn_mfma_f32_32x32x16_bf16(pf[i & 3], vf, o[i >> 2], 0, 0, 0);
            }
#undef MLA_VLD
            __builtin_amdgcn_s_setprio(0);
        }
        if (!grp) MLA_LANDED(t);
        MLA_BAR();
    }
    if (!grp) MLA_BAR();
#undef MLA_BAR
#undef MLA_PREFETCH
#undef MLA_LANDED
    lsum += __shfl_xor(lsum, 32);
    if (hh == 0) wsf[r32] = 1.f / lsum;
    asm volatile("s_waitcnt lgkmcnt(0)" ::: "memory");
    bf16_t* orow = O + (rowbase + q0 + 32 * w) * DM + h * 128 + r32;
#pragma unroll
    for (int g = 0; g < 4; ++g) { const f32x4 c4 = *(LAS const f32x4*)(wsf + 8 * g + 4 * hh);
#pragma unroll
        for (int e = 0; e < 4; ++e) { const int qr = 8 * g + 4 * hh + e;
#pragma unroll
            for (int d = 0; d < 4; ++d) orow[(size_t)qr * DM + 32 * d] = (bf16_t)f2bf(o[d][4 * g + e] * c4[e]); } }
    asm volatile("s_waitcnt lgkmcnt(0)" ::: "memory");
    __builtin_amdgcn_s_barrier();
    asm volatile("" ::: "memory");
#undef MLA_ISSUE
}
DEVI void phase(LAS unsigned char* lds, const bf16_t* Q, const bf16_t* K, const bf16_t* KV, bf16_t* O, int vcu, int G) {
    for (int p = vcu; p < 256; p += G) {
        const int bh = p >> 3, s = p & 7;
        unit(lds, Q, K, KV, O, bh >> 3, bh & 7, 15 - s);
        unit(lds, Q, K, KV, O, bh >> 3, bh & 7, s);
    }
}
}


namespace peer {
typedef float f32x2 __attribute__((ext_vector_type(2)));
DEVI float rl(float v, int l) { return __builtin_bit_cast(float, __builtin_amdgcn_readlane(__builtin_bit_cast(int, v), l)); }
DEVI void convert_load(f32x4 (&v)[8], const float* src, int lane) {
#pragma unroll
    for (int i = 0; i < 8; ++i) v[i] = *(const f32x4*)(src + 256 * i + 4 * lane);
}
template <bool HAS_GAIN, bool INT8> DEVI void convert_finish(f32x4 (&v)[8], const f32x4 (&gn)[8], unsigned char* dst, float* scale_inv, int lane) {
    float am = 0.f;
#pragma unroll
    for (int i = 0; i < 8; ++i) { f32x4 x = v[i]; if (HAS_GAIN) x = x * gn[i];
        v[i] = x; am = fmaxf(am, fmaxf(fmaxf(fabsf(x[0]), fabsf(x[1])), fmaxf(fabsf(x[2]), fabsf(x[3])))); }
#pragma unroll
    for (int o = 1; o < 64; o <<= 1) am = fmaxf(am, __shfl_xor(am, o));
    const float top = INT8 ? 127.f : 256.f;
    const float sc = am > 0.f ? top / am : 1.f;
#pragma unroll
    for (int i = 0; i < 8; ++i) { const f32x4 x = v[i] * sc; int p;
        if (INT8) { const int q0 = __float2int_rn(x[0]), q1 = __float2int_rn(x[1]), q2 = __float2int_rn(x[2]), q3 = __float2int_rn(x[3]);
                    p = (q0 & 255) | ((q1 & 255) << 8) | ((q2 & 255) << 16) | (q3 << 24); }
        else { p = __builtin_amdgcn_cvt_pk_fp8_f32(x[0], x[1], 0, false); p = __builtin_amdgcn_cvt_pk_fp8_f32(x[2], x[3], p, true); }
        *(int*)(dst + ((size_t)(2 * i + (lane >> 5)) * 16384) * 128 + 4 * (lane & 31)) = p; }
    if (lane == 0) *scale_inv = am > 0.f ? am / top : 1.f;
}
template <bool HAS_GAIN> DEVI void convert_rows(const float* src, const float* gain, unsigned char* dst, float* scale_inv, int first, int stride, int n, int lane) {
    if (first >= n) return;
    f32x4 gn[8];
#pragma unroll
    for (int i = 0; i < 8; ++i) gn[i] = HAS_GAIN ? *(const f32x4*)(gain + 256 * i + 4 * lane) : (f32x4){1.f, 1.f, 1.f, 1.f};
    f32x4 cur[8], nx1[8], nx2[8];
    int r = first;
    if (r + stride < n) {
        convert_load(cur, src + (size_t)r * DM, lane);
        convert_load(nx1, src + (size_t)(r + stride) * DM, lane);
        for (; r + 2 * stride < n; r += stride) {
            convert_load(nx2, src + (size_t)(r + 2 * stride) * DM, lane);
            convert_finish<HAS_GAIN, true>(cur, gn, dst + (size_t)r * 128, scale_inv + r, lane);
#pragma unroll
            for (int i = 0; i < 8; ++i) { cur[i] = nx1[i]; nx1[i] = nx2[i]; }
        }
        convert_finish<HAS_GAIN, true>(cur, gn, dst + (size_t)r * 128, scale_inv + r, lane); r += stride;
        convert_finish<HAS_GAIN, true>(nx1, gn, dst + (size_t)r * 128, scale_inv + r, lane);
    } else {
        convert_load(cur, src + (size_t)r * DM, lane);
        convert_finish<HAS_GAIN, true>(cur, gn, dst + (size_t)r * 128, scale_inv + r, lane);
    }
}
DEVI float reduce4(float p0, float p1, float p2, float p3, int lane) {
    const bool h5 = (lane & 32) != 0, h4 = (lane & 16) != 0;
    float a = h5 ? p2 : p0, b = h5 ? p0 : p2; a += __shfl_xor(b, 32);
    float c = h5 ? p3 : p1, d = h5 ? p1 : p3; c += __shfl_xor(d, 32);
    float x = h4 ? c : a, y = h4 ? a : c; x += __shfl_xor(y, 16);
    x += __shfl_xor(x, 8); x += __shfl_xor(x, 4); x += __shfl_xor(x, 2); x += __shfl_xor(x, 1);
    return x;
}
#define PEER_LOAD4(buf, base, sel, k0) do { _Pragma("unroll") for (int r_ = 0; r_ < 4; ++r_) { \
        const unsigned char* rp_ = (base) + (size_t)__builtin_amdgcn_readlane((sel), ((k0) + r_) & 63) * DM + lane * 16; \
        buf[r_][0] = *(const u32x4*)(rp_); buf[r_][1] = *(const u32x4*)(rp_ + 1024); } } while (0)
DEVI float dotrow(const u32x4 (&row)[2], const f32x2 (&h2)[16]) {
    f32x2 p = (f32x2){0.f, 0.f};
#pragma unroll
    for (int c = 0; c < 2; ++c)
#pragma unroll
        for (int j = 0; j < 4; ++j) { const int wv = (int)row[c][j];
            const f32x2 f01 = __builtin_amdgcn_cvt_pk_f32_fp8(wv, false), f23 = __builtin_amdgcn_cvt_pk_f32_fp8(wv, true);
            p += f01 * h2[8 * c + 2 * j]; p += f23 * h2[8 * c + 2 * j + 1]; }
    return p[0] + p[1];
}
DEVI void axpyrow(f32x2 (&y)[16], const u32x4 (&row)[2], float wk) {
#pragma unroll
    for (int c = 0; c < 2; ++c)
#pragma unroll
        for (int j = 0; j < 4; ++j) { const int wv = (int)row[c][j];
            const f32x2 f01 = __builtin_amdgcn_cvt_pk_f32_fp8(wv, false), f23 = __builtin_amdgcn_cvt_pk_f32_fp8(wv, true);
            y[8 * c + 2 * j] += f01 * wk; y[8 * c + 2 * j + 1] += f23 * wk; }
}
DEVI void token(LAS float* scr, const bf16_t* hn, const unsigned char* U8, const unsigned char* V8, const float* usc, const float* vsc, const int* idx, const float* gw, float* out, size_t t, int lane) {
    f32x2 h2[16];
#pragma unroll
    for (int c = 0; c < 2; ++c)
#pragma unroll
        for (int q = 0; q < 2; ++q) { const u32x4 w = *(const u32x4*)(hn + t * DM + 1024 * c + 16 * lane + 8 * q); float f[8]; unpack8(w, f);
#pragma unroll
            for (int e = 0; e < 4; ++e) h2[8 * c + 4 * q + e] = (f32x2){f[2 * e], f[2 * e + 1]}; }
    const int idlo = idx[t * 128 + lane], idhi = idx[t * 128 + 64 + lane];
    const float glo = gw[t * 128 + lane] * vsc[idlo], ghi = gw[t * 128 + 64 + lane] * vsc[idhi];
    const float ulo = usc[idlo], uhi = usc[idhi];
    u32x4 bA[4][2], bB[4][2];
    PEER_LOAD4(bA, U8, idlo, 0);
    for (int kb = 0; kb < 128; kb += 8) {
        const int sel = kb < 64 ? idlo : idhi;
        PEER_LOAD4(bB, U8, sel, kb + 4);
        { const float x = reduce4(dotrow(bA[0], h2), dotrow(bA[1], h2), dotrow(bA[2], h2), dotrow(bA[3], h2), lane); if ((lane & 15) == 0) scr[kb + (lane >> 4)] = x; }
        if (kb + 8 < 128) { const int sel2 = (kb + 8) < 64 ? idlo : idhi; PEER_LOAD4(bA, U8, sel2, kb + 8); }
        { const float x = reduce4(dotrow(bB[0], h2), dotrow(bB[1], h2), dotrow(bB[2], h2), dotrow(bB[3], h2), lane); if ((lane & 15) == 0) scr[kb + 4 + (lane >> 4)] = x; }
    }
    asm volatile("s_waitcnt lgkmcnt(0)" ::: "memory");
    const float wlo = glo * gelu_tanh(scr[lane] * ulo), whi = ghi * gelu_tanh(scr[64 + lane] * uhi);
    asm volatile("s_waitcnt lgkmcnt(0)" ::: "memory");
    f32x2 y[16];
#pragma unroll
    for (int i = 0; i < 16; ++i) y[i] = (f32x2){0.f, 0.f};
    PEER_LOAD4(bA, V8, idlo, 0);
    for (int kb = 0; kb < 128; kb += 8) {
        const int sel = kb < 64 ? idlo : idhi; const float wsel = kb < 64 ? wlo : whi;
        PEER_LOAD4(bB, V8, sel, kb + 4);
#pragma unroll
        for (int r = 0; r < 4; ++r) axpyrow(y, bA[r], rl(wsel, (kb + r) & 63));
        if (kb + 8 < 128) { const int sel2 = (kb + 8) < 64 ? idlo : idhi; PEER_LOAD4(bA, V8, sel2, kb + 8); }
#pragma unroll
        for (int r = 0; r < 4; ++r) axpyrow(y, bB[r], rl(wsel, (kb + 4 + r) & 63));
    }
#pragma unroll
    for (int c = 0; c < 2; ++c)
#pragma unroll
        for (int j = 0; j < 4; ++j) { float* o = out + t * DM + 1024 * c + 16 * lane + 4 * j;
            f32x4 a = *(const f32x4*)o; a[0] += y[8 * c + 2 * j][0]; a[1] += y[8 * c + 2 * j][1]; a[2] += y[8 * c + 2 * j + 1][0]; a[3] += y[8 * c + 2 * j + 1][1];
            *(f32x4*)o = a; }
}
#undef PEER_LOAD4

DEVI f32x2 dot16(const u32x4 row, const f32x2 (&h2)[8], f32x2 p) {
#pragma unroll
    for (int j = 0; j < 4; ++j) { const int wv = (int)row[j];
        p += __builtin_amdgcn_cvt_pk_f32_fp8(wv, false) * h2[2 * j]; p += __builtin_amdgcn_cvt_pk_f32_fp8(wv, true) * h2[2 * j + 1]; }
    return p;
}
template <int M> DEVI float xshf(float x) {
    if constexpr (M == 1) return __builtin_bit_cast(float, __builtin_amdgcn_update_dpp(0, __builtin_bit_cast(int, x), 0xB1, 0xF, 0xF, false));
    else if constexpr (M == 2) return __builtin_bit_cast(float, __builtin_amdgcn_update_dpp(0, __builtin_bit_cast(int, x), 0x4E, 0xF, 0xF, false));
    else return __shfl_xor(x, M);
}
template <int M> DEVI int xshi(int x) {
    if constexpr (M == 1) return __builtin_amdgcn_update_dpp(0, x, 0xB1, 0xF, 0xF, false);
    else if constexpr (M == 2) return __builtin_amdgcn_update_dpp(0, x, 0x4E, 0xF, 0xF, false);
    else return __shfl_xor(x, M);
}
template <int B2, int B1, int B0> DEVI void reduce16i(const int (&v)[16], int lane, int& o0, int& o1) {
    const bool b2 = (lane & B2) != 0, b1 = (lane & B1) != 0, b0 = (lane & B0) != 0;
    int q[8], r[4];
#pragma unroll
    for (int j = 0; j < 8; ++j) q[j] = (b2 ? v[8 + j] : v[j]) + xshi<B2>(b2 ? v[j] : v[8 + j]);
#pragma unroll
    for (int j = 0; j < 4; ++j) r[j] = (b1 ? q[4 + j] : q[j]) + xshi<B1>(b1 ? q[j] : q[4 + j]);
    o0 = (b0 ? r[2] : r[0]) + xshi<B0>(b0 ? r[0] : r[2]);
    o1 = (b0 ? r[3] : r[1]) + xshi<B0>(b0 ? r[1] : r[3]);
}
template <int B2, int B1, int B0> DEVI f32x2 reduce16(const float (&v)[16], int lane) {
    const bool b2 = (lane & B2) != 0, b1 = (lane & B1) != 0, b0 = (lane & B0) != 0;
    float q[8], r[4];
#pragma unroll
    for (int j = 0; j < 8; ++j) q[j] = (b2 ? v[8 + j] : v[j]) + xshf<B2>(b2 ? v[j] : v[8 + j]);
#pragma unroll
    for (int j = 0; j < 4; ++j) r[j] = (b1 ? q[4 + j] : q[j]) + xshf<B1>(b1 ? q[j] : q[4 + j]);
    f32x2 o;
    o[0] = (b0 ? r[2] : r[0]) + xshf<B0>(b0 ? r[0] : r[2]);
    o[1] = (b0 ? r[3] : r[1]) + xshf<B0>(b0 ? r[1] : r[3]);
    return o;
}
template <int MASK> DEVI u32x4 bcast4(const u32x4 v) {
    u32x4 r;
#pragma unroll
    for (int k = 0; k < 4; ++k) r[k] = (unsigned)__builtin_amdgcn_ds_swizzle((int)v[k], MASK);
    return r;
}
DEVI void unpack_ids(const u32x4 lo, const u32x4 hi, int (&id)[16]) {
#pragma unroll
    for (int k = 0; k < 4; ++k) { id[2 * k] = (int)(lo[k] & 0xffffu); id[2 * k + 1] = (int)(lo[k] >> 16); id[8 + 2 * k] = (int)(hi[k] & 0xffffu); id[8 + 2 * k + 1] = (int)(hi[k] >> 16); }
}
DEVI void h_to_int8(const bf16_t* hrow, signed char* orow, float* hsc_inv, int lane) {
    float f[4][8]; float am = 0.f;
#pragma unroll
    for (int i = 0; i < 4; ++i) { unpack8(*(const u32x4*)(hrow + 512 * i + 8 * lane), f[i]);
#pragma unroll
        for (int e = 0; e < 8; ++e) am = fmaxf(am, fabsf(f[i][e])); }
#pragma unroll
    for (int o = 1; o < 64; o <<= 1) am = fmaxf(am, __shfl_xor(am, o));
    const float sc = am > 0.f ? 127.f / am : 0.f;
#pragma unroll
    for (int i = 0; i < 4; ++i) { u32x2 w;
        { const int q0 = __float2int_rn(f[i][0] * sc), q1 = __float2int_rn(f[i][1] * sc), q2 = __float2int_rn(f[i][2] * sc), q3 = __float2int_rn(f[i][3] * sc);
          w.x = (unsigned)((q0 & 255) | ((q1 & 255) << 8) | ((q2 & 255) << 16) | (q3 << 24)); }
        { const int q0 = __float2int_rn(f[i][4] * sc), q1 = __float2int_rn(f[i][5] * sc), q2 = __float2int_rn(f[i][6] * sc), q3 = __float2int_rn(f[i][7] * sc);
          w.y = (unsigned)((q0 & 255) | ((q1 & 255) << 8) | ((q2 & 255) << 16) | (q3 << 24)); }
        *(u32x2*)(orow + 512 * i + 8 * lane) = w; }
    if (lane == 0) *hsc_inv = am * (1.f / 127.f);
}
DEVI void sliceA(const signed char* h8, const unsigned char* U8, const unsigned short* idx, bf16_t* aP, int s, int t0, int nt, int lane) {
    const int g = lane >> 3, c8 = lane & 7;
    const unsigned char* ub = U8 + (size_t)s * 16384 * 128; const unsigned lo = 16u * (unsigned)c8;
    const bool ldi = (c8 == 0), ldh = ((lane & 0x18) == 0);
    u32x4 il = (u32x4){0u, 0u, 0u, 0u}, ih = il, hw = il;
    if (ldi) { il = *(const u32x4*)(idx + (size_t)t0 * 128 + 16 * g); ih = *(const u32x4*)(idx + (size_t)t0 * 128 + 16 * g + 8); }
    if (ldh) hw = *(const u32x4*)(h8 + (size_t)t0 * DM + 128 * s + 16 * c8);
    u32x4 bil = bcast4<0x18>(il), bih = bcast4<0x18>(ih), hb = bcast4<0x07>(hw);
    for (int tt = 0; tt < nt; ++tt) {
        const size_t t = (size_t)t0 + tt;
        int id[16]; unpack_ids(bil, bih, id);
        u32x4 rows[16];
#pragma unroll
        for (int i = 0; i < 16; ++i) rows[i] = *(const u32x4*)(ub + ((unsigned)id[i] * 128u + lo));
        const u32x4 hcur = hb;
        if (tt + 1 < nt) {
            if (ldi) { il = *(const u32x4*)(idx + (t + 1) * 128 + 16 * g); ih = *(const u32x4*)(idx + (t + 1) * 128 + 16 * g + 8); }
            if (ldh) hw = *(const u32x4*)(h8 + (t + 1) * DM + 128 * s + 16 * c8);
        }
        int p[16];
#pragma unroll
        for (int i = 0; i < 16; ++i) { int acc = __builtin_amdgcn_sdot4((int)rows[i][0], (int)hcur[0], 0, false); acc = __builtin_amdgcn_sdot4((int)rows[i][1], (int)hcur[1], acc, false);
            acc = __builtin_amdgcn_sdot4((int)rows[i][2], (int)hcur[2], acc, false); acc = __builtin_amdgcn_sdot4((int)rows[i][3], (int)hcur[3], acc, false); p[i] = acc; }
        int oi0, oi1; reduce16i<4, 2, 1>(p, lane, oi0, oi1);
        const f32x2 o = (f32x2){(float)oi0, (float)oi1};
        bil = bcast4<0x18>(il); bih = bcast4<0x18>(ih); hb = bcast4<0x07>(hw);
        asm volatile("" : "+v"(bil), "+v"(bih), "+v"(hb));
        *(unsigned*)(aP + (t * 16 + s) * 128 + 2 * lane) = pk2(o[0], o[1]);
    }
}
DEVI void rowA2(const bf16_t* aP, const unsigned short* idx, const float* gw, const float* usc, const float* vsc, const float* ssqh, const float* hsc_inv, signed char* W, float* wsc, size_t t, int lane) {
    const float r2 = hsc_inv[t] / sqrtf(ssqh[t] * (1.f / DM) + EPS);
    f32x2 a = (f32x2){0.f, 0.f};
#pragma unroll
    for (int s = 0; s < 16; ++s) { const unsigned w2 = *(const unsigned*)(aP + (t * 16 + s) * 128 + 2 * lane); a += (f32x2){__uint_as_float(w2 << 16), __uint_as_float(w2 & 0xffff0000u)}; }
    const unsigned ii = *(const unsigned*)(idx + t * 128 + 2 * lane);
    const int i0 = (int)(ii & 0xffffu), i1 = (int)(ii >> 16);
    const f32x2 g = *(const f32x2*)(gw + t * 128 + 2 * lane);
    const float w0 = g[0] * vsc[i0] * gelu_tanh(a[0] * usc[i0] * r2), w1 = g[1] * vsc[i1] * gelu_tanh(a[1] * usc[i1] * r2);
    float am = fmaxf(fabsf(w0), fabsf(w1));
#pragma unroll
    for (int o = 1; o < 64; o <<= 1) am = fmaxf(am, __shfl_xor(am, o));
    const float sc = am > 0.f ? 127.f / am : 0.f;
    const int q0 = __float2int_rn(w0 * sc), q1 = __float2int_rn(w1 * sc);
    *(unsigned short*)(W + t * 128 + 2 * lane) = (unsigned short)((q0 & 255) | ((q1 & 255) << 8));
    if (lane == 0) wsc[t] = am * (1.f / 127.f);
}
DEVI unsigned bperm(unsigned hi, unsigned lo, unsigned sel) { return __builtin_amdgcn_perm(hi, lo, sel); }
DEVI void sliceB(const unsigned char* V8, const unsigned short* idx, const signed char* W, const float* wsc, const bf16_t* hb, float* out, int s, int t0, int nt, int lane) {
    const int g = lane >> 3, c8 = lane & 7;
    const unsigned char* vb = V8 + (size_t)s * 16384 * 128; const unsigned lo = 16u * (unsigned)c8;
    const bool ldi = (c8 == 0);
    u32x4 il = (u32x4){0u, 0u, 0u, 0u}, ih = il, wq = il;
    if (ldi) { il = *(const u32x4*)(idx + (size_t)t0 * 128 + 16 * g); ih = *(const u32x4*)(idx + (size_t)t0 * 128 + 16 * g + 8); wq = *(const u32x4*)(W + (size_t)t0 * 128 + 16 * g); }
    u32x4 bil = bcast4<0x18>(il), bih = bcast4<0x18>(ih), wb = bcast4<0x18>(wq);
    unsigned hw2 = *(const unsigned*)(hb + (size_t)t0 * DM + 128 * s + 16 * c8 + 2 * g);
    float ws = wsc[t0];
    for (int tt = 0; tt < nt; ++tt) {
        const size_t t = (size_t)t0 + tt;
        int id[16]; unpack_ids(bil, bih, id);
        u32x4 rows[16];
#pragma unroll
        for (int i = 0; i < 16; ++i) rows[i] = *(const u32x4*)(vb + ((unsigned)id[i] * 128u + lo));
        float* op = out + t * DM + 128 * s + 16 * c8 + 2 * g;
        const f32x2 hcur = (f32x2){__uint_as_float(hw2 << 16), __uint_as_float(hw2 & 0xffff0000u)};
        const u32x4 wcur = wb; const float wscur = ws;
        if (tt + 1 < nt) {
            if (ldi) { il = *(const u32x4*)(idx + (t + 1) * 128 + 16 * g); ih = *(const u32x4*)(idx + (t + 1) * 128 + 16 * g + 8); wq = *(const u32x4*)(W + (t + 1) * 128 + 16 * g); }
            hw2 = *(const unsigned*)(hb + (t + 1) * DM + 128 * s + 16 * c8 + 2 * g);
            ws = wsc[t + 1];
        }
        int acc[16];
#pragma unroll
        for (int c = 0; c < 16; ++c) acc[c] = 0;
#pragma unroll
        for (int q = 0; q < 4; ++q)
#pragma unroll
            for (int j = 0; j < 4; ++j) {
                const unsigned d0 = rows[4 * q][j], d1 = rows[4 * q + 1][j], d2 = rows[4 * q + 2][j], d3 = rows[4 * q + 3][j];
                const unsigned p01l = bperm(d1, d0, 0x05010400u), p01h = bperm(d1, d0, 0x07030602u);
                const unsigned p23l = bperm(d3, d2, 0x05010400u), p23h = bperm(d3, d2, 0x07030602u);
                const unsigned t0_ = bperm(p23l, p01l, 0x05040100u), t1_ = bperm(p23l, p01l, 0x07060302u);
                const unsigned t2_ = bperm(p23h, p01h, 0x05040100u), t3_ = bperm(p23h, p01h, 0x07060302u);
                acc[4 * j + 0] = __builtin_amdgcn_sdot4((int)t0_, (int)wcur[q], acc[4 * j + 0], false);
                acc[4 * j + 1] = __builtin_amdgcn_sdot4((int)t1_, (int)wcur[q], acc[4 * j + 1], false);
                acc[4 * j + 2] = __builtin_amdgcn_sdot4((int)t2_, (int)wcur[q], acc[4 * j + 2], false);
                acc[4 * j + 3] = __builtin_amdgcn_sdot4((int)t3_, (int)wcur[q], acc[4 * j + 3], false);
            }
        int oi0, oi1; reduce16i<32, 16, 8>(acc, lane, oi0, oi1);
        const f32x2 o = (f32x2){(float)oi0, (float)oi1};
        bil = bcast4<0x18>(il); bih = bcast4<0x18>(ih); wb = bcast4<0x18>(wq);
        asm volatile("" : "+v"(bil), "+v"(bih), "+v"(wb), "+v"(hw2), "+v"(ws));
        *(f32x2*)op = hcur + o * wscur;
    }
}
}


namespace topk {
struct CandTab { int a[50], b[50]; };
constexpr CandTab make_tab() { CandTab t{}; int n = 0; for (int a = 0; a < 16; ++a) for (int b = 0; b < 16; ++b) if ((a + 1) * (b + 1) <= 16) { t.a[n] = a; t.b[n] = b; ++n; } return t; }
constexpr CandTab CT = make_tab();
DEVI void ins16(float (&L)[16], float x) {
#pragma unroll
    for (int k = 0; k < 16; ++k) { const float hi = fmaxf(L[k], x); x = fminf(L[k], x); L[k] = hi; }
}
DEVI void merge_partner(float (&L)[16]) {
    float M[16];
#pragma unroll
    for (int k = 0; k < 16; ++k) M[k] = __shfl_xor(L[k], 32);
#pragma unroll
    for (int k = 0; k < 16; ++k) L[k] = fmaxf(L[k], M[15 - k]);
#pragma unroll
    for (int st = 8; st >= 1; st >>= 1)
#pragma unroll
        for (int i = 0; i < 16; ++i) if ((i & st) == 0) { const float a = L[i], b = L[i + st]; L[i] = fmaxf(a, b); L[i + st] = fminf(a, b); }
}
DEVI void stage_keys(LAS unsigned char* lds, const bf16_t* subk, int h, int tid) {
#pragma unroll
    for (int i = 0; i < 8; ++i) {
        const int c = tid + 512 * i, p = c >> 11, rem = c & 2047, row = rem >> 4, ch = rem & 15, kb = ch >> 2, cq = ch & 3;
        const u32x4 v = *(const u32x4*)(subk + ((size_t)(h * 2 + p) * 128 + row) * 128 + ch * 8);
        *(LAS u32x4*)(lds + p * 32768 + kb * 8192 + row * 64 + ((cq ^ ((row >> 2) & 3)) * 16)) = v;
    }
}
DEVI void unit(LAS unsigned char* lds, const bf16_t* qp, unsigned short* idx, float* gw, int tt, int h) {
    const int tid = threadIdx.x, lane = tid & 63, w = __builtin_amdgcn_readfirstlane(tid >> 6), r32 = lane & 31, hh = lane >> 5;
    const size_t tok = (size_t)tt * 256 + 32 * w + r32;
    const int ksw = (r32 >> 2) & 3;
    float T0[16], T1[16];
#pragma unroll
    for (int p = 0; p < 2; ++p) {
        bf16x8 qf[8];
        const bf16_t* qfrag = qp + ((((size_t)tt * 8 + w) * 8 + h) * 2 + p) * 4096 + hh * 256 + r32 * 8;
#pragma unroll
        for (int ks = 0; ks < 8; ++ks) qf[ks] = *(const bf16x8*)(qfrag + ks * 512);
        f32x16 acc[4];
#pragma unroll
        for (int kt = 0; kt < 4; ++kt)
#pragma unroll
            for (int r = 0; r < 16; ++r) acc[kt][r] = 0.f;
        LAS const unsigned char* kbase = lds + p * 32768 + r32 * 64;
#pragma unroll
        for (int ks = 0; ks < 8; ++ks) {
            const int off = (ks >> 1) * 8192 + (((2 * (ks & 1) + hh) ^ ksw) * 16);
#pragma unroll
            for (int kt = 0; kt < 4; ++kt) { const bf16x8 kf = *(LAS const bf16x8*)(kbase + off + kt * 2048); acc[kt] = __builtin_amdgcn_mfma_f32_32x32x16_bf16(kf, qf[ks], acc[kt], 0, 0, 0); }
        }
        float L[16];
#pragma unroll
        for (int k = 0; k < 16; ++k) L[k] = -INFINITY;
#pragma unroll
        for (int kt = 0; kt < 4; ++kt)
#pragma unroll
            for (int r = 0; r < 16; ++r) { const unsigned key = (unsigned)(32 * kt + (r & 3) + 8 * (r >> 2) + 4 * hh); ins16(L, __uint_as_float((__float_as_uint(acc[kt][r]) & ~127u) | key)); }
        merge_partner(L);
#pragma unroll
        for (int k = 0; k < 16; ++k) { if (p == 0) T0[k] = L[k]; else T1[k] = L[k]; }
    }
    LAS unsigned* tl = (LAS unsigned*)(lds + 65536) + w * 2048 + lane;
#pragma unroll
    for (int k = 0; k < 16; ++k) { tl[k * 64] = __float_as_uint(T0[k]); tl[(16 + k) * 64] = __float_as_uint(T1[k]); }
    float C[16];
#pragma unroll
    for (int k = 0; k < 16; ++k) C[k] = -INFINITY;
#pragma unroll
    for (int i = 0; i < 25; ++i) {
        const float v0 = T0[CT.a[2 * i]] + T1[CT.b[2 * i]], v1 = T0[CT.a[2 * i + 1]] + T1[CT.b[2 * i + 1]];
        const unsigned c0 = (unsigned)(CT.a[2 * i] * 16 + CT.b[2 * i]), c1 = (unsigned)(CT.a[2 * i + 1] * 16 + CT.b[2 * i + 1]);
        const unsigned bits = (__float_as_uint(hh ? v1 : v0) & ~255u) | (hh ? c1 : c0);
        ins16(C, __uint_as_float(bits));
    }
    merge_partner(C);
    const float mx = C[0];
    float sum = 0.f;
#pragma unroll
    for (int k = 0; k < 16; ++k) sum += __expf(C[k] - mx);
    const float inv = 1.f / sum;
    unsigned short io8[8]; f32x4 go4[2];
#pragma unroll
    for (int k = 0; k < 8; ++k) {
        float clo = C[k], chi = C[8 + k]; asm volatile("" : "+v"(clo), "+v"(chi));
        const float cv = hh ? chi : clo;
        const unsigned cb = __float_as_uint(cv), ai = (cb >> 4) & 15u, bi = cb & 15u;
        const unsigned i1 = tl[ai * 64] & 127u, i2 = tl[(16 + bi) * 64] & 127u;
        io8[k] = (unsigned short)((i1 << 7) | i2); go4[k >> 2][k & 3] = __expf(cv - mx) * inv;
    }
    asm volatile("s_waitcnt lgkmcnt(0)" ::: "memory");
    unsigned short* io = idx + tok * 128 + h * 16 + 8 * hh; float* go = gw + tok * 128 + h * 16 + 8 * hh;
    { u32x4 pw; pw.x = io8[0] | ((unsigned)io8[1] << 16); pw.y = io8[2] | ((unsigned)io8[3] << 16); pw.z = io8[4] | ((unsigned)io8[5] << 16); pw.w = io8[6] | ((unsigned)io8[7] << 16); *(u32x4*)io = pw; }
    *(f32x4*)go = go4[0]; *(f32x4*)(go + 4) = go4[1];
}
DEVI void phase(LAS unsigned char* lds, const bf16_t* qp, const bf16_t* subk, unsigned short* idx, float* gw, int vcu, int G) {
    int last_h = -1;
    for (int u = vcu; u < 512; u += G) {
        const int h = u & 7, tt = u >> 3;
        if (h != last_h) {
            asm volatile("s_waitcnt lgkmcnt(0)" ::: "memory"); __builtin_amdgcn_s_barrier(); asm volatile("" ::: "memory");
            stage_keys(lds, subk, h, threadIdx.x); last_h = h;
            asm volatile("s_waitcnt vmcnt(0) lgkmcnt(0)" ::: "memory"); __builtin_amdgcn_s_barrier(); asm volatile("" ::: "memory");
        }
        unit(lds, qp, idx, gw, tt, h);
    }
}
}


namespace swa {
constexpr int KOFF = 0, VOFF = 32768, POFF = 65536, LOFF = 66560, WOFF = 70784;
DEVI s16x4 vtr(LAS const unsigned char* p) { return __builtin_bit_cast(s16x4, __builtin_amdgcn_ds_read_tr16_b64_v4i16((LAS s16x4*)p)); }
DEVI void unit(LAS unsigned char* lds, const bf16_t* proj, const int* pos, const float* sinks, const float* rel, const float* sqg, const float* skg, bf16_t* O, int b, int kvh, int nb) {
    const int tid = threadIdx.x, lane = tid & 63, w = __builtin_amdgcn_readfirstlane(tid >> 6), r32 = lane & 31, hh = lane >> 5;
    const int head = kvh * 8 + w;
    const int tk0 = nb * 128 - 128;
    const size_t rowbase = (size_t)b * SEQ;
    asm volatile("s_waitcnt lgkmcnt(0)" ::: "memory"); __builtin_amdgcn_s_barrier(); asm volatile("" ::: "memory");
#pragma unroll
    for (int i = 0; i < 8; ++i) {
        const int c = tid + 512 * i, isV = c >> 11, rem = c & 2047, row = rem >> 3, ch = rem & 7, kb = ch >> 2, cq = ch & 3;
        const int tk = tk0 + row;
        u32x4 v = (u32x4){0u, 0u, 0u, 0u};
        if (tk >= 0) v = *(const u32x4*)(proj + (rowbase + tk) * PROJ_LD + (isV ? C_SV : C_SK) + kvh * 64 + ch * 8);
        if (i < 4) {
            float f[8]; unpack8(v, f); float ss = 0.f;
#pragma unroll
            for (int e = 0; e < 8; ++e) ss += f[e] * f[e];
            ss += __shfl_xor(ss, 1); ss += __shfl_xor(ss, 2); ss += __shfl_xor(ss, 4);
            const float r = 1.f / sqrtf(ss * (1.f / 64.f) + EPS);
            const f32x4 g0 = *(const f32x4*)(skg + ch * 8), g1 = *(const f32x4*)(skg + ch * 8 + 4);
            f[0] *= r * g0[0]; f[1] *= r * g0[1]; f[2] *= r * g0[2]; f[3] *= r * g0[3]; f[4] *= r * g1[0]; f[5] *= r * g1[1]; f[6] *= r * g1[2]; f[7] *= r * g1[3];
            v = pack8(f);
        }
        const int dst = isV ? (VOFF + kb * 16384 + row * 64 + cq * 16) : (KOFF + kb * 16384 + row * 64 + ((cq ^ ((row >> 2) & 3)) * 16));
        *(LAS u32x4*)(lds + dst) = v;
    }
    LAS int* posk = (LAS int*)(lds + POFF);
    if (tid < 256) posk[tid] = (tk0 + tid >= 0) ? pos[rowbase + tk0 + tid] : 0;
    LAS float* lut = (LAS float*)(lds + LOFF) + w * 132;
    for (int d = lane; d <= 128; d += 64) lut[d] = rel[t5_bucket(d) * 16 + head];
    asm volatile("s_waitcnt vmcnt(0) lgkmcnt(0)" ::: "memory"); __builtin_amdgcn_s_barrier(); asm volatile("" ::: "memory");
    const float sink = sinks[head];
    LAS float* wsf = (LAS float*)(lds + WOFF) + w * 32;
    const int ksw = (r32 >> 2) & 3;
    const int vlane = VOFF + ((lane >> 4) & 1) * 32 + (lane & 3) * 8 + (4 * hh + ((lane & 15) >> 2)) * 64;
#pragma unroll 1
    for (int qs = 0; qs < 4; ++qs) {
        const size_t t = rowbase + nb * 128 + 32 * qs + r32;
        const bf16_t* qrow = proj + t * PROJ_LD + C_SQ + head * 64 + 8 * hh;
        bf16x8 qf[4];
        {
            float qv[4][8]; float ss = 0.f;
#pragma unroll
            for (int ks = 0; ks < 4; ++ks) { unpack8(*(const u32x4*)(qrow + 16 * ks), qv[ks]);
#pragma unroll
                for (int e = 0; e < 8; ++e) ss += qv[ks][e] * qv[ks][e]; }
            ss += __shfl_xor(ss, 32);
            const float r = 0.125f / sqrtf(ss * (1.f / 64.f) + EPS);
#pragma unroll
            for (int ks = 0; ks < 4; ++ks) { const f32x4 g0 = *(const f32x4*)(sqg + 16 * ks + 8 * hh), g1 = *(const f32x4*)(sqg + 16 * ks + 8 * hh + 4);
                qv[ks][0] *= r * g0[0]; qv[ks][1] *= r * g0[1]; qv[ks][2] *= r * g0[2]; qv[ks][3] *= r * g0[3]; qv[ks][4] *= r * g1[0]; qv[ks][5] *= r * g1[1]; qv[ks][6] *= r * g1[2]; qv[ks][7] *= r * g1[3];
                qf[ks] = __builtin_bit_cast(bf16x8, pack8(qv[ks])); }
        }
        const int pq = pos[t];
        f32x16 S[5];
#pragma unroll
        for (int kk = 0; kk < 5; ++kk)
#pragma unroll
            for (int r = 0; r < 16; ++r) S[kk][r] = 0.f;
#pragma unroll
        for (int ks = 0; ks < 4; ++ks) {
            const int off = KOFF + (ks >> 1) * 16384 + (32 * qs + r32) * 64 + (((2 * (ks & 1) + hh) ^ ksw) * 16);
#pragma unroll
            for (int kk = 0; kk < 5; ++kk) { const bf16x8 kf = *(LAS const bf16x8*)(lds + off + kk * 2048); S[kk] = __builtin_amdgcn_mfma_f32_32x32x16_bf16(kf, qf[ks], S[kk], 0, 0, 0); }
        }
        float m = sink;
#pragma unroll
        for (int kk = 0; kk < 5; ++kk)
#pragma unroll
            for (int g = 0; g < 4; ++g) {
                const int jb = 32 * (qs + kk) + 8 * g + 4 * hh;
                const i32x4 pk = *(LAS const i32x4*)(posk + jb);
                const int pkv[4] = {pk[0], pk[1], pk[2], pk[3]};
#pragma unroll
                for (int e = 0; e < 4; ++e) {
                    const int dj = 32 * kk + 8 * g + 4 * hh + e - r32;
                    int d = pq - pkv[e]; d = d < 0 ? 0 : (d > 128 ? 128 : d);
                    const float sv = S[kk][4 * g + e] + lut[d];
                    const bool valid = (dj >= 1) && (dj <= 128) && (tk0 + jb + e >= 0);
                    const float sm = valid ? sv : -INFINITY;
                    S[kk][4 * g + e] = sm; m = fmaxf(m, sm);
                }
            }
        m = fmaxf(m, __shfl_xor(m, 32));
        float ps = 0.f;
#pragma unroll
        for (int kk = 0; kk < 5; ++kk)
#pragma unroll
            for (int r = 0; r < 16; ++r) { const float p = __expf(S[kk][r] - m); S[kk][r] = p; ps += p; }
        ps += __shfl_xor(ps, 32);
        ps += __expf(sink - m);
        f32x16 o[2];
#pragma unroll
        for (int d = 0; d < 2; ++d)
#pragma unroll
            for (int r = 0; r < 16; ++r) o[d][r] = 0.f;
#pragma unroll
        for (int kk = 0; kk < 5; ++kk)
#pragma unroll
            for (int s2 = 0; s2 < 2; ++s2) {
                u32x4 wv; wv.x = pk2(S[kk][8 * s2 + 0], S[kk][8 * s2 + 1]); wv.y = pk2(S[kk][8 * s2 + 2], S[kk][8 * s2 + 3]); wv.z = pk2(S[kk][8 * s2 + 4], S[kk][8 * s2 + 5]); wv.w = pk2(S[kk][8 * s2 + 6], S[kk][8 * s2 + 7]);
                const bf16x8 pf = __builtin_bit_cast(bf16x8, wv);
                LAS const unsigned char* vb = lds + vlane + (32 * (qs + kk) + 16 * s2) * 64;
#pragma unroll
                for (int d = 0; d < 2; ++d) {
                    const s16x4 lo = vtr(vb + d * 16384), hi = vtr(vb + d * 16384 + 512);
                    const bf16x8 vf = (bf16x8){lo[0], lo[1], lo[2], lo[3], hi[0], hi[1], hi[2], hi[3]};
                    o[d] = __builtin_amdgcn_mfma_f32_32x32x16_bf16(pf, vf, o[d], 0, 0, 0);
                }
            }
        if (hh == 0) wsf[r32] = 1.f / ps;
        asm volatile("s_waitcnt lgkmcnt(0)" ::: "memory");
        bf16_t* orow = O + (rowbase + nb * 128 + 32 * qs) * DM + 1024 + head * 64 + r32;
#pragma unroll
        for (int g = 0; g < 4; ++g) { const f32x4 c4 = *(LAS const f32x4*)(wsf + 8 * g + 4 * hh);
#pragma unroll
            for (int e = 0; e < 4; ++e) { const int qr = 8 * g + 4 * hh + e;
#pragma unroll
                for (int d = 0; d < 2; ++d) orow[(size_t)qr * DM + 32 * d] = (bf16_t)f2bf(o[d][4 * g + e] * c4[e]); } }
        asm volatile("s_waitcnt lgkmcnt(0)" ::: "memory");
    }
}
DEVI void phase(LAS unsigned char* lds, const bf16_t* proj, const int* pos, const float* sinks, const float* rel, const float* sqg, const float* skg, bf16_t* O, int vcu, int G) {
    for (int u = vcu; u < 256; u += G) { const int nb = u & 31, bk = u >> 5; unit(lds, proj, pos, sinks, rel, sqg, skg, O, bk >> 1, bk & 1, nb); }
    asm volatile("s_waitcnt lgkmcnt(0)" ::: "memory"); __builtin_amdgcn_s_barrier(); asm volatile("" ::: "memory");
}
}

constexpr int N_PHASES = 14;
struct Args { const void* in[21]; float* out; unsigned char* ws; int ph_lo, ph_hi; };

__global__ void __launch_bounds__(NTHREADS, 2) __attribute__((amdgpu_waves_per_eu(2, 2))) mega_fwd(Args a) {
    extern __shared__ __attribute__((aligned(16))) unsigned char lds_raw[];
    LAS unsigned char* lds = (LAS unsigned char*)lds_raw;
    volatile LAS unsigned* MISC = (volatile LAS unsigned*)(lds + MISC_OFF);
    const int tid = threadIdx.x, lane = tid & 63, wave = __builtin_amdgcn_readfirstlane(tid >> 6);
    const int G = gridDim.x, bx = blockIdx.x;
    const int vcu = (G % 8 == 0) ? (bx % 8) * (G / 8) + bx / 8 : bx;
    const int gw = vcu * NWAVES + wave, NGW = G * NWAVES;

    const float* x = (const float*)a.in[0]; const int* pos = (const int*)a.in[1];
    const float* g1 = (const float*)a.in[2]; const float* w_in = (const float*)a.in[3]; const float* qag = (const float*)a.in[4]; const float* wqb = (const float*)a.in[5];
    const float* kvag = (const float*)a.in[6]; const float* wkvb = (const float*)a.in[7]; const float* mqg = (const float*)a.in[8]; const float* mkg = (const float*)a.in[9];
    const float* sqg = (const float*)a.in[10]; const float* skg = (const float*)a.in[11]; const float* sinks = (const float*)a.in[12]; const float* rel = (const float*)a.in[13];
    const float* gog = (const float*)a.in[14]; const float* wout = (const float*)a.in[15]; const float* g2 = (const float*)a.in[16]; const float* wpq = (const float*)a.in[17];
    const float* subk = (const float*)a.in[18]; const float* pu = (const float*)a.in[19]; const float* pv = (const float*)a.in[20];
    float* out = a.out; unsigned char* ws = a.ws;
    bf16_t* W1T = (bf16_t*)(ws + WS_W1T); bf16_t* WQB = (bf16_t*)(ws + WS_WQB); bf16_t* WKVB = (bf16_t*)(ws + WS_WKVB); bf16_t* WOUT = (bf16_t*)(ws + WS_WOUT);
    bf16_t* WPQ = (bf16_t*)(ws + WS_WPQ); bf16_t* SUBK = (bf16_t*)(ws + WS_SUBK); bf16_t* UB = (bf16_t*)(ws + WS_UB); bf16_t* VB = (bf16_t*)(ws + WS_VB);
    bf16_t* PROJ = (bf16_t*)(ws + WS_PROJ); bf16_t* KV = (bf16_t*)(ws + WS_KV); bf16_t* Q = (bf16_t*)(ws + WS_Q); bf16_t* K = (bf16_t*)(ws + WS_K); bf16_t* ACT = (bf16_t*)(ws + WS_ACT);
    bf16_t* QP = PROJ; unsigned short* IDX = (unsigned short*)(ws + WS_Q); float* GWT = (float*)(ws + WS_Q + 8 * MiB); signed char* WEX = (signed char*)(ws + WS_Q + 16 * MiB); float* WSC = (float*)(ws + WS_CTL + 512 * 1024); bf16_t* AP = (bf16_t*)(ws + WS_PROJ);
    float* LATP = (float*)(ws + WS_CTL + 1024 * 1024);
    bf16_t* HB = (bf16_t*)(ws + WS_Q + 24 * MiB); float* SSQH = (float*)(ws + WS_CTL + 64 * 1024);
    signed char* HB8 = (signed char*)(ws + WS_ACT); float* HSC = (float*)(ws + WS_CTL + 448 * 1024);
    signed char* W1T8 = (signed char*)(ws + WS_W1T); signed char* WOUT8 = (signed char*)(ws + WS_WOUT); signed char* A8 = (signed char*)(ws + WS_ACT);
    signed char* WPQ8 = (signed char*)(ws + WS_WPQ); float* CM_PQ = (float*)(ws + WS_CTL + 44 * 1024);
    float* CM_IN = (float*)(ws + WS_CTL + 20 * 1024); float* CM_OUT = (float*)(ws + WS_CTL + 32 * 1024);
    float* SA1 = (float*)(ws + WS_CTL + 128 * 1024); float* SA7 = (float*)(ws + WS_CTL + 192 * 1024);
    unsigned char* U8 = ws + WS_UB; unsigned char* V8 = ws + WS_VB; float* USC = (float*)(ws + WS_CTL + 256 * 1024); float* VSC = (float*)(ws + WS_CTL + 384 * 1024);

    for (int u = tid; u < (LDS_BYTES - RING_BYTES) / 4; u += NTHREADS) ((LAS unsigned*)(lds + RING_BYTES))[u] = 0u;
    __syncthreads();
    XcdBarrier bar = xcd_barrier_post((unsigned*)(ws + WS_CTL) + 1024, MISC + 8);
    const int lo = a.ph_lo, hi = a.ph_hi;
#define IN(k) (lo <= (k) && (k) < hi)
#define SEAM(k) do { if (IN(k) && IN((k) + 1)) xcd_barrier(bar); } while (0)

    if (IN(0)) {
        LAS float* scr = (LAS float*)(lds + wave * 16384);
        constexpr int C1 = 64 * 9, C4 = 64 * 8, C5 = 64 * 8, I2 = 8 * 48, I3 = 4 * 64;
        for (int it = gw; it < C1 + C4 + C5 + I2 + I3; it += NGW) {
            int r = it;
            if (r < C1) { colmax_item(w_in, nullptr, CM_IN, 2112, 1, r, lane); continue; } r -= C1;
            if (r < C4) { colmax_item(wout, gog, CM_OUT, 2048, 0, r, lane); continue; } r -= C4;
            if (r < C5) { colmax_item(wpq, g2, CM_PQ, 2048, 0, r, lane); continue; } r -= C5;
            if (r < I2) { transpose_item(wqb, WQB, qag, 512, 1536, 0, r, scr, lane); continue; } r -= I2;
            transpose_item(wkvb, WKVB, kvag, 256, 2048, 2, r, scr, lane);
        }
        const size_t gtid = (size_t)vcu * NTHREADS + tid, nthr = (size_t)G * NTHREADS;
        for (size_t i = gtid; i < (size_t)192 * 2048 / 4; i += nthr) ((unsigned*)(W1T8 + (size_t)2112 * 2048))[i] = 0u;
        convert_range(subk, SUBK, (size_t)8 * 2 * 128 * 128 / 8, nullptr, 128, gtid, nthr);
        { f32x4 cur[8], nxt[8];
          if (gw < T) {
#pragma unroll
              for (int j = 0; j < 8; ++j) cur[j] = *(const f32x4*)(x + (size_t)gw * DM + 4 * (lane + 64 * j));
          }
          for (int t = gw; t < T; t += NGW) {
              const bool more = t + NGW < T;
              if (more) {
#pragma unroll
                  for (int j = 0; j < 8; ++j) nxt[j] = *(const f32x4*)(x + (size_t)(t + NGW) * DM + 4 * (lane + 64 * j));
              }
              norm1_regs_q(cur, g1, A8 + (size_t)t * DM, SA1 + t, lane);
              if (more) {
#pragma unroll
                  for (int j = 0; j < 8; ++j) cur[j] = nxt[j];
              }
          } }
    }
    SEAM(0);
    if (IN(1)) {
        LAS float* scr = (LAS float*)(lds + wave * 16384);
        constexpr int I1 = 32 * 66, I4 = 32 * 64, I5 = 32 * 64;
        for (int it = gw; it < I1 + I4 + I5; it += NGW) {
            if (it < I1) transpose_item_q(w_in, W1T8, nullptr, CM_IN, 2048, 2112, 1, it, scr, lane);
            else if (it < I1 + I4) transpose_item_q(wout, WOUT8, gog, CM_OUT, 2048, 2048, 0, it - I1, scr, lane);
            else transpose_item_q(wpq, WPQ8, g2, CM_PQ, 2048, 2048, 0, it - I1 - I4, scr, lane);
        }
    }
    SEAM(1);
    if (IN(2)) {
        pg8::Gemm g{(const bf16_t*)A8, (const bf16_t*)W1T8, T, PROJ_LD, DM / 2, DM / 2, DM / 2}; pg8::StaticOrder S; S.init(T, PROJ_LD, G, bx);
        pg8::EpiBf16<true> E{PROJ, PROJ_LD, nullptr, 0.f, nullptr, 0, 0, LATP, 3, SA1, CM_IN};
        pg8::gemm_phase<pg8::EpiBf16<true>, pg8::StaticOrder, true, true>(lds, g, S, E);
        { const int nfull = (T / 256) * (PROJ_LD / 256) % G;
          const int nconv = G - nfull;
          if (nfull == 0 || nconv <= 0) { peer::convert_rows<true>(pu, g2, U8, USC, gw, NGW, 16384, lane); peer::convert_rows<false>(pv, nullptr, V8, VSC, gw, NGW, 16384, lane); }
          else if (bx >= nfull) { const int cw = (bx - nfull) * NWAVES + wave, cs = nconv * NWAVES;
              peer::convert_rows<true>(pu, g2, U8, USC, cw, cs, 16384, lane); peer::convert_rows<false>(pv, nullptr, V8, VSC, cw, cs, 16384, lane); } }
    }
    SEAM(2);
    if (IN(3)) {
        { pg8::Gemm g{PROJ + C_QLAT, WQB, T, 1536, 512, PROJ_LD, 512}; pg8::StaticOrder S; S.init(T, 1536, G, bx);
          pg8::EpiBf16<false> E{ACT, QK_LD, nullptr, 1.f / 512.f, LATP, 0, 8, nullptr, 0, nullptr, nullptr};
          pg8::gemm_phase<pg8::EpiBf16<false>, pg8::StaticOrder, true>(lds, g, S, E); }
        { pg8::Gemm g{PROJ + C_KVLAT, WKVB, T, 2048, 256, PROJ_LD, 256}; pg8::StaticOrder S; S.init(T, 2048, G, bx);
          pg8::EpiBf16<false> E{KV, KV_LD, nullptr, 1.f / 256.f, LATP, 8, 4, nullptr, 0, nullptr, nullptr};
          pg8::gemm_phase<pg8::EpiBf16<false>, pg8::StaticOrder, true>(lds, g, S, E); }
    }
    SEAM(3);
    if (IN(4)) {
        for (int t = gw; t < T; t += NGW)
            p3_row(ACT + (size_t)t * QK_LD, KV + (size_t)t * KV_LD, PROJ + (size_t)t * PROJ_LD + C_KPE, pos[t], mqg, mkg, Q + (size_t)t * QK_LD, K + (size_t)t * QK_LD, lane);
    }
    SEAM(4);
    if (IN(5)) {
        mla::phase(lds, Q, K, KV, ACT, vcu, G);
        swa::phase(lds, PROJ, pos, sinks, rel, sqg, skg, ACT, vcu, G);
    }
    SEAM(5);
    if (IN(6)) { for (int t = gw; t < T; t += NGW) p4_row_q(ACT + (size_t)t * DM, SA7 + t, lane); }
    SEAM(6);
    if (IN(7)) {
        pg8::Gemm g{ACT, (const bf16_t*)WOUT8, T, DM, DM / 2, DM, DM / 2}; pg8::StaticOrder S; S.init(T, DM, G, bx);
        pg8::EpiResid<true> E{x, out, HB, SSQH, DM, SA7, CM_OUT};
        pg8::gemm_phase<pg8::EpiResid<true>, pg8::StaticOrder, true, true>(lds, g, S, E);
    }
    SEAM(7);
    if (IN(8)) { for (int t = gw; t < T; t += NGW) peer::h_to_int8(HB + (size_t)t * DM, HB8 + (size_t)t * DM, HSC + t, lane); }
    SEAM(8);
    if (IN(9)) {
        pg8::Gemm g{(const bf16_t*)HB8, (const bf16_t*)WPQ8, T, DM, DM / 2, DM / 2, DM / 2}; pg8::StaticOrder S; S.init(T, DM, G, bx);
        pg8::EpiQp<true> E{QP, SSQH, 1.f / DM, HSC, CM_PQ};
        pg8::gemm_phase<pg8::EpiQp<true>, pg8::StaticOrder, true, true>(lds, g, S, E);
    }
    SEAM(9);
    if (IN(10)) {
        topk::phase(lds, QP, SUBK, IDX, GWT, vcu, G);
    }
    SEAM(10);
    if (IN(11)) {
        for (int vb = bx; vb < 256; vb += G) { const int grp = vb & 7, rank = vb >> 3, t0 = rank * 512 + wave * 64;
            peer::sliceA(HB8, U8, IDX, AP, grp, t0, 64, lane); peer::sliceA(HB8, U8, IDX, AP, grp + 8, t0, 64, lane); }
    }
    SEAM(11);
    if (IN(12)) { for (int t = gw; t < T; t += NGW) peer::rowA2(AP, IDX, GWT, USC, VSC, SSQH, HSC, WEX, WSC, (size_t)t, lane); }
    SEAM(12);
    if (IN(13)) {
        for (int vb = bx; vb < 256; vb += G) { const int grp = vb & 7, rank = vb >> 3, t0 = rank * 512 + wave * 64;
            peer::sliceB(V8, IDX, WEX, WSC, HB, out, grp, t0, 64, lane); peer::sliceB(V8, IDX, WEX, WSC, HB, out, grp + 8, t0, 64, lane); }
    }
#undef IN
#undef SEAM
}

#ifndef MK_N_LAUNCHES
#define MK_N_LAUNCHES 1
#endif
extern "C" void kernel_launch(void* const* d_in, const int* in_sizes, int n_in, void* d_out, int out_size, void* d_ws, size_t ws_size, hipStream_t stream) {
    static int grid = 0;
    if (grid == 0) {
        if (n_in != 21 || ws_size < WS_END || out_size != T * DM) { fprintf(stderr, "kernel_launch: unexpected problem (n_in %d, ws %zu, out %d)\n", n_in, ws_size, out_size); grid = -1; return; }
        int dev = 0, cus = 0;
        if (hipGetDevice(&dev) != hipSuccess || hipDeviceGetAttribute(&cus, hipDeviceAttributeMultiprocessorCount, dev) != hipSuccess) { grid = -1; return; }
        if (hipFuncSetAttribute((const void*)mega_fwd, hipFuncAttributeMaxDynamicSharedMemorySize, LDS_BYTES) != hipSuccess) { fprintf(stderr, "kernel_launch: hipFuncSetAttribute failed\n"); grid = -1; return; }
        int per_cu = 0;
        if (hipOccupancyMaxActiveBlocksPerMultiprocessor(&per_cu, (const void*)mega_fwd, NTHREADS, LDS_BYTES) != hipSuccess || per_cu < 1) { fprintf(stderr, "kernel_launch: occupancy query says %d\n", per_cu); }
        (void)hipGetLastError();
        grid = cus;
    }
    if (grid < 0) return;
    (void)hipMemsetAsync((char*)d_ws + WS_CTL, 0, CTL_ZERO_BYTES, stream);
    Args a{};
    for (int i = 0; i < 21; ++i) a.in[i] = d_in[i];
    a.out = (float*)d_out; a.ws = (unsigned char*)d_ws;
    if (MK_N_LAUNCHES == 1) { a.ph_lo = 0; a.ph_hi = N_PHASES; hipLaunchKernelGGL(mega_fwd, dim3(grid), dim3(NTHREADS), LDS_BYTES, stream, a); }
    else for (int p = 0; p < N_PHASES; ++p) { a.ph_lo = p; a.ph_hi = p + 1; hipLaunchKernelGGL(mega_fwd, dim3(grid), dim3(NTHREADS), LDS_BYTES, stream, a); }
}
```
